# Optimizing an MI355X kernel written in HIP

```python
import jax
import jax.numpy as jnp
from jax import lax
import numpy as np

D_MODEL = 1024
BATCH = 16
SEQ = 2048
DEPTH = 2

GRID_W = 64
CTX_LEN = 256
HEAD_DIM = 64
N_GROUPS = 4
GROUP_HEADS = D_MODEL // HEAD_DIM // N_GROUPS
GROUP_WIDTH = GROUP_HEADS * HEAD_DIM
MIX_WIDTH = N_GROUPS * GROUP_WIDTH
GQA_KV_HEADS = GROUP_HEADS // 2
KV_WIDTH = GQA_KV_HEADS * HEAD_DIM
MLP_HIDDEN = 4 * D_MODEL
CHUNK = 64
Q_BLOCK = 128
NA_KH = 8
NA_KW = 16
ROPE_THETA = 10000.0
EPS = 1e-6
NEG_BIG = -1e30
FORGET_FLOOR = 1e-20
IN_SPLITS = (
    GROUP_WIDTH, GROUP_WIDTH, GROUP_WIDTH, GROUP_WIDTH, GROUP_WIDTH,
    GROUP_WIDTH, GROUP_WIDTH, GROUP_WIDTH, GROUP_WIDTH, 4 * GROUP_HEADS,
    GROUP_WIDTH, KV_WIDTH, KV_WIDTH,
    GROUP_WIDTH, GROUP_WIDTH, GROUP_WIDTH,
)
IN_WIDTH = sum(IN_SPLITS)
F32 = jnp.float32

kernel_name = "hybrid_parallel_group_diffusion_block"


def _rmsnorm(t, g):
    tf = t.astype(F32)
    y = tf * lax.rsqrt(jnp.mean(tf * tf, axis=-1, keepdims=True) + EPS)
    return (y * g.astype(F32)).astype(t.dtype)


def _modulate(h, shift, scale):
    return h * (1 + scale) + shift


def _split_in(z):
    idx = [int(o) for o in np.cumsum(IN_SPLITS)[:-1]]
    return jnp.split(z, idx, axis=-1)


def _heads(t, nh):
    b, s, _ = t.shape
    return t.reshape(b, s, nh, -1).transpose(0, 2, 1, 3)


def _merge(t):
    b, h, s, e = t.shape
    return t.transpose(0, 2, 1, 3).reshape(b, s, h * e)


def _to_chunks(t):
    b, h, s, e = t.shape
    return t.reshape(b, h, s // CHUNK, CHUNK, e).transpose(2, 0, 1, 3, 4)


def _from_chunks(t):
    nc, b, h, l, e = t.shape
    return t.transpose(1, 2, 0, 3, 4).reshape(b, h, nc * l, e)


def _axial_rope(n_tokens, dtype):
    t = jnp.arange(n_tokens)
    row = (t // GRID_W).astype(F32)
    col = (t % GRID_W).astype(F32)
    axis_dims = HEAD_DIM // 2
    inv = jnp.power(ROPE_THETA, -2.0 * jnp.arange(axis_dims // 2, dtype=F32) / axis_dims)
    ang = jnp.concatenate([row[:, None] * inv, col[:, None] * inv], axis=-1)
    return jnp.cos(ang).astype(dtype), jnp.sin(ang).astype(dtype)


def _apply_rope(t, cos, sin):
    t2 = t.reshape(*t.shape[:-1], t.shape[-1] // 2, 2)
    t0, t1 = t2[..., 0], t2[..., 1]
    return jnp.stack([t0 * cos - t1 * sin, t0 * sin + t1 * cos], axis=-1).reshape(t.shape)


def _hgrn2_inputs(q, i, f, lb):
    q = _heads(jax.nn.silu(q), GROUP_HEADS).astype(F32) * HEAD_DIM ** -0.5
    v = _heads(i, GROUP_HEADS).astype(F32)
    f = _heads(f, GROUP_HEADS).astype(F32)
    lbh = lb.reshape(GROUP_HEADS, 1, HEAD_DIM).astype(F32)
    forget = lbh + (1 - lbh) * jax.nn.sigmoid(f)
    log_forget = jnp.log(jnp.maximum(forget, FORGET_FLOOR))
    k = (1 - lbh) * jax.nn.sigmoid(-f)
    return (q, k, v, log_forget)


def _hgrn2_scan(inputs, state):
    tri = jnp.tril(jnp.ones((CHUNK, CHUNK), bool))

    def step(s, blk):
        qc, kc, vc, gc = blk
        b = jnp.cumsum(gc, axis=2)
        rel = jnp.where(tri[:, :, None], b[:, :, :, None, :] - b[:, :, None, :, :], NEG_BIG)
        a = jnp.einsum('bhtd,bhsd,bhtsd->bhts', qc, kc, jnp.exp(rel))
        o = jnp.einsum('bhts,bhsv->bhtv', a, vc) + jnp.einsum('bhtd,bhdv->bhtv', qc * jnp.exp(b), s)
        b_end = b[:, :, -1, :]
        s_new = jnp.exp(b_end)[..., None] * s + jnp.einsum(
            'bhsd,bhsv->bhdv', kc * jnp.exp(b_end[:, :, None, :] - b), vc)
        return s_new, o

    s_fin, o = lax.scan(step, state, tuple(_to_chunks(t) for t in inputs))
    return _from_chunks(o), s_fin


def _mlstm_inputs(q, k, v, gates, gate_b):
    b, s, _ = gates.shape
    q = _heads(q, GROUP_HEADS).astype(F32)
    k = _heads(k, GROUP_HEADS).astype(F32) * HEAD_DIM ** -0.5
    v = _heads(v, GROUP_HEADS).astype(F32)
    g = (gates.astype(F32) + gate_b.astype(F32)).reshape(b, s, 4, GROUP_HEADS).transpose(2, 0, 3, 1)[..., None]
    ig_f, ig_b, fg_f, fg_b = g[0], g[1], g[2], g[3]
    return ((q, k, v, ig_f, jax.nn.log_sigmoid(fg_f)), (q, k, v, ig_b, jax.nn.log_sigmoid(fg_b)))


def _mlstm_scan(inputs, state):
    tri = jnp.tril(jnp.ones((CHUNK, CHUNK), bool))

    def step(carry, blk):
        cmat, nvec, m = carry
        qc, kc, vc, igc, lfc = blk
        igc, lfc = igc[..., 0], lfc[..., 0]
        b = jnp.cumsum(lfc, axis=-1)
        a = b + m[..., None]
        dlog = jnp.where(tri, b[..., :, None] - b[..., None, :] + igc[..., None, :], NEG_BIG)
        m_t = jnp.maximum(a, jnp.max(dlog, axis=-1))
        w_in = jnp.exp(a - m_t)
        p = jnp.exp(dlog - m_t[..., None]) * jnp.einsum('bhtd,bhsd->bhts', qc, kc)
        num = w_in[..., None] * jnp.einsum('bhtd,bhdv->bhtv', qc, cmat) + jnp.einsum('bhts,bhsv->bhtv', p, vc)
        den = w_in * jnp.einsum('bhtd,bhd->bht', qc, nvec) + jnp.sum(p, axis=-1)
        h = num / jnp.maximum(jnp.abs(den), jnp.exp(-m_t))[..., None]
        b_end = b[..., -1]
        g_s = b_end[..., None] - b + igc
        m_new = jnp.maximum(b_end + m, jnp.max(g_s, axis=-1))
        w_old = jnp.exp(b_end + m - m_new)
        w_s = jnp.exp(g_s - m_new[..., None])
        c_new = w_old[..., None, None] * cmat + jnp.einsum('bhs,bhsd,bhsv->bhdv', w_s, kc, vc)
        n_new = w_old[..., None] * nvec + jnp.einsum('bhs,bhsd->bhd', w_s, kc)
        return (c_new, n_new, m_new), h

    s_fin, h = lax.scan(step, state, tuple(_to_chunks(t) for t in inputs))
    return _from_chunks(h), s_fin


def _bidir_prefix(scan_fn, init_state, ctx_f, ctx_b, lat_f, lat_b):
    flip = lambda ts: tuple(jnp.flip(t, axis=2) for t in ts)
    oc_f, sc_f = scan_fn(ctx_f, init_state)
    ol_f, _ = scan_fn(lat_f, sc_f)
    oc_b, sc_b = scan_fn(flip(ctx_b), init_state)
    ol_b, _ = scan_fn(flip(lat_b), sc_b)
    return oc_f + jnp.flip(oc_b, axis=2), ol_f + jnp.flip(ol_b, axis=2)


def _gated_head_norm(o, g, gate):
    return _merge(_rmsnorm(o, g)).astype(gate.dtype) * gate


def _gqa_heads(q, k, v, qn_g, kn_g):
    return (_rmsnorm(_heads(q, GROUP_HEADS), qn_g), _rmsnorm(_heads(k, GQA_KV_HEADS), kn_g),
            _heads(v, GQA_KV_HEADS))


def _gqa_latent(q, k, v, k_ctx, v_ctx):
    b, hq, s, d = q.shape
    hkv = k.shape[1]
    kk = jnp.concatenate([k_ctx, k], axis=2)
    vv = jnp.concatenate([v_ctx, v], axis=2)
    qb = q.reshape(b, hkv, hq // hkv, s // Q_BLOCK, Q_BLOCK, d).transpose(3, 0, 1, 2, 4, 5)

    def block(qi):
        sc = jnp.einsum('bkgqd,bksd->bkgqs', qi, kk).astype(F32) * d ** -0.5
        return jnp.einsum('bkgqs,bksd->bkgqd', jax.nn.softmax(sc, axis=-1).astype(vv.dtype), vv)

    o = lax.map(block, qb)
    return o.transpose(1, 2, 3, 0, 4, 5).reshape(b, hq, s, d)


def _dense_attn(q, k, v):
    b, hq, s, d = q.shape
    hkv = k.shape[1]
    qg = q.reshape(b, hkv, hq // hkv, s, d)
    sc = jnp.einsum('bkgqd,bksd->bkgqs', qg, k).astype(F32) * d ** -0.5
    o = jnp.einsum('bkgqs,bksd->bkgqd', jax.nn.softmax(sc, axis=-1).astype(v.dtype), v)
    return o.reshape(b, hq, s, d)


def _neighbourhood_attn(q, k, v, k_ctx, v_ctx, rpb):
    b, h, s, d = q.shape
    rows = s // GRID_W
    kh = min(NA_KH, rows)
    scale = d ** -0.5
    qg = q.reshape(b, h, rows, GRID_W, d)
    kg = k.reshape(b, h, rows, GRID_W, d)
    vg = v.reshape(b, h, rows, GRID_W, d)
    col = jnp.arange(GRID_W)
    cstart = jnp.clip(col - NA_KW // 2, 0, GRID_W - NA_KW)
    col_in = (col[None, :] >= cstart[:, None]) & (col[None, :] < cstart[:, None] + NA_KW)
    col_idx = jnp.clip(col[None, :] - col[:, None], 1 - NA_KW, NA_KW - 1) + NA_KW - 1
    mask = jnp.broadcast_to(col_in[:, None, :], (GRID_W, kh, GRID_W)).reshape(GRID_W, kh * GRID_W)
    rpb_cols = rpb[:, :, col_idx]

    def row_block(r):
        r0 = jnp.clip(r - kh // 2, 0, rows - kh)
        kr = lax.dynamic_slice_in_dim(kg, r0, kh, axis=2).reshape(b, h, kh * GRID_W, d)
        vr = lax.dynamic_slice_in_dim(vg, r0, kh, axis=2).reshape(b, h, kh * GRID_W, d)
        qr = lax.dynamic_index_in_dim(qg, r, axis=2, keepdims=False)
        row_idx = r0 + jnp.arange(kh) - r + NA_KH - 1
        bias = jnp.take(rpb_cols, row_idx, axis=1).transpose(0, 2, 1, 3).reshape(h, GRID_W, kh * GRID_W)
        s_loc = jnp.einsum('bhqd,bhkd->bhqk', qr, kr).astype(F32) * scale + bias.astype(F32)
        s_loc = jnp.where(mask, s_loc, NEG_BIG)
        s_ctx = jnp.einsum('bhqd,bhcd->bhqc', qr, k_ctx).astype(F32) * scale
        p = jax.nn.softmax(jnp.concatenate([s_ctx, s_loc], axis=-1), axis=-1).astype(v.dtype)
        return jnp.einsum('bhqk,bhkd->bhqd', p, jnp.concatenate([v_ctx, vr], axis=2))

    o = lax.map(row_block, jnp.arange(rows))
    return o.transpose(1, 2, 0, 3, 4).reshape(b, h, s, d)


def _sqrelu_mlp(h, w1, w2):
    return jnp.square(jax.nn.relu(h @ w1)) @ w2


def _layer(x, xc, c, c_ctx, w_mod, b_mod, g1, g2, w_in, lb, hgrn_g, mlstm_b, mlstm_g,
           qn_g, kn_g, rpb, w_out, w1, w2, rope, need_ctx):
    dt = x.dtype
    mod = jnp.split((jax.nn.silu(c) @ w_mod + b_mod)[:, None, :], 6, axis=-1)
    modc = jnp.split((jax.nn.silu(c_ctx) @ w_mod + b_mod)[None, None, :], 6, axis=-1)
    zl = _split_in(_modulate(_rmsnorm(x, g1), mod[0], mod[1]) @ w_in)
    zc = _split_in(_modulate(_rmsnorm(xc, g1), modc[0], modc[1]) @ w_in)
    bsz = x.shape[0]

    a_c, a_l = _bidir_prefix(
        _hgrn2_scan, jnp.zeros((bsz, GROUP_HEADS, HEAD_DIM, HEAD_DIM), F32),
        _hgrn2_inputs(zc[0], zc[1], zc[3], lb[0]), _hgrn2_inputs(zc[0], zc[1], zc[4], lb[1]),
        _hgrn2_inputs(zl[0], zl[1], zl[3], lb[0]), _hgrn2_inputs(zl[0], zl[1], zl[4], lb[1]))
    a_l = _gated_head_norm(a_l, hgrn_g, jax.nn.silu(zl[2]))

    m_cf, m_cb = _mlstm_inputs(zc[5], zc[6], zc[7], zc[9], mlstm_b)
    m_lf, m_lb = _mlstm_inputs(zl[5], zl[6], zl[7], zl[9], mlstm_b)
    st0 = (jnp.zeros((bsz, GROUP_HEADS, HEAD_DIM, HEAD_DIM), F32),
           jnp.zeros((bsz, GROUP_HEADS, HEAD_DIM), F32), jnp.zeros((bsz, GROUP_HEADS), F32))
    b_c, b_l = _bidir_prefix(_mlstm_scan, st0, m_cf, m_cb, m_lf, m_lb)
    b_l = _gated_head_norm(b_l, mlstm_g, jax.nn.sigmoid(zl[8]))

    ql, kl, vl = _gqa_heads(zl[10], zl[11], zl[12], qn_g, kn_g)
    qc_, kc_, vc_ = _gqa_heads(zc[10], zc[11], zc[12], qn_g, kn_g)
    c_l = _merge(_gqa_latent(_apply_rope(ql, *rope), _apply_rope(kl, *rope), vl, kc_, vc_))

    nq, nk, nv = (_heads(t, GROUP_HEADS) for t in zl[13:16])
    cq, ck, cv = (_heads(t, GROUP_HEADS) for t in zc[13:16])
    d_l = _merge(_neighbourhood_attn(nq, nk, nv, ck, cv, rpb))

    y = jnp.concatenate([a_l.astype(dt), b_l.astype(dt), c_l.astype(dt), d_l.astype(dt)], axis=-1) @ w_out
    x = x + mod[2] * y
    x = x + mod[5] * _sqrelu_mlp(_modulate(_rmsnorm(x, g2), mod[3], mod[4]), w1, w2)

    if need_ctx:
        a_cc = _gated_head_norm(a_c, hgrn_g, jax.nn.silu(zc[2]))
        b_cc = _gated_head_norm(b_c, mlstm_g, jax.nn.sigmoid(zc[8]))
        c_cc = _merge(_dense_attn(qc_, kc_, vc_))
        d_cc = _merge(_dense_attn(cq, ck, cv))
        yc = jnp.concatenate([a_cc.astype(dt), b_cc.astype(dt), c_cc.astype(dt), d_cc.astype(dt)], axis=-1) @ w_out
        xc = xc + modc[2] * yc
        xc = xc + modc[5] * _sqrelu_mlp(_modulate(_rmsnorm(xc, g2), modc[3], modc[4]), w1, w2)
    return x, xc


def setup_inputs(seed: int = 0) -> dict:
    key = jax.random.key(seed)
    ks = jax.random.split(key, 20)
    d = D_MODEL
    nrm = lambda k, shape, s: jax.random.normal(k, shape, F32) * s
    gate_base = jnp.concatenate([jnp.zeros((2 * GROUP_HEADS,), F32),
                                 jnp.tile(jnp.linspace(3.0, 6.0, GROUP_HEADS, dtype=F32), 2)])
    return {
        "x": nrm(ks[0], (BATCH, SEQ, d), 1.0),
        "c": nrm(ks[1], (BATCH, d), 1.0),
        "ctx": nrm(ks[2], (BATCH, CTX_LEN, d), 1.0),
        "c_ctx": nrm(ks[3], (d,), 1.0),
        "w_mod": nrm(ks[4], (DEPTH, d, 6 * d), d ** -0.5),
        "b_mod": nrm(ks[5], (DEPTH, 6 * d), 0.02),
        "norm1_g": 1.0 + nrm(ks[6], (DEPTH, d), 0.05),
        "norm2_g": 1.0 + nrm(ks[7], (DEPTH, d), 0.05),
        "w_in": nrm(ks[8], (DEPTH, d, IN_WIDTH), d ** -0.5),
        "hgrn_lb_logits": nrm(ks[9], (DEPTH, 2, GROUP_WIDTH), 0.5),
        "hgrn_norm_g": 1.0 + nrm(ks[10], (DEPTH, HEAD_DIM), 0.05),
        "mlstm_gate_b": gate_base[None, :] + nrm(ks[11], (DEPTH, 4 * GROUP_HEADS), 0.1),
        "mlstm_norm_g": 1.0 + nrm(ks[12], (DEPTH, HEAD_DIM), 0.05),
        "gqa_qnorm_g": 1.0 + nrm(ks[13], (DEPTH, HEAD_DIM), 0.05),
        "gqa_knorm_g": 1.0 + nrm(ks[14], (DEPTH, HEAD_DIM), 0.05),
        "na_rpb": nrm(ks[15], (DEPTH, GROUP_HEADS, 2 * NA_KH - 1, 2 * NA_KW - 1), 0.1),
        "w_out": nrm(ks[16], (DEPTH, MIX_WIDTH, d), MIX_WIDTH ** -0.5),
        "w_mlp1": nrm(ks[17], (DEPTH, d, MLP_HIDDEN), d ** -0.5),
        "w_mlp2": nrm(ks[18], (DEPTH, MLP_HIDDEN, d), MLP_HIDDEN ** -0.5),
        "final_norm_g": 1.0 + nrm(ks[19], (d,), 0.05),
    }


def reference(x, c, ctx, c_ctx, w_mod, b_mod, norm1_g, norm2_g, w_in, hgrn_lb_logits, hgrn_norm_g,
              mlstm_gate_b, mlstm_norm_g, gqa_qnorm_g, gqa_knorm_g, na_rpb, w_out, w_mlp1, w_mlp2,
              final_norm_g):
    rope = _axial_rope(x.shape[1], x.dtype)
    sm = jax.nn.softmax(hgrn_lb_logits.astype(F32), axis=0)
    lbs = jnp.cumsum(sm, axis=0) - sm[0:1]
    xc = ctx
    for l in range(DEPTH):
        x, xc = _layer(x, xc, c, c_ctx, w_mod[l], b_mod[l], norm1_g[l], norm2_g[l], w_in[l], lbs[l],
                       hgrn_norm_g[l], mlstm_gate_b[l], mlstm_norm_g[l], gqa_qnorm_g[l], gqa_knorm_g[l],
                       na_rpb[l], w_out[l], w_mlp1[l], w_mlp2[l], rope, l < DEPTH - 1)
    return _rmsnorm(x, final_norm_g)
```

```cpp
#include <hip/hip_runtime.h>
#include <hip/hip_cooperative_groups.h>
#include <cstdio>
#include <cstdint>
namespace cg = cooperative_groups;

typedef unsigned short u16;
typedef short bf16x8 __attribute__((ext_vector_type(8)));
typedef float f32x4 __attribute__((ext_vector_type(4)));
typedef float f32x16 __attribute__((ext_vector_type(16)));
typedef unsigned u32x4 __attribute__((ext_vector_type(4)));
typedef unsigned u32x2 __attribute__((ext_vector_type(2)));
#define DI __device__ __forceinline__

#ifndef PHASE_LIMIT
#define PHASE_LIMIT 1000
#endif

constexpr int DM = 1024, NBATCH = 16, SEQ = 2048, CTXL = 256;
constexpr int NLAT = NBATCH * SEQ;
constexpr int NTOK = NLAT + NBATCH * CTXL;
constexpr int ZW = 3584;
constexpr int INW = 3600;
constexpr int HID = 4096;
constexpr int HQ = 0, HI_ = 256, HG = 512, HFF = 768, HFB = 1024, MQ = 1280, MK = 1536, MV = 1792, MO = 2048,
              GQ = 2304, GK = 2560, GV = 2688, NQ = 2816, NK = 3072, NV = 3328;
constexpr float EPSN = 1e-6f;
constexpr float L2E = 1.4426950408889634f;
constexpr int NTHR = 512;
constexpr int LDS_BYTES = 131072;

struct Params {
  const float *x, *c, *ctx, *c_ctx, *w_mod, *b_mod, *g1, *g2, *w_in, *lb_logits, *hgrn_g, *mlstm_b, *mlstm_g,
      *qn_g, *kn_g, *rpb, *w_out, *w1, *w2, *final_g;
  float* out;
  u16 *WinT, *WoutT, *W1T, *W2T;
  float *wg, *modv, *ropec, *ropes, *gates, *xcw;
  u16 *xn, *z, *obuf, *hid;
};

DI unsigned pk_bf16(float a, float b) {
  typedef __bf16 bf2 __attribute__((ext_vector_type(2)));
  typedef float f2 __attribute__((ext_vector_type(2)));
  f2 v = {a, b};
  bf2 r = __builtin_convertvector(v, bf2);
  return __builtin_bit_cast(unsigned, r);
}
DI u16 f2bf(float a) { return (u16)(pk_bf16(a, 0.f) & 0xffffu); }
DI float bf_lo(unsigned u) { return __uint_as_float(u << 16); }
DI float bf_hi(unsigned u) { return __uint_as_float(u & 0xffff0000u); }
DI float bf2f(u16 h) { return __uint_as_float(((unsigned)h) << 16); }
DI f32x16 mfma32(bf16x8 a, bf16x8 b, f32x16 c) { return __builtin_amdgcn_mfma_f32_32x32x16_bf16(a, b, c, 0, 0, 0); }
DI f32x4 mfma16(bf16x8 a, bf16x8 b, f32x4 c) { return __builtin_amdgcn_mfma_f32_16x16x32_bf16(a, b, c, 0, 0, 0); }
DI bf16x8 as_bf16x8(u32x4 v) { return __builtin_bit_cast(bf16x8, v); }
DI float wave_sum(float v) {
#pragma unroll
  for (int o = 32; o > 0; o >>= 1) v += __shfl_xor(v, o);
  return v;
}
DI int opaque_tid() { int t = threadIdx.x; asm volatile("" : "+v"(t)); return t; }
DI float fexp(float x) { return __builtin_amdgcn_exp2f(x * L2E); }
DI float siluf(float x) { return x / (1.f + __expf(-x)); }
DI float sigmf(float x) { return 1.f / (1.f + __expf(-x)); }

namespace gm {
constexpr int BM = 256, BK = 64, HALF = 128, HT = HALF * BK, NXCD = 8, WGM = 8;
DI int lds_byte(int r, int c) {
  int st = (r >> 4) * 2 + (c >> 5), rr = r & 15, cc = c & 31, ob = rr * 64 + cc * 2;
  return st * 1024 + (ob ^ (((ob >> 9) & 1) << 5));
}
DI void stage_rc(int b, int& R, int& C) {
  int st = b / 1024, sb = b % 1024, swz = sb ^ (((sb >> 9) & 1) << 5);
  R = (st >> 1) * 16 + swz / 64;
  C = (st & 1) * 32 + (swz % 64) / 2;
}
}

enum { EPI_IN = 0, EPI_OUT = 1, EPI_MLP1 = 2, EPI_MLP2 = 3 };

template <int EPI>
DI void gemm_epilogue(const Params& p, int layer, f32x4 (&acc)[2][2][4][2], int brow, int bcol, int pn, int wr, int wc,
                      int fr, int fq, char* smem) {
  using namespace gm;
  if (EPI == EPI_IN) {
    u16* Z = p.z;
    const bool latent = brow < NLAT;
    if (pn == 9 || pn == 10) {
      float* xch = (float*)smem;
      float ss[2][4][2];
#pragma unroll
      for (int ai = 0; ai < 2; ++ai)
#pragma unroll
        for (int m = 0; m < 4; ++m)
#pragma unroll
          for (int bj = 0; bj < 2; ++bj) {
            float s = 0.f;
#pragma unroll
            for (int n = 0; n < 2; ++n)
#pragma unroll
              for (int j = 0; j < 4; ++j) s += acc[ai][bj][m][n][j] * acc[ai][bj][m][n][j];
            s += __shfl_xor(s, 16);
            s += __shfl_xor(s, 32);
            ss[ai][m][bj] = s;
          }
      if (fq == 0) {
#pragma unroll
        for (int ai = 0; ai < 2; ++ai)
#pragma unroll
          for (int m = 0; m < 4; ++m)
#pragma unroll
            for (int bj = 0; bj < 2; ++bj) xch[(ai * 128 + wr * 64 + m * 16 + fr) * 8 + bj * 4 + wc] = ss[ai][m][bj];
      }
      __syncthreads();
      const float* gq = (pn == 9 ? p.qn_g : p.kn_g) + layer * 64;
#pragma unroll
      for (int ai = 0; ai < 2; ++ai)
#pragma unroll
        for (int m = 0; m < 4; ++m) {
          __builtin_amdgcn_sched_barrier(0);
          const int rl = ai * 128 + wr * 64 + m * 16 + fr;
          const int row = brow + rl;
          const int spos = row & (SEQ - 1);
#pragma unroll
          for (int bj = 0; bj < 2; ++bj) {
            const bool normed = (pn == 9) || (bj == 0);
            float rs = 1.f;
            if (normed) {
              float tot = ss[ai][m][bj] + xch[rl * 8 + bj * 4 + (wc ^ 1)];
              rs = __builtin_amdgcn_rsqf(tot * (1.f / 64.f) + EPSN);
            }
#pragma unroll
            for (int n = 0; n < 2; ++n) {
              const int cih = (wc & 1) * 32 + n * 16 + fq * 4;
              f32x4 v = acc[ai][bj][m][n];
              if (normed) {
                f32x4 g = *(const f32x4*)(gq + cih);
                v = v * rs * g;
                if (latent) {
                  const float2 cs = *(const float2*)(p.ropec + spos * 32 + (cih >> 1));
                  const float2 sn = *(const float2*)(p.ropes + spos * 32 + (cih >> 1));
                  f32x4 r;
                  r[0] = v[0] * cs.x - v[1] * sn.x;
                  r[1] = v[0] * sn.x + v[1] * cs.x;
                  r[2] = v[2] * cs.y - v[3] * sn.y;
                  r[3] = v[2] * sn.y + v[3] * cs.y;
                  v = r;
                }
                if (pn == 9) v = v * 0.125f;
              }
              u32x2 o;
              o[0] = pk_bf16(v[0], v[1]);
              o[1] = pk_bf16(v[2], v[3]);
              *(u32x2*)(Z + (size_t)row * ZW + bcol + bj * 128 + wc * 32 + n * 16 + fq * 4) = o;
            }
          }
        }
    } else {
      const float sc = (pn == 0 || pn == 6 || pn == 11) ? 0.125f : 1.f;
      const bool dosilu = (pn == 0);
#pragma unroll
      for (int ai = 0; ai < 2; ++ai)
#pragma unroll
        for (int m = 0; m < 4; ++m) {
          __builtin_amdgcn_sched_barrier(0);
          const int row = brow + ai * 128 + wr * 64 + m * 16 + fr;
#pragma unroll
          for (int bj = 0; bj < 2; ++bj)
#pragma unroll
            for (int n = 0; n < 2; ++n) {
              f32x4 v = acc[ai][bj][m][n];
              if (dosilu) {
#pragma unroll
                for (int j = 0; j < 4; ++j) v[j] = siluf(v[j]);
              }
              v = v * sc;
              u32x2 o;
              o[0] = pk_bf16(v[0], v[1]);
              o[1] = pk_bf16(v[2], v[3]);
              *(u32x2*)(Z + (size_t)row * ZW + bcol + bj * 128 + wc * 32 + n * 16 + fq * 4) = o;
            }
        }
    }
  } else if (EPI == EPI_MLP1) {
#pragma unroll
    for (int ai = 0; ai < 2; ++ai)
#pragma unroll
      for (int m = 0; m < 4; ++m) {
        __builtin_amdgcn_sched_barrier(0);
        const int row = brow + ai * 128 + wr * 64 + m * 16 + fr;
#pragma unroll
        for (int bj = 0; bj < 2; ++bj)
#pragma unroll
          for (int n = 0; n < 2; ++n) {
            f32x4 v = acc[ai][bj][m][n];
#pragma unroll
            for (int j = 0; j < 4; ++j) {
              float r = fmaxf(v[j], 0.f);
              v[j] = r * r;
            }
            u32x2 o;
            o[0] = pk_bf16(v[0], v[1]);
            o[1] = pk_bf16(v[2], v[3]);
            *(u32x2*)(p.hid + (size_t)row * HID + bcol + bj * 128 + wc * 32 + n * 16 + fq * 4) = o;
          }
      }
  } else {
    const bool latent = brow < NLAT;
    const int bidx = latent ? (brow >> 11) : 16;
    const float* gate = p.modv + ((size_t)(layer * 17 + bidx) * 6 + (EPI == EPI_OUT ? 2 : 5)) * DM;
    const float* src;
    float* dst;
    if (latent) {
      dst = p.out + (size_t)brow * DM;
      src = (EPI == EPI_OUT && layer == 0) ? p.x + (size_t)brow * DM : dst;
    } else {
      dst = p.xcw + (size_t)(brow - NLAT) * DM;
      src = (EPI == EPI_OUT && layer == 0) ? p.ctx + (size_t)(brow - NLAT) * DM : dst;
    }
#pragma unroll
    for (int ai = 0; ai < 2; ++ai)
#pragma unroll
      for (int m = 0; m < 4; ++m) {
        __builtin_amdgcn_sched_barrier(0);
        const int rl = ai * 128 + wr * 64 + m * 16 + fr;
#pragma unroll
        for (int bj = 0; bj < 2; ++bj)
#pragma unroll
          for (int n = 0; n < 2; ++n) {
            const int col = bcol + bj * 128 + wc * 32 + n * 16 + fq * 4;
            const f32x4 xv = *(const f32x4*)(src + (size_t)rl * DM + col);
            const f32x4 gv = *(const f32x4*)(gate + col);
            f32x4 o = xv + gv * acc[ai][bj][m][n];
            *(f32x4*)(dst + (size_t)rl * DM + col) = o;
          }
      }
  }
}

#define LAS __attribute__((address_space(3)))
template <int EPI, int K>
__device__ void gemm_phase(const Params& p, int layer, const u16* __restrict__ A, const u16* __restrict__ Bt, int nM, int nN) {
  using namespace gm;
  extern __shared__ __attribute__((aligned(16))) unsigned char shm[];
  LAS unsigned char* lds = (LAS unsigned char*)shm;
  constexpr int HTB = HT * 2;
#define SAo(b, h) (((b) * 2 + (h)) * HTB)
#define SBo(b, h) ((4 + (b) * 2 + (h)) * HTB)
#define STAGE(bufoff, gbase, voff)                                                                   \
  do {                                                                                               \
    _Pragma("unroll") for (int _i = 0; _i < 2; ++_i)                                                 \
      __builtin_amdgcn_global_load_lds((const unsigned*)((const char*)(gbase) + (voff)[_i]),         \
                                       (LAS unsigned*)(lds + (bufoff) + ldsw + _i * 8192), 16, 0, 0); \
  } while (0)
#define LDA(dst, b, h)                                                                               \
  do {                                                                                               \
    _Pragma("unroll") for (int m = 0; m < 4; ++m) _Pragma("unroll") for (int k = 0; k < 2; ++k)      \
      dst[m][k] = *(const LAS bf16x8*)(lds + SAo(b, h) + aoff + m * 2048 + k * 1024);                \
  } while (0)
#define LDB(dst, b, h)                                                                               \
  do {                                                                                               \
    _Pragma("unroll") for (int n = 0; n < 2; ++n) _Pragma("unroll") for (int k = 0; k < 2; ++k)      \
      dst[n][k] = *(const LAS bf16x8*)(lds + SBo(b, h) + boff + n * 2048 + k * 1024);                \
  } while (0)
#define MMA(ai, bj, At_, Bt_)                                                                        \
  do {                                                                                               \
    __builtin_amdgcn_s_setprio(1);                                                                   \
    _Pragma("unroll") for (int m = 0; m < 4; ++m) _Pragma("unroll") for (int n = 0; n < 2; ++n)      \
      _Pragma("unroll") for (int k = 0; k < 2; ++k)                                                  \
        acc[ai][bj][m][n] = __builtin_amdgcn_mfma_f32_16x16x32_bf16(Bt_[n][k], At_[m][k], acc[ai][bj][m][n], 0, 0, 0); \
    __builtin_amdgcn_s_setprio(0);                                                                   \
  } while (0)
#define WAIT_V(n) asm volatile("s_waitcnt vmcnt(" #n ")" ::: "memory")
#define WAIT_L(n) asm volatile("s_waitcnt lgkmcnt(" #n ")" ::: "memory")
#define BAR __builtin_amdgcn_s_barrier()
#define SCHED __builtin_amdgcn_sched_barrier(0)

  const int nwg = nM * nN;
  const int tid = opaque_tid(), wid = __builtin_amdgcn_readfirstlane(tid >> 6), lane = tid & 63, wr = wid >> 2, wc = wid & 3,
            fr = lane & 15, fq = lane >> 4;
  constexpr int nt = K / BK;
  unsigned voff[2];
#pragma unroll
  for (int i = 0; i < 2; ++i) {
    int r_, c_;
    stage_rc(tid * 16 + i * 8192, r_, c_);
    voff[i] = (unsigned)(r_ * K + c_) * 2u;
  }
  const size_t kstep = (size_t)(BK * 2);
  const size_t hstep = (size_t)HALF * K * 2;
  const size_t tstep = 2 * hstep;
  const unsigned ldsw = (unsigned)wid * 1024u;
  const int aoff = lds_byte(wr * 64 + fr, fq * 8), boff = lds_byte(wc * 32 + fr, fq * 8);
  for (int it = 0;; ++it) {
    const long L = (long)it * gridDim.x + blockIdx.x;
    if (L >= nwg) break;
    int wgid = (int)L;
    {
      const int q = nwg / NXCD, r = nwg % NXCD, xcd = wgid % NXCD, off = wgid / NXCD;
      wgid = (xcd < r ? xcd * (q + 1) : r * (q + 1) + (xcd - r) * q) + off;
    }
    const int nig = WGM * nN, gid = wgid / nig, fm = gid * WGM, gsz = min(nM - fm, WGM);
    const int pm = fm + ((wgid % nig) % gsz), pn = (wgid % nig) / gsz, brow = pm * BM, bcol = pn * BM;
    const char* cA = (const char*)A + (size_t)pm * tstep;
    const char* cB = (const char*)Bt + (size_t)pn * tstep;

    f32x4 acc[2][2][4][2];
#pragma unroll
    for (int a = 0; a < 2; ++a)
#pragma unroll
      for (int b = 0; b < 2; ++b)
#pragma unroll
        for (int m = 0; m < 4; ++m)
#pragma unroll
          for (int n = 0; n < 2; ++n) acc[a][b][m][n] = (f32x4){0.f, 0.f, 0.f, 0.f};
    bf16x8 At[4][2], B0[2][2], B1[2][2];

    STAGE(SBo(0, 0), cB, voff); STAGE(SAo(0, 0), cA, voff);
    STAGE(SBo(0, 1), cB + hstep, voff); STAGE(SAo(0, 1), cA + hstep, voff);
    if (wr == 1) BAR;
    WAIT_V(4); BAR;
    STAGE(SBo(1, 0), cB + kstep, voff); STAGE(SAo(1, 0), cA + kstep, voff); STAGE(SBo(1, 1), cB + hstep + kstep, voff);
    WAIT_V(6); BAR;
    for (int t = 0; t < nt - 2; t += 2) {
      const char* a1 = cA + (size_t)(t + 1) * kstep;
      const char* a2 = cA + (size_t)(t + 2) * kstep;
      const char* b2 = cB + (size_t)(t + 2) * kstep;
      const char* a3 = a2 + kstep;
      const char* b3 = b2 + kstep;
      LDB(B0, 0, 0); SCHED; LDA(At, 0, 0); STAGE(SAo(1, 1), a1 + hstep, voff);
      WAIT_L(8); BAR; WAIT_L(0); MMA(0, 0, At, B0); BAR; SCHED;
      LDB(B1, 0, 1); STAGE(SBo(0, 0), b2, voff);
      BAR; WAIT_L(0); MMA(0, 1, At, B1); BAR;
      LDA(At, 0, 1); STAGE(SAo(0, 0), a2, voff);
      BAR; WAIT_L(0); MMA(1, 0, At, B0); BAR; SCHED;
      STAGE(SBo(0, 1), b2 + hstep, voff);
      WAIT_V(6); BAR; MMA(1, 1, At, B1); BAR;
      LDB(B0, 1, 0); SCHED; LDA(At, 1, 0); STAGE(SAo(0, 1), a2 + hstep, voff);
      WAIT_L(8); BAR; WAIT_L(0); MMA(0, 0, At, B0); BAR; SCHED;
      LDB(B1, 1, 1); STAGE(SBo(1, 0), b3, voff);
      BAR; WAIT_L(0); MMA(0, 1, At, B1); BAR;
      LDA(At, 1, 1); STAGE(SAo(1, 0), a3, voff);
      BAR; WAIT_L(0); MMA(1, 0, At, B0); BAR; SCHED;
      STAGE(SBo(1, 1), b3 + hstep, voff);
      WAIT_V(6); BAR; MMA(1, 1, At, B1); BAR;
    }
    { LDB(B0, 0, 0); LDA(At, 0, 0); STAGE(SAo(1, 1), cA + (size_t)(nt - 1) * kstep + hstep, voff);
      BAR; WAIT_L(0); MMA(0, 0, At, B0); BAR;
      LDB(B1, 0, 1); BAR; WAIT_L(0); MMA(0, 1, At, B1); BAR;
      LDA(At, 0, 1); WAIT_V(4); BAR; WAIT_L(0); MMA(1, 0, At, B0); MMA(1, 1, At, B1); BAR; }
    { LDB(B0, 1, 0); LDA(At, 1, 0); WAIT_V(2); BAR; WAIT_L(0); MMA(0, 0, At, B0); BAR;
      LDB(B1, 1, 1); WAIT_V(0); BAR; WAIT_L(0); MMA(0, 1, At, B1); BAR;
      LDA(At, 1, 1); BAR; WAIT_L(0); MMA(1, 0, At, B0); MMA(1, 1, At, B1); BAR; }
    if (wr == 0) BAR;
    __syncthreads();
    gemm_epilogue<EPI>(p, layer, acc, brow, bcol, pn, wr, wc, fr, fq, (char*)shm);
    __syncthreads();
  }
#undef SAo
#undef SBo
#undef STAGE
#undef LDA
#undef LDB
#undef MMA
}

__device__ void transpose_tile(const float* __restrict__ src, int ldsrc, int scol0, int k0, u16* __restrict__ dst, int Kd, int drow0, char* smem) {
  float* ts = (float*)smem;
  const int tid = opaque_tid();
  {
    const int kk = tid >> 4, n4 = (tid & 15) * 4;
#pragma unroll
    for (int i = 0; i < 2; ++i) {
      const int k = kk + 32 * i;
      const f32x4 v = *(const f32x4*)(src + (size_t)(k0 + k) * ldsrc + scol0 + n4);
      ts[k * 65 + n4 + 0] = v[0];
      ts[k * 65 + n4 + 1] = v[1];
      ts[k * 65 + n4 + 2] = v[2];
      ts[k * 65 + n4 + 3] = v[3];
    }
  }
  __syncthreads();
  {
    const int n = tid >> 3, k8 = (tid & 7) * 8;
    u32x4 o;
#pragma unroll
    for (int j = 0; j < 4; ++j) o[j] = pk_bf16(ts[(k8 + 2 * j) * 65 + n], ts[(k8 + 2 * j + 1) * 65 + n]);
    *(u32x4*)(dst + (size_t)(drow0 + n) * Kd + k0 + k8) = o;
  }
  __syncthreads();
}

__device__ void mod_job(const Params& p, int job, char* smem) {
  const int l = job / 96, n0 = (job % 96) * 64;
  float* sc = (float*)smem;
  float* red = (float*)(smem + 17 * 1024 * 4);
  const int tid = opaque_tid();
  for (int i = tid; i < 17 * 1024; i += NTHR) {
    const int r = i >> 10, k = i & 1023;
    const float v = (r < 16) ? p.c[r * 1024 + k] : p.c_ctx[k];
    sc[i] = siluf(v);
  }
  __syncthreads();
  const int col = tid & 63, kq = tid >> 6;
  float acc[17];
#pragma unroll
  for (int r = 0; r < 17; ++r) acc[r] = 0.f;
  const float* w = p.w_mod + (size_t)l * 1024 * 6144 + n0 + col;
  for (int k = kq * 128; k < kq * 128 + 128; ++k) {
    const float wv = w[(size_t)k * 6144];
#pragma unroll
    for (int r = 0; r < 17; ++r) acc[r] += sc[r * 1024 + k] * wv;
  }
#pragma unroll
  for (int r = 0; r < 17; ++r) red[(kq * 17 + r) * 64 + col] = acc[r];
  __syncthreads();
  for (int i = tid; i < 17 * 64; i += NTHR) {
    const int r = i >> 6, cc = i & 63;
    float s = p.b_mod[l * 6144 + n0 + cc];
#pragma unroll
    for (int q = 0; q < 8; ++q) s += red[(q * 17 + r) * 64 + cc];
    const int n = n0 + cc;
    p.modv[((size_t)(l * 17 + r) * 6 + (n >> 10)) * DM + (n & 1023)] = s;
  }
  __syncthreads();
}

__device__ void prologue_phase(const Params& p, char* smem) {
  constexpr int NJ_MOD = 192, NJ_TR = 6400, NJ_G = 2, NJ_R = 16;
  for (int job = blockIdx.x; job < NJ_MOD + NJ_TR + NJ_G + NJ_R; job += gridDim.x) {
    if (job < NJ_MOD) {
      mod_job(p, job, smem);
    } else if (job < NJ_MOD + NJ_TR) {
      int j = job - NJ_MOD;
      const int l = j / 3200;
      j %= 3200;
      if (j < 896) {
        const int kt = j / 56, nt = j % 56;
        const int scol = nt * 64 + (nt >= 36 ? 16 : 0);
        transpose_tile(p.w_in + (size_t)l * DM * INW, INW, scol, kt * 64, p.WinT + (size_t)l * ZW * DM, DM, nt * 64, smem);
      } else if (j < 896 + 256) {
        j -= 896;
        const int kt = j / 16, nt = j % 16;
        transpose_tile(p.w_out + (size_t)l * DM * DM, DM, nt * 64, kt * 64, p.WoutT + (size_t)l * DM * DM, DM, nt * 64, smem);
      } else if (j < 896 + 256 + 1024) {
        j -= 896 + 256;
        const int kt = j / 64, nt = j % 64;
        transpose_tile(p.w1 + (size_t)l * DM * HID, HID, nt * 64, kt * 64, p.W1T + (size_t)l * HID * DM, DM, nt * 64, smem);
      } else {
        j -= 896 + 256 + 1024;
        const int kt = j / 16, nt = j % 16;
        transpose_tile(p.w2 + (size_t)l * HID * DM, DM, nt * 64, kt * 64, p.W2T + (size_t)l * DM * HID, HID, nt * 64, smem);
      }
    } else if (job < NJ_MOD + NJ_TR + NJ_G) {
      const int l = job - NJ_MOD - NJ_TR;
      for (int i = threadIdx.x; i < 16 * 1024; i += NTHR) {
        const int n = i & 15, k = i >> 4;
        p.wg[(size_t)(l * 16 + n) * DM + k] = p.w_in[(size_t)l * DM * INW + (size_t)k * INW + 2304 + n];
      }
    } else {
      const int j = job - NJ_MOD - NJ_TR - NJ_G;
      for (int i = threadIdx.x; i < 4096; i += NTHR) {
        const int e = j * 4096 + i;
        const int s = e >> 5, idx = e & 31;
        const int row = s >> 6, col = s & 63;
        const int fi = idx & 15;
        const float inv = powf(10000.f, -2.0f * (float)fi / 32.f);
        const float ang = (idx < 16 ? (float)row : (float)col) * inv;
        p.ropec[e] = cosf(ang);
        p.ropes[e] = sinf(ang);
      }
    }
  }
}

__device__ void norm_phase(const Params& p, int layer, int which, int nrows) {
  const int tid_ = opaque_tid();
  const int lane = tid_ & 63, wid = tid_ >> 6;
  const float* g = (which == 0 ? p.g1 : p.g2) + layer * DM;
  for (int row = blockIdx.x * 8 + wid; row < nrows; row += gridDim.x * 8) {
    const bool latent = row < NLAT;
    const float* src;
    if (which == 0 && layer == 0) src = latent ? p.x + (size_t)row * DM : p.ctx + (size_t)(row - NLAT) * DM;
    else src = latent ? p.out + (size_t)row * DM : p.xcw + (size_t)(row - NLAT) * DM;
    const int bidx = latent ? (row >> 11) : 16;
    const float* shift = p.modv + ((size_t)(layer * 17 + bidx) * 6 + (which == 0 ? 0 : 3)) * DM;
    const float* scale = shift + DM;
    f32x4 v[4];
    float ss = 0.f;
#pragma unroll
    for (int i = 0; i < 4; ++i) {
      v[i] = *(const f32x4*)(src + i * 256 + lane * 4);
      ss += v[i][0] * v[i][0] + v[i][1] * v[i][1] + v[i][2] * v[i][2] + v[i][3] * v[i][3];
    }
    ss = wave_sum(ss);
    const float rs = __builtin_amdgcn_rsqf(ss * (1.f / DM) + EPSN);
#pragma unroll
    for (int i = 0; i < 4; ++i) {
      const int c0 = i * 256 + lane * 4;
      const f32x4 gv = *(const f32x4*)(g + c0), sh = *(const f32x4*)(shift + c0), sc = *(const f32x4*)(scale + c0);
      v[i] = (v[i] * rs * gv) * (sc + 1.f) + sh;
      u32x2 o;
      o[0] = pk_bf16(v[i][0], v[i][1]);
      o[1] = pk_bf16(v[i][2], v[i][3]);
      *(u32x2*)(p.xn + (size_t)row * DM + c0) = o;
    }
    if (which == 0) {
      const float* wgl = p.wg + (size_t)layer * 16 * DM;
      float myg = 0.f;
#pragma unroll 1
      for (int n = 0; n < 16; ++n) {
        float a = 0.f;
#pragma unroll
        for (int i = 0; i < 4; ++i) {
          const f32x4 wv = *(const f32x4*)(wgl + n * DM + i * 256 + lane * 4);
          a += v[i][0] * wv[0] + v[i][1] * wv[1] + v[i][2] * wv[2] + v[i][3] * wv[3];
        }
        a = wave_sum(a);
        if (lane == n) myg = a;
      }
      if (lane < 16) p.gates[(size_t)row * 16 + lane] = myg + p.mlstm_b[layer * 16 + lane];
    }
  }
}

__device__ void final_norm_phase(const Params& p) {
  const int tid_ = opaque_tid();
  const int lane = tid_ & 63, wid = tid_ >> 6;
  for (int row = blockIdx.x * 8 + wid; row < NLAT; row += gridDim.x * 8) {
    float* src = p.out + (size_t)row * DM;
    f32x4 v[4];
    float ss = 0.f;
#pragma unroll
    for (int i = 0; i < 4; ++i) {
      v[i] = *(const f32x4*)(src + i * 256 + lane * 4);
      ss += v[i][0] * v[i][0] + v[i][1] * v[i][1] + v[i][2] * v[i][2] + v[i][3] * v[i][3];
    }
    ss = wave_sum(ss);
    const float rs = __builtin_amdgcn_rsqf(ss * (1.f / DM) + EPSN);
#pragma unroll
    for (int i = 0; i < 4; ++i) {
      const int c0 = i * 256 + lane * 4;
      const f32x4 gv = *(const f32x4*)(p.final_g + c0);
      *(f32x4*)(src + c0) = v[i] * rs * gv;
    }
  }
}

constexpr int KS_STRIDE = 72, VT_STRIDE = 66;
DI bf16x8 ld_frag16(const u16* base) { return *(const bf16x8*)base; }
DI bf16x8 ld_frag4x4(const u16* a, const u16* b) {
  u32x4 r;
  const unsigned* pa = (const unsigned*)a;
  const unsigned* pb = (const unsigned*)b;
  r[0] = pa[0]; r[1] = pa[1]; r[2] = pb[0]; r[3] = pb[1];
  return as_bf16x8(r);
}

__device__ void attn_job(const Params& p, int layer, int kind, int idx, char* smem) {
  u16* Ks = (u16*)smem;
  u16* Vt = (u16*)(smem + 2 * 64 * KS_STRIDE * 2);
  float* rpbs = (float*)(smem + 2 * 64 * KS_STRIDE * 2 + 2 * 64 * VT_STRIDE * 2);
  const int tid = opaque_tid(), lane = tid & 63, w = __builtin_amdgcn_readfirstlane(tid >> 6), tq = lane & 31, hh = lane >> 5;
  int b, qrow0, qcol, ocol, kcol, vcol, nlat = 0, lat0 = 0, r = 0, r0w = 0, R0 = 0, hN = 0;
  if (kind == 0) {
    b = idx >> 5; const int kvh = (idx >> 4) & 1, qt = idx & 15;
    const int head = kvh * 2 + (w >> 2);
    qrow0 = b * SEQ + qt * 128 + (w & 3) * 32; qcol = GQ + head * 64; ocol = 512 + head * 64;
    kcol = GK + kvh * 64; vcol = GV + kvh * 64; nlat = 32; lat0 = b * SEQ;
  } else if (kind == 1) {
    b = idx >> 5; hN = (idx >> 3) & 3; const int rg = idx & 7;
    r = rg * 4 + (w >> 1);
    qrow0 = b * SEQ + r * 64 + (w & 1) * 32; qcol = NQ + hN * 64; ocol = 768 + hN * 64;
    kcol = NK + hN * 64; vcol = NV + hN * 64;
    R0 = min(max(rg * 4 - 4, 0), 24);
    const int R1 = min(max(rg * 4 + 3 - 4, 0), 24) + 8;
    nlat = R1 - R0; lat0 = b * SEQ + R0 * 64;
    r0w = min(max(r - 4, 0), 24);
  } else if (kind == 2) {
    b = idx >> 2; const int kvh = (idx >> 1) & 1, half = idx & 1;
    const int head = kvh * 2 + (w >> 2);
    qrow0 = NLAT + b * CTXL + half * 128 + (w & 3) * 32; qcol = GQ + head * 64; ocol = 512 + head * 64;
    kcol = GK + kvh * 64; vcol = GV + kvh * 64;
  } else {
    b = idx >> 2; hN = idx & 3;
    qrow0 = NLAT + b * CTXL + w * 32; qcol = NQ + hN * 64; ocol = 768 + hN * 64;
    kcol = NK + hN * 64; vcol = NV + hN * 64;
  }
  const int ntiles = 4 + nlat;
  const u16* Z = p.z;
  if (kind == 1) {
    for (int i = tid; i < 15 * 32; i += NTHR) {
      const int rr = i >> 5, cc = i & 31;
      rpbs[i] = (cc < 31) ? p.rpb[((size_t)(layer * 4 + hN) * 15 + rr) * 31 + cc] : 0.f;
    }
  }
  bf16x8 qf[4];
#pragma unroll
  for (int st = 0; st < 4; ++st) qf[st] = *(const bf16x8*)(Z + (size_t)(qrow0 + tq) * ZW + qcol + 16 * st + 8 * hh);
  const int qc = (w & 1) * 32 + tq;
  const int cs = min(max(qc - 8, 0), 48);
  float mrun = -1e30f, lsum = 0.f;
  f32x16 O[2];
#pragma unroll
  for (int i = 0; i < 16; ++i) { O[0][i] = 0.f; O[1][i] = 0.f; }
  const int lkey = tid >> 3, lc = tid & 7;
  auto tile_row0 = [&](int i) { return (i < 4) ? (NLAT + b * CTXL + i * 64) : (lat0 + (i - 4) * 64); };
  u32x4 kreg, vreg;
  {
    const size_t ro = (size_t)(tile_row0(0) + lkey) * ZW;
    kreg = *(const u32x4*)(Z + ro + kcol + lc * 8);
    vreg = *(const u32x4*)(Z + ro + vcol + lc * 8);
  }
  for (int i = 0; i < ntiles; ++i) {
    u16* Kb = Ks + (i & 1) * 64 * KS_STRIDE;
    u16* Vb = Vt + (i & 1) * 64 * VT_STRIDE;
    *(u32x4*)(Kb + lkey * KS_STRIDE + lc * 8) = kreg;
#pragma unroll
    for (int j = 0; j < 4; ++j) {
      Vb[(lc * 8 + 2 * j) * VT_STRIDE + lkey] = (u16)(vreg[j] & 0xffffu);
      Vb[(lc * 8 + 2 * j + 1) * VT_STRIDE + lkey] = (u16)(vreg[j] >> 16);
    }
    __syncthreads();
    if (i + 1 < ntiles) {
      const size_t ro = (size_t)(tile_row0(i + 1) + lkey) * ZW;
      kreg = *(const u32x4*)(Z + ro + kcol + lc * 8);
      vreg = *(const u32x4*)(Z + ro + vcol + lc * 8);
    }
    bool active = true;
    int kr = 0;
    if (kind == 1 && i >= 4) {
      kr = R0 + i - 4;
      active = (kr >= r0w) && (kr < r0w + 8);
    }
    if (active) {
      f32x16 s[2];
#pragma unroll
      for (int kb = 0; kb < 2; ++kb) {
#pragma unroll
        for (int e = 0; e < 16; ++e) s[kb][e] = 0.f;
#pragma unroll
        for (int st = 0; st < 4; ++st) {
          const bf16x8 a = ld_frag16(Kb + (kb * 32 + tq) * KS_STRIDE + 16 * st + 8 * hh);
          s[kb] = mfma32(a, qf[st], s[kb]);
        }
      }
      if (kind == 1 && i >= 4) {
        const int rowoff = (kr - r + 7) * 32;
#pragma unroll
        for (int kb = 0; kb < 2; ++kb)
#pragma unroll
          for (int e = 0; e < 16; ++e) {
            const int kc = kb * 32 + (e & 3) + 8 * (e >> 2) + 4 * hh;
            const bool valid = (kc >= cs) && (kc < cs + 16);
            const int dc = min(max(kc - qc + 15, 0), 30);
            const float bias = rpbs[rowoff + dc];
            s[kb][e] = valid ? s[kb][e] + bias : -1e30f;
          }
      }
      float mx = -1e30f;
#pragma unroll
      for (int kb = 0; kb < 2; ++kb)
#pragma unroll
        for (int e = 0; e < 16; ++e) mx = fmaxf(mx, s[kb][e]);
      mx = fmaxf(mx, __shfl_xor(mx, 32));
      const float mnew = fmaxf(mrun, mx);
      const float alpha = __builtin_amdgcn_exp2f((mrun - mnew) * L2E);
      mrun = mnew;
      float ps = 0.f;
      const float mb = mnew * L2E;
#pragma unroll
      for (int kb = 0; kb < 2; ++kb)
#pragma unroll
        for (int e = 0; e < 16; ++e) {
          const float pv = __builtin_amdgcn_exp2f(s[kb][e] * L2E - mb);
          s[kb][e] = pv;
          ps += pv;
        }
      lsum = lsum * alpha + ps;
#pragma unroll
      for (int e = 0; e < 16; ++e) { O[0][e] *= alpha; O[1][e] *= alpha; }
#pragma unroll
      for (int kb = 0; kb < 2; ++kb)
#pragma unroll
        for (int st = 0; st < 2; ++st) {
          u32x4 pp;
#pragma unroll
          for (int j = 0; j < 4; ++j) pp[j] = pk_bf16(s[kb][8 * st + 2 * j], s[kb][8 * st + 2 * j + 1]);
          const bf16x8 pf = as_bf16x8(pp);
#pragma unroll
          for (int db = 0; db < 2; ++db) {
            const u16* vrow = Vb + (db * 32 + tq) * VT_STRIDE + kb * 32 + 16 * st + 4 * hh;
            const bf16x8 a = ld_frag4x4(vrow, vrow + 8);
            O[db] = mfma32(a, pf, O[db]);
          }
        }
    }
  }
  lsum += __shfl_xor(lsum, 32);
  const float inv = 1.f / lsum;
  u16* dst = p.xn + (size_t)(qrow0 + tq) * DM + ocol;
#pragma unroll
  for (int db = 0; db < 2; ++db)
#pragma unroll
    for (int g4 = 0; g4 < 4; ++g4) {
      u32x2 o;
      o[0] = pk_bf16(O[db][4 * g4 + 0] * inv, O[db][4 * g4 + 1] * inv);
      o[1] = pk_bf16(O[db][4 * g4 + 2] * inv, O[db][4 * g4 + 3] * inv);
      *(u32x2*)(dst + db * 32 + 8 * g4 + 4 * hh) = o;
    }
  __syncthreads();
}

__device__ void hgrn_chain(const Params& p, int layer, int idx, char* smem) {
  const int b = idx >> 3, h = (idx >> 1) & 3, dir = idx & 1;
  u16* Qs = (u16*)smem;
  u16* VT = (u16*)(smem + 9216);
  float* bb = (float*)(smem + 17664);
  float* kkf = (float*)(smem + 34304);
  u16* KdT = (u16*)(smem + 50944);
  u16* ST = (u16*)(smem + 59392);
  float* tot = (float*)(smem + 68608);
  float* bend = (float*)(smem + 70656);
  const int tid = opaque_tid(), lane = tid & 63, w = __builtin_amdgcn_readfirstlane(tid >> 6), c = lane & 15, g = lane >> 4;
  const int d_ = tid & 63, part = w;
  const int lrow = tid >> 3, c8 = tid & 7;
  float lb = 0.f;
  if (layer == 1) {
    const float l0 = p.lb_logits[(0 * 2 + dir) * 256 + h * 64 + d_], l1 = p.lb_logits[(1 * 2 + dir) * 256 + h * 64 + d_];
    lb = 1.f / (1.f + __expf(l0 - l1));
  }
  const int fcol = (dir ? HFB : HFF) + h * 64;
  const u16* Z = p.z;
  u16* ob = p.obuf + (size_t)(0 * 2 + dir) * NTOK * 256;
  f32x4 cst[2];
  cst[0] = (f32x4){0.f, 0.f, 0.f, 0.f};
  cst[1] = cst[0];
  for (int i = tid; i < 64 * 72; i += NTHR) ST[i] = 0;
  auto chunk_base = [&](int i) {
    if (i < 4) { const int cc = dir ? 3 - i : i; return NLAT + b * CTXL + cc * 64; }
    const int cc = dir ? 31 - (i - 4) : (i - 4);
    return b * SEQ + cc * 64;
  };
  u32x4 nq, nv;
  u16 nf[8];
  {
    const int base = chunk_base(0);
    const size_t ro = (size_t)(base + (dir ? 63 - lrow : lrow)) * ZW;
    nq = *(const u32x4*)(Z + ro + HQ + h * 64 + c8 * 8);
    nv = *(const u32x4*)(Z + ro + HI_ + h * 64 + c8 * 8);
#pragma unroll
    for (int e = 0; e < 8; ++e) {
      const int t = part * 8 + e;
      nf[e] = Z[(size_t)(base + (dir ? 63 - t : t)) * ZW + fcol + d_];
    }
  }
  __syncthreads();
  for (int i = 0; i < 36; ++i) {
    const int base = chunk_base(i);
    *(u32x4*)(Qs + lrow * 72 + c8 * 8) = nq;
#pragma unroll
    for (int j = 0; j < 4; ++j) {
      VT[(c8 * 8 + 2 * j) * 66 + lrow] = (u16)(nv[j] & 0xffffu);
      VT[(c8 * 8 + 2 * j + 1) * 66 + lrow] = (u16)(nv[j] >> 16);
    }
    float cl[8], kf[8];
    {
      float cum = 0.f;
#pragma unroll
      for (int e = 0; e < 8; ++e) {
        const float f = bf2f(nf[e]);
        const float ef = __expf(-f);
        const float sig = 1.f / (1.f + ef);
        const float forget = lb + (1.f - lb) * sig;
        cum += __logf(fmaxf(forget, 1e-20f));
        cl[e] = cum;
        kf[e] = (1.f - lb) * (ef / (1.f + ef));
      }
      tot[part * 64 + d_] = cum;
    }
    __syncthreads();
    {
      float off = 0.f, bendv = 0.f;
#pragma unroll
      for (int q = 0; q < 8; ++q) {
        const float tv = tot[q * 64 + d_];
        bendv += tv;
        if (q < part) off += tv;
      }
      float kd[8];
#pragma unroll
      for (int e = 0; e < 8; ++e) {
        const int t = part * 8 + e;
        const float bv = off + cl[e];
        bb[t * 65 + d_] = bv;
        kkf[t * 65 + d_] = kf[e];
        kd[e] = kf[e] * __expf(bendv - bv);
      }
      unsigned* kdp = (unsigned*)(KdT + d_ * 66 + part * 8);
#pragma unroll
      for (int j = 0; j < 4; ++j) kdp[j] = pk_bf16(kd[2 * j], kd[2 * j + 1]);
      if (part == 0) bend[d_] = bendv;
    }
    if (i + 1 < 36) {
      const int nb = chunk_base(i + 1);
      const size_t ro = (size_t)(nb + (dir ? 63 - lrow : lrow)) * ZW;
      nq = *(const u32x4*)(Z + ro + HQ + h * 64 + c8 * 8);
      nv = *(const u32x4*)(Z + ro + HI_ + h * 64 + c8 * 8);
#pragma unroll
      for (int e = 0; e < 8; ++e) {
        const int t = part * 8 + e;
        nf[e] = Z[(size_t)(nb + (dir ? 63 - t : t)) * ZW + fcol + d_];
      }
    }
    __syncthreads();
    {
      const int tb = w & 3, vh = w >> 2;
      const int t = tb * 16 + c;
      bf16x8 qt[2], qe[2];
      float rref[2][8];
#pragma unroll
      for (int kk = 0; kk < 2; ++kk) {
        const u32x4 qraw = *(const u32x4*)(Qs + t * 72 + 32 * kk + 8 * g);
        u32x4 a, e2;
#pragma unroll
        for (int j = 0; j < 4; ++j) {
          const int d0 = 32 * kk + 8 * g + 2 * j;
          const float r0 = tb ? bb[(16 * tb - 1) * 65 + d0] : 0.f, r1 = tb ? bb[(16 * tb - 1) * 65 + d0 + 1] : 0.f;
          rref[kk][2 * j] = r0;
          rref[kk][2 * j + 1] = r1;
          const float b0 = bb[t * 65 + d0], b1 = bb[t * 65 + d0 + 1];
          const float q0 = bf_lo(qraw[j]), q1 = bf_hi(qraw[j]);
          a[j] = pk_bf16(q0 * __expf(b0 - r0), q1 * __expf(b1 - r1));
          e2[j] = pk_bf16(q0 * __expf(b0), q1 * __expf(b1));
        }
        qt[kk] = as_bf16x8(a);
        qe[kk] = as_bf16x8(e2);
      }
      unsigned pp[4][2];
#pragma unroll
      for (int st = 0; st < 4; ++st) {
        f32x4 sacc = (f32x4){0.f, 0.f, 0.f, 0.f};
        if (st <= tb) {
          const int s = st * 16 + c;
#pragma unroll
          for (int kk = 0; kk < 2; ++kk) {
            u32x4 a;
#pragma unroll
            for (int j = 0; j < 4; ++j) {
              const int d0 = 32 * kk + 8 * g + 2 * j;
              const float k0 = kkf[s * 65 + d0], k1 = kkf[s * 65 + d0 + 1];
              const float b0 = bb[s * 65 + d0], b1 = bb[s * 65 + d0 + 1];
              a[j] = pk_bf16(k0 * __expf(rref[kk][2 * j] - b0), k1 * __expf(rref[kk][2 * j + 1] - b1));
            }
            sacc = mfma16(as_bf16x8(a), qt[kk], sacc);
          }
          if (st == tb) {
#pragma unroll
            for (int rg = 0; rg < 4; ++rg)
              if (4 * g + rg > c) sacc[rg] = 0.f;
          }
        }
        pp[st][0] = pk_bf16(sacc[0], sacc[1]);
        pp[st][1] = pk_bf16(sacc[2], sacc[3]);
      }
      bf16x8 pf[2];
#pragma unroll
      for (int kk = 0; kk < 2; ++kk) {
        u32x4 a;
        a[0] = pp[2 * kk][0]; a[1] = pp[2 * kk][1]; a[2] = pp[2 * kk + 1][0]; a[3] = pp[2 * kk + 1][1];
        pf[kk] = as_bf16x8(a);
      }
      const int tok = base + (dir ? 63 - t : t);
#pragma unroll
      for (int vi = 0; vi < 2; ++vi) {
        const int vt = vh * 2 + vi;
        f32x4 o = (f32x4){0.f, 0.f, 0.f, 0.f};
#pragma unroll
        for (int kk = 0; kk < 2; ++kk) {
          const bf16x8 a = ld_frag16(ST + (vt * 16 + c) * 72 + 32 * kk + 8 * g);
          o = mfma16(a, qe[kk], o);
          const u16* vrow = VT + (vt * 16 + c) * 66 + 32 * kk + 4 * g;
          const bf16x8 a2 = ld_frag4x4(vrow, vrow + 16);
          o = mfma16(a2, pf[kk], o);
        }
        u32x2 ov;
        ov[0] = pk_bf16(o[0], o[1]);
        ov[1] = pk_bf16(o[2], o[3]);
        *(u32x2*)(ob + (size_t)tok * 256 + h * 64 + vt * 16 + 4 * g) = ov;
      }
    }
    __syncthreads();
    {
      const int vt = w >> 1, dh = w & 1;
#pragma unroll
      for (int i2 = 0; i2 < 2; ++i2) {
        const int dt = 2 * dh + i2, dcol = dt * 16 + c;
        const float dec = __expf(bend[dcol]);
        f32x4 a4 = cst[i2] * dec;
#pragma unroll
        for (int kk = 0; kk < 2; ++kk) {
          const u16* ar = VT + (vt * 16 + c) * 66 + 32 * kk + 8 * g;
          const u16* br = KdT + (dt * 16 + c) * 66 + 32 * kk + 8 * g;
          a4 = mfma16(ld_frag4x4(ar, ar + 4), ld_frag4x4(br, br + 4), a4);
        }
        cst[i2] = a4;
#pragma unroll
        for (int rg = 0; rg < 4; ++rg) ST[(vt * 16 + 4 * g + rg) * 72 + dcol] = f2bf(a4[rg]);
      }
    }
    __syncthreads();
  }
}

__device__ void mlstm_chain(const Params& p, int layer, int idx, char* smem) {
  const int b = idx >> 3, h = (idx >> 1) & 3, dir = idx & 1;
  u16* Qs = (u16*)smem;
  u16* Ksm = (u16*)(smem + 9216);
  u16* VT = (u16*)(smem + 18432);
  u16* KTw = (u16*)(smem + 26880);
  u16* CT = (u16*)(smem + 35328);
  float* nvv = (float*)(smem + 44544);
  float* us = (float*)(smem + 44800);
  float* Ms = (float*)(smem + 45056);
  float* bs = (float*)(smem + 45312);
  float* scl = (float*)(smem + 45568);
  const int tid = opaque_tid(), lane = tid & 63, w = __builtin_amdgcn_readfirstlane(tid >> 6), c = lane & 15, g = lane >> 4;
  const int lrow = tid >> 3, c8 = tid & 7;
  const u16* Z = p.z;
  u16* ob = p.obuf + (size_t)(2 + dir) * NTOK * 256;
  f32x4 cst[2];
  cst[0] = (f32x4){0.f, 0.f, 0.f, 0.f};
  cst[1] = cst[0];
  for (int i = tid; i < 64 * 72; i += NTHR) CT[i] = 0;
  if (tid < 64) nvv[tid] = 0.f;
  float mprev = 0.f;
  auto chunk_base = [&](int i) {
    if (i < 4) { const int cc = dir ? 3 - i : i; return NLAT + b * CTXL + cc * 64; }
    const int cc = dir ? 31 - (i - 4) : (i - 4);
    return b * SEQ + cc * 64;
  };
  u32x4 nq, nk, nv;
  float nig = 0.f, nfg = 0.f;
  {
    const int base = chunk_base(0);
    const size_t ro = (size_t)(base + (dir ? 63 - lrow : lrow)) * ZW;
    nq = *(const u32x4*)(Z + ro + MQ + h * 64 + c8 * 8);
    nk = *(const u32x4*)(Z + ro + MK + h * 64 + c8 * 8);
    nv = *(const u32x4*)(Z + ro + MV + h * 64 + c8 * 8);
    if (w == 0) {
      const size_t tg = (size_t)(base + (dir ? 63 - lane : lane)) * 16;
      nig = p.gates[tg + dir * 4 + h];
      nfg = p.gates[tg + 8 + dir * 4 + h];
    }
  }
  __syncthreads();
  for (int i = 0; i < 36; ++i) {
    const int base = chunk_base(i);
    *(u32x4*)(Qs + lrow * 72 + c8 * 8) = nq;
    *(u32x4*)(Ksm + lrow * 72 + c8 * 8) = nk;
#pragma unroll
    for (int j = 0; j < 4; ++j) {
      VT[(c8 * 8 + 2 * j) * 66 + lrow] = (u16)(nv[j] & 0xffffu);
      VT[(c8 * 8 + 2 * j + 1) * 66 + lrow] = (u16)(nv[j] >> 16);
    }
    const u32x4 kcur = nk;
    if (w == 0) {
      const float fg = nfg, ig = nig;
      const float lf = fminf(fg, 0.f) - __logf(1.f + __expf(-fabsf(fg)));
      float bc = lf;
#pragma unroll
      for (int o = 1; o < 64; o <<= 1) {
        const float t = __shfl_up(bc, o);
        if (lane >= o) bc += t;
      }
      const float u = ig - bc;
      float cm = u;
#pragma unroll
      for (int o = 1; o < 64; o <<= 1) {
        const float t = __shfl_up(cm, o);
        if (lane >= o) cm = fmaxf(cm, t);
      }
      const float M = fmaxf(mprev, cm);
      us[lane] = u;
      Ms[lane] = M;
      bs[lane] = bc;
      if (lane == 63) {
        scl[0] = __expf(mprev - M);
        scl[1] = bc + M;
      }
    }
    __syncthreads();
    if (i + 1 < 36) {
      const int nb = chunk_base(i + 1);
      const size_t ro = (size_t)(nb + (dir ? 63 - lrow : lrow)) * ZW;
      nq = *(const u32x4*)(Z + ro + MQ + h * 64 + c8 * 8);
      nk = *(const u32x4*)(Z + ro + MK + h * 64 + c8 * 8);
      nv = *(const u32x4*)(Z + ro + MV + h * 64 + c8 * 8);
      if (w == 0) {
        const size_t tg = (size_t)(nb + (dir ? 63 - lane : lane)) * 16;
        nig = p.gates[tg + dir * 4 + h];
        nfg = p.gates[tg + 8 + dir * 4 + h];
      }
    }
    const float Mend = Ms[63];
    {
      const float ws = __expf(us[lrow] - Mend);
#pragma unroll
      for (int j = 0; j < 4; ++j) {
        KTw[(c8 * 8 + 2 * j) * 66 + lrow] = f2bf(bf_lo(kcur[j]) * ws);
        KTw[(c8 * 8 + 2 * j + 1) * 66 + lrow] = f2bf(bf_hi(kcur[j]) * ws);
      }
    }
    {
      const int tb = w & 3, vh = w >> 2;
      const int t = tb * 16 + c;
      const float Mt = Ms[t];
      const float win = __expf(mprev - Mt);
      bf16x8 qf[2];
#pragma unroll
      for (int kk = 0; kk < 2; ++kk) qf[kk] = ld_frag16(Qs + t * 72 + 32 * kk + 8 * g);
      float psum = 0.f;
      unsigned pp[4][2];
#pragma unroll
      for (int st = 0; st < 4; ++st) {
        f32x4 sacc = (f32x4){0.f, 0.f, 0.f, 0.f};
        if (st <= tb) {
#pragma unroll
          for (int kk = 0; kk < 2; ++kk) sacc = mfma16(ld_frag16(Ksm + (st * 16 + c) * 72 + 32 * kk + 8 * g), qf[kk], sacc);
#pragma unroll
          for (int rg = 0; rg < 4; ++rg) {
            const int s = st * 16 + 4 * g + rg;
            const float dv = (s <= t) ? __expf(us[s] - Mt) : 0.f;
            sacc[rg] *= dv;
            psum += sacc[rg];
          }
        }
        pp[st][0] = pk_bf16(sacc[0], sacc[1]);
        pp[st][1] = pk_bf16(sacc[2], sacc[3]);
      }
      psum += __shfl_xor(psum, 16);
      psum += __shfl_xor(psum, 32);
      float qn = 0.f;
      {
        const u32x4 q0 = *(const u32x4*)(Qs + t * 72 + 16 * g), q1 = *(const u32x4*)(Qs + t * 72 + 16 * g + 8);
#pragma unroll
        for (int j = 0; j < 4; ++j) {
          qn += bf_lo(q0[j]) * nvv[16 * g + 2 * j] + bf_hi(q0[j]) * nvv[16 * g + 2 * j + 1];
          qn += bf_lo(q1[j]) * nvv[16 * g + 8 + 2 * j] + bf_hi(q1[j]) * nvv[16 * g + 8 + 2 * j + 1];
        }
      }
      qn += __shfl_xor(qn, 16);
      qn += __shfl_xor(qn, 32);
      const float den = win * qn + psum;
      const float mt = bs[t] + Mt;
      const float hs = 1.f / fmaxf(fabsf(den), __expf(-mt));
      bf16x8 pf[2];
#pragma unroll
      for (int kk = 0; kk < 2; ++kk) {
        u32x4 a;
        a[0] = pp[2 * kk][0]; a[1] = pp[2 * kk][1]; a[2] = pp[2 * kk + 1][0]; a[3] = pp[2 * kk + 1][1];
        pf[kk] = as_bf16x8(a);
      }
      const int tok = base + (dir ? 63 - t : t);
#pragma unroll
      for (int vi = 0; vi < 2; ++vi) {
        const int vt = vh * 2 + vi;
        f32x4 o = (f32x4){0.f, 0.f, 0.f, 0.f};
#pragma unroll
        for (int kk = 0; kk < 2; ++kk) o = mfma16(ld_frag16(CT + (vt * 16 + c) * 72 + 32 * kk + 8 * g), qf[kk], o);
        o = o * win;
#pragma unroll
        for (int kk = 0; kk < 2; ++kk) {
          const u16* vrow = VT + (vt * 16 + c) * 66 + 32 * kk + 4 * g;
          o = mfma16(ld_frag4x4(vrow, vrow + 16), pf[kk], o);
        }
        o = o * hs;
        u32x2 ov;
        ov[0] = pk_bf16(o[0], o[1]);
        ov[1] = pk_bf16(o[2], o[3]);
        *(u32x2*)(ob + (size_t)tok * 256 + h * 64 + vt * 16 + 4 * g) = ov;
      }
    }
    __syncthreads();
    {
      const float wold = scl[0];
      const float mnew = scl[1];
      const int vt = w >> 1, dh = w & 1;
#pragma unroll
      for (int i2 = 0; i2 < 2; ++i2) {
        const int dt = 2 * dh + i2, dcol = dt * 16 + c;
        f32x4 a4 = cst[i2] * wold;
#pragma unroll
        for (int kk = 0; kk < 2; ++kk) {
          const u16* ar = VT + (vt * 16 + c) * 66 + 32 * kk + 8 * g;
          const u16* br = KTw + (dt * 16 + c) * 66 + 32 * kk + 8 * g;
          a4 = mfma16(ld_frag4x4(ar, ar + 4), ld_frag4x4(br, br + 4), a4);
        }
        cst[i2] = a4;
#pragma unroll
        for (int rg = 0; rg < 4; ++rg) CT[(vt * 16 + 4 * g + rg) * 72 + dcol] = f2bf(a4[rg]);
      }
      {
        const int dn = tid >> 3, p8 = tid & 7;
        const unsigned* kr = (const unsigned*)(KTw + dn * 66 + p8 * 8);
        float s = 0.f;
#pragma unroll
        for (int j = 0; j < 4; ++j) s += bf_lo(kr[j]) + bf_hi(kr[j]);
        s += __shfl_xor(s, 1);
        s += __shfl_xor(s, 2);
        s += __shfl_xor(s, 4);
        if (p8 == 0) nvv[dn] = wold * nvv[dn] + s;
      }
      mprev = mnew;
    }
    __syncthreads();
  }
}

__device__ void mixer_phase(const Params& p, int layer, char* smem) {
  const int njobs = 256 + 512 + 512 + (layer == 0 ? 128 : 0);
  for (int job = blockIdx.x; job < njobs; job += gridDim.x) {
    if (job < 128) hgrn_chain(p, layer, job, smem);
    else if (job < 256) mlstm_chain(p, layer, job - 128, smem);
    else if (job < 768) attn_job(p, layer, 0, job - 256, smem);
    else if (job < 1280) attn_job(p, layer, 1, job - 768, smem);
    else if (job < 1344) attn_job(p, layer, 2, job - 1280, smem);
    else attn_job(p, layer, 3, job - 1344, smem);
    __syncthreads();
  }
}

__device__ void combine_phase(const Params& p, int layer, int nrows) {
  const int tid_ = opaque_tid();
  const int lane = tid_ & 63, wid = tid_ >> 6;
  const int mixer = lane >> 5;
  const int col = (lane & 31) * 8;
  const float* gsrc = (mixer == 0 ? p.hgrn_g : p.mlstm_g) + layer * 64 + (col & 63);
  float gv[8];
#pragma unroll
  for (int j = 0; j < 8; ++j) gv[j] = gsrc[j];
  for (int row = blockIdx.x * 8 + wid; row < nrows; row += gridDim.x * 8) {
    const u32x4 a = *(const u32x4*)(p.obuf + ((size_t)(mixer * 2 + 0) * NTOK + row) * 256 + col);
    const u32x4 bq = *(const u32x4*)(p.obuf + ((size_t)(mixer * 2 + 1) * NTOK + row) * 256 + col);
    const u32x4 gz = *(const u32x4*)(p.z + (size_t)row * ZW + (mixer == 0 ? HG : MO) + col);
    float o[8];
    float ss = 0.f;
#pragma unroll
    for (int j = 0; j < 4; ++j) {
      o[2 * j] = bf_lo(a[j]) + bf_lo(bq[j]);
      o[2 * j + 1] = bf_hi(a[j]) + bf_hi(bq[j]);
      ss += o[2 * j] * o[2 * j] + o[2 * j + 1] * o[2 * j + 1];
    }
    ss += __shfl_xor(ss, 1);
    ss += __shfl_xor(ss, 2);
    ss += __shfl_xor(ss, 4);
    const float rs = __builtin_amdgcn_rsqf(ss * (1.f / 64.f) + EPSN);
    u32x4 outv;
#pragma unroll
    for (int j = 0; j < 4; ++j) {
      const float z0 = bf_lo(gz[j]), z1 = bf_hi(gz[j]);
      const float g0 = mixer == 0 ? siluf(z0) : sigmf(z0), g1 = mixer == 0 ? siluf(z1) : sigmf(z1);
      outv[j] = pk_bf16(o[2 * j] * rs * gv[2 * j] * g0, o[2 * j + 1] * rs * gv[2 * j + 1] * g1);
    }
    *(u32x4*)(p.xn + (size_t)row * DM + mixer * 256 + col) = outv;
  }
}

__global__ void __launch_bounds__(NTHR) fwd_megakernel(Params p) {
  extern __shared__ __attribute__((aligned(16))) char smem_raw[];
  cg::grid_group grid = cg::this_grid();
  int ph = 0;
#define SEAM() do { if (++ph >= PHASE_LIMIT) return; grid.sync(); } while (0)
  prologue_phase(p, smem_raw);
  SEAM();
  for (int l = 0; l < 2; ++l) {
    const int nMr = (l == 0) ? 144 : 128;
    const int nrows2 = (l == 0) ? NTOK : NLAT;
    norm_phase(p, l, 0, NTOK);
    SEAM();
    gemm_phase<EPI_IN, 1024>(p, l, p.xn, p.WinT + (size_t)l * ZW * DM, 144, 14);
    SEAM();
    mixer_phase(p, l, smem_raw);
    SEAM();
    combine_phase(p, l, nrows2);
    SEAM();
    gemm_phase<EPI_OUT, 1024>(p, l, p.xn, p.WoutT + (size_t)l * DM * DM, nMr, 4);
    SEAM();
    norm_phase(p, l, 1, nrows2);
    SEAM();
    gemm_phase<EPI_MLP1, 1024>(p, l, p.xn, p.W1T + (size_t)l * HID * DM, nMr, 16);
    SEAM();
    gemm_phase<EPI_MLP2, 4096>(p, l, p.hid, p.W2T + (size_t)l * DM * HID, nMr, 4);
    SEAM();
  }
  final_norm_phase(p);
}

extern "C" void kernel_launch(void* const* d_in, const int* in_sizes, int n_in, void* d_out, int out_size, void* d_ws,
                              size_t ws_size, hipStream_t stream) {
  static int grid_blocks = 0;
  if (!grid_blocks) {
    hipFuncSetAttribute((const void*)fwd_megakernel, hipFuncAttributeMaxDynamicSharedMemorySize, LDS_BYTES);
    int dev = 0, cus = 0, per_cu = 0;
    hipGetDevice(&dev);
    hipDeviceGetAttribute(&cus, hipDeviceAttributeMultiprocessorCount, dev);
    hipOccupancyMaxActiveBlocksPerMultiprocessor(&per_cu, fwd_megakernel, NTHR, LDS_BYTES);
    if (per_cu < 1) per_cu = 1;
    if (per_cu > 1) per_cu = 1;
    grid_blocks = cus * per_cu;
  }
  Params p{};
  const float* const* in = (const float* const*)d_in;
  p.x = in[0]; p.c = in[1]; p.ctx = in[2]; p.c_ctx = in[3]; p.w_mod = in[4]; p.b_mod = in[5]; p.g1 = in[6]; p.g2 = in[7];
  p.w_in = in[8]; p.lb_logits = in[9]; p.hgrn_g = in[10]; p.mlstm_b = in[11]; p.mlstm_g = in[12]; p.qn_g = in[13];
  p.kn_g = in[14]; p.rpb = in[15]; p.w_out = in[16]; p.w1 = in[17]; p.w2 = in[18]; p.final_g = in[19];
  p.out = (float*)d_out;
  char* ws = (char*)d_ws;
  size_t off = 0;
  auto take = [&](size_t bytes) { char* r = ws + off; off += (bytes + 255) & ~(size_t)255; return r; };
  p.WinT = (u16*)take((size_t)2 * ZW * DM * 2);
  p.WoutT = (u16*)take((size_t)2 * DM * DM * 2);
  p.W1T = (u16*)take((size_t)2 * HID * DM * 2);
  p.W2T = (u16*)take((size_t)2 * DM * HID * 2);
  p.wg = (float*)take((size_t)2 * 16 * DM * 4);
  p.modv = (float*)take((size_t)2 * 17 * 6 * DM * 4);
  p.ropec = (float*)take((size_t)SEQ * 32 * 4);
  p.ropes = (float*)take((size_t)SEQ * 32 * 4);
  p.gates = (float*)take((size_t)NTOK * 16 * 4);
  p.xcw = (float*)take((size_t)NBATCH * CTXL * DM * 4);
  p.xn = (u16*)take((size_t)NTOK * DM * 2);
  p.z = (u16*)take((size_t)NTOK * ZW * 2);
  p.obuf = (u16*)take((size_t)4 * NTOK * 256 * 2);
  p.hid = p.z;
  if (off > ws_size) fprintf(stderr, "workspace too small: need %zu have %zu\n", off, ws_size);
  void* args[] = {&p};
  hipError_t e = hipLaunchCooperativeKernel((const void*)fwd_megakernel, dim3(grid_blocks), dim3(NTHR), args, LDS_BYTES, stream);
  if (e != hipSuccess) fprintf(stderr, "cooperative launch failed: %s (grid %d)\n", hipGetErrorString(e), grid_blocks);
}
```

```cpp
#include <hip/hip_runtime.h>
#include <hip/hip_cooperative_groups.h>
#include <cstdio>
#include <cstdint>
namespace cg = cooperative_groups;

typedef unsigned short u16;
typedef short bf16x8 __attribute__((ext_vector_type(8)));
typedef float f32x4 __attribute__((ext_vector_type(4)));
typedef float f32x16 __attribute__((ext_vector_type(16)));
typedef unsigned u32x4 __attribute__((ext_vector_type(4)));
typedef unsigned u32x2 __attribute__((ext_vector_type(2)));
#define DI __device__ __forceinline__

#ifndef PHASE_LIMIT
#define PHASE_LIMIT 1000
#endif
#define REP_MIXER 1
#define REP_GIN 1
#define REP_MLP1 1
#define REP_PROL 1
#define REP_NORM 1
#define REP_COMB 1
#define REP_CHAIN 1
#define REP_ATT 1
#define EXTRA_SYNC 0

constexpr int DM = 1024, NBATCH = 16, SEQ = 2048, CTXL = 256;
constexpr int NLAT = NBATCH * SEQ;
constexpr int NTOK = NLAT + NBATCH * CTXL;
constexpr int ZW = 3584;
constexpr int INW = 3600;
constexpr int HID = 4096;
constexpr int HQ = 0, HI_ = 256, HG = 512, HFF = 768, HFB = 1024, MQ = 1280, MK = 1536, MV = 1792, MO = 2048,
              GQ = 2304, GK = 2560, GV = 2688, NQ = 2816, NK = 3072, NV = 3328;
constexpr float EPSN = 1e-6f;
constexpr float L2E = 1.4426950408889634f;
constexpr int NTHR = 512;
constexpr int LDS_BYTES = 131072 + 8192 + 16;
constexpr int XCH_OFF = 131072, ST_OFF = 131072 + 8192;

struct Params {
  const float *x, *c, *ctx, *c_ctx, *w_mod, *b_mod, *g1, *g2, *w_in, *lb_logits, *hgrn_g, *mlstm_b, *mlstm_g,
      *qn_g, *kn_g, *rpb, *w_out, *w1, *w2, *final_g;
  float* out;
  u16 *WinT, *WoutT, *W1T, *W2T;
  float *wg, *modv, *ropec, *ropes, *gates, *xcw;
  u16 *xn, *z, *obuf, *hid;
  unsigned* bar;
};

DI unsigned pk_bf16(float a, float b) {
  typedef __bf16 bf2 __attribute__((ext_vector_type(2)));
  typedef float f2 __attribute__((ext_vector_type(2)));
  f2 v = {a, b};
  bf2 r = __builtin_convertvector(v, bf2);
  return __builtin_bit_cast(unsigned, r);
}
DI u16 f2bf(float a) { return (u16)(pk_bf16(a, 0.f) & 0xffffu); }
DI float bf_lo(unsigned u) { return __uint_as_float(u << 16); }
DI float bf_hi(unsigned u) { return __uint_as_float(u & 0xffff0000u); }
DI float bf2f(u16 h) { return __uint_as_float(((unsigned)h) << 16); }
DI f32x16 mfma32(bf16x8 a, bf16x8 b, f32x16 c) { return __builtin_amdgcn_mfma_f32_32x32x16_bf16(a, b, c, 0, 0, 0); }
DI f32x4 mfma16(bf16x8 a, bf16x8 b, f32x4 c) { return __builtin_amdgcn_mfma_f32_16x16x32_bf16(a, b, c, 0, 0, 0); }
DI bf16x8 as_bf16x8(u32x4 v) { return __builtin_bit_cast(bf16x8, v); }
DI float wave_sum(float v) {
#pragma unroll
  for (int o = 32; o > 0; o >>= 1) v += __shfl_xor(v, o);
  return v;
}
DI int opaque_tid() { int t = threadIdx.x; asm volatile("" : "+v"(t)); return t; }
DI float fexp(float x) { return __builtin_amdgcn_exp2f(x * L2E); }
DI float siluf(float x) { return x / (1.f + __expf(-x)); }
DI float sigmf(float x) { return 1.f / (1.f + __expf(-x)); }

#define XB_TMO      128
#define XB_XCNT(j)  (256  + 64 * (j))
#define XB_XSUB(j)  (1280 + 64 * (j))
#define XB_XGEN(j)  (2304 + 64 * (j))
#define XB_TOP      3328
#define XB_TOPGEN   3392
#define XCD_BAR_WORDS 3456
#define XB_SPIN_CAP (1u << 20)
#define LAS __attribute__((address_space(3)))
DI unsigned xb_ld(unsigned* p) { return __hip_atomic_load(p, __ATOMIC_RELAXED, __HIP_MEMORY_SCOPE_AGENT); }
DI unsigned xb_add(unsigned* p, unsigned v) { return __hip_atomic_fetch_add(p, v, __ATOMIC_RELAXED, __HIP_MEMORY_SCOPE_AGENT); }
DI unsigned xb_xcc_id() { return (unsigned)__builtin_amdgcn_s_getreg((3 << 11) | 20) & 0xFu; }
#define XB_SPIN(cond, bar) do { unsigned _sp = 0; while (cond) { __builtin_amdgcn_s_sleep(1); \
    if ((++_sp & 255u) == 0u) { if (xb_ld(&(bar)[XB_TMO])) break; if (_sp > XB_SPIN_CAP) { atomicAdd(&(bar)[XB_TMO], 1u); break; } } } } while (0)
struct XcdBarrier { unsigned* bar; unsigned x; volatile LAS unsigned* st; };
DI XcdBarrier xcd_barrier_post(unsigned* bar, volatile LAS unsigned* st) {
  XcdBarrier b; b.bar = bar; b.x = xb_xcc_id(); b.st = st;
  if (threadIdx.x == 0) (void)xb_add(&bar[XB_XCNT(b.x)], 1u);
  return b;
}
DI void xcd_barrier_complete(unsigned* bar, unsigned x, unsigned& nloc, unsigned& nx) {
  const unsigned G = gridDim.x * gridDim.y * gridDim.z;
  unsigned sum, cnt, mine, sp = 0u;
  for (;;) {
    sum = 0u; cnt = 0u; mine = 0u;
#pragma unroll
    for (unsigned j = 0; j < 16; ++j) { const unsigned c = xb_ld(&bar[XB_XCNT(j)]); sum += c; cnt += (c > 0u) ? 1u : 0u; mine = (j == x) ? c : mine; }
    if (sum == G) break;
    __builtin_amdgcn_s_sleep(1);
    if ((++sp & 255u) == 0u) { if (xb_ld(&bar[XB_TMO])) break; if (sp > XB_SPIN_CAP) { atomicAdd(&bar[XB_TMO], 1u); break; } }
  }
  nloc = mine > 0u ? mine : 1u; nx = cnt > 0u ? cnt : 1u;
}
DI void xcd_barrier(const XcdBarrier& b) {
  asm volatile("s_waitcnt vmcnt(0)" ::: "memory");
  __syncthreads();
  if (threadIdx.x == 0) {
    unsigned* bar = b.bar;
    __builtin_amdgcn_s_waitcnt(0);
    unsigned nloc = b.st[0], nx = b.st[1];
    if (nloc == 0u) { xcd_barrier_complete(bar, b.x, nloc, nx); b.st[0] = nloc; b.st[1] = nx; }
    const unsigned old = xb_add(&bar[XB_XSUB(b.x)], 1u);
    const unsigned gen = old / nloc;
    if (old + 1u == (gen + 1u) * nloc) {
      __builtin_amdgcn_fence(__ATOMIC_RELEASE, "agent");
      asm volatile("s_waitcnt vmcnt(0)" ::: "memory");
      const unsigned og = xb_add(&bar[XB_TOP], 1u);
      const unsigned tg = og / nx;
      if (og + 1u == (tg + 1u) * nx) xb_add(&bar[XB_TOPGEN], 1u);
      else XB_SPIN(xb_ld(&bar[XB_TOPGEN]) == tg, bar);
      __builtin_amdgcn_fence(__ATOMIC_ACQUIRE, "agent");
      xb_add(&bar[XB_XGEN(b.x)], 1u);
      asm volatile("s_waitcnt vmcnt(0)" ::: "memory");
    } else {
      XB_SPIN(xb_ld(&bar[XB_XGEN(b.x)]) == gen, bar);
      __builtin_amdgcn_fence(__ATOMIC_ACQUIRE, "agent");
      asm volatile("s_waitcnt vmcnt(0)" ::: "memory");
    }
  }
  __syncthreads();
}

namespace gm {
constexpr int BM = 256, BK = 64, HALF = 128, HT = HALF * BK, NXCD = 8, WGM = 8;
DI int lds_byte(int r, int c) {
  int st = (r >> 4) * 2 + (c >> 5), rr = r & 15, cc = c & 31, ob = rr * 64 + cc * 2;
  return st * 1024 + (ob ^ (((ob >> 9) & 1) << 5));
}
DI void stage_rc(int b, int& R, int& C) {
  int st = b / 1024, sb = b % 1024, swz = sb ^ (((sb >> 9) & 1) << 5);
  R = (st >> 1) * 16 + swz / 64;
  C = (st & 1) * 32 + (swz % 64) / 2;
}
}

enum { EPI_IN = 0, EPI_OUT = 1, EPI_MLP1 = 2, EPI_MLP2 = 3 };

template <int EPI>
DI void gemm_epilogue(const Params& p, int layer, f32x4 (&acc)[2][2][4][2], int brow, int bcol, int pn, int wr, int wc,
                      int fr, int fq, char* smem) {
  using namespace gm;
  if (EPI == EPI_IN) {
    u16* Z = p.z;
    const bool latent = brow < NLAT;
    if (pn == 9 || pn == 10) {
      float* xch = (float*)smem;
#pragma unroll
      for (int ai = 0; ai < 2; ++ai)
#pragma unroll
        for (int m = 0; m < 4; ++m)
#pragma unroll
          for (int bj = 0; bj < 2; ++bj) {
            float s = 0.f;
#pragma unroll
            for (int n = 0; n < 2; ++n)
#pragma unroll
              for (int j = 0; j < 4; ++j) s += acc[ai][bj][m][n][j] * acc[ai][bj][m][n][j];
            s += __shfl_xor(s, 16);
            s += __shfl_xor(s, 32);
            if (fq == 0) xch[(ai * 128 + wr * 64 + m * 16 + fr) * 8 + bj * 4 + wc] = s;
          }
      __syncthreads();
      const float* gq = (pn == 9 ? p.qn_g : p.kn_g) + layer * 64;
#pragma unroll
      for (int ai = 0; ai < 2; ++ai)
#pragma unroll
        for (int m = 0; m < 4; ++m) {
          __builtin_amdgcn_sched_barrier(0);
          const int rl = ai * 128 + wr * 64 + m * 16 + fr;
          const int row = brow + rl;
          const int spos = row & (SEQ - 1);
#pragma unroll
          for (int bj = 0; bj < 2; ++bj) {
            const bool normed = (pn == 9) || (bj == 0);
            float rs = 1.f;
            if (normed) {
              float tot = xch[rl * 8 + bj * 4 + wc] + xch[rl * 8 + bj * 4 + (wc ^ 1)];
              rs = __builtin_amdgcn_rsqf(tot * (1.f / 64.f) + EPSN);
            }
#pragma unroll
            for (int n = 0; n < 2; ++n) {
              const int cih = (wc & 1) * 32 + n * 16 + fq * 4;
              f32x4 v = acc[ai][bj][m][n];
              if (normed) {
                f32x4 g = *(const f32x4*)(gq + cih);
                v = v * rs * g;
                if (latent) {
                  const float2 cs = *(const float2*)(p.ropec + spos * 32 + (cih >> 1));
                  const float2 sn = *(const float2*)(p.ropes + spos * 32 + (cih >> 1));
                  f32x4 r;
                  r[0] = v[0] * cs.x - v[1] * sn.x;
                  r[1] = v[0] * sn.x + v[1] * cs.x;
                  r[2] = v[2] * cs.y - v[3] * sn.y;
                  r[3] = v[2] * sn.y + v[3] * cs.y;
                  v = r;
                }
                if (pn == 9) v = v * 0.125f;
              }
              u32x2 o;
              o[0] = pk_bf16(v[0], v[1]);
              o[1] = pk_bf16(v[2], v[3]);
              *(u32x2*)(Z + (size_t)row * ZW + bcol + bj * 128 + wc * 32 + n * 16 + fq * 4) = o;
            }
          }
        }
    } else {
      const float sc = (pn == 0 || pn == 6 || pn == 11) ? 0.125f : 1.f;
      const bool dosilu = (pn == 0);
#pragma unroll
      for (int ai = 0; ai < 2; ++ai)
#pragma unroll
        for (int m = 0; m < 4; ++m) {
          __builtin_amdgcn_sched_barrier(0);
          const int row = brow + ai * 128 + wr * 64 + m * 16 + fr;
#pragma unroll
          for (int bj = 0; bj < 2; ++bj)
#pragma unroll
            for (int n = 0; n < 2; ++n) {
              f32x4 v = acc[ai][bj][m][n];
              if (dosilu) {
#pragma unroll
                for (int j = 0; j < 4; ++j) v[j] = siluf(v[j]);
              }
              v = v * sc;
              u32x2 o;
              o[0] = pk_bf16(v[0], v[1]);
              o[1] = pk_bf16(v[2], v[3]);
              *(u32x2*)(Z + (size_t)row * ZW + bcol + bj * 128 + wc * 32 + n * 16 + fq * 4) = o;
            }
        }
    }
  } else if (EPI == EPI_MLP1) {
#pragma unroll
    for (int ai = 0; ai < 2; ++ai)
#pragma unroll
      for (int m = 0; m < 4; ++m) {
        __builtin_amdgcn_sched_barrier(0);
        const int row = brow + ai * 128 + wr * 64 + m * 16 + fr;
#pragma unroll
        for (int bj = 0; bj < 2; ++bj)
#pragma unroll
          for (int n = 0; n < 2; ++n) {
            f32x4 v = acc[ai][bj][m][n];
#pragma unroll
            for (int j = 0; j < 4; ++j) {
              float r = fmaxf(v[j], 0.f);
              v[j] = r * r;
            }
            u32x2 o;
            o[0] = pk_bf16(v[0], v[1]);
            o[1] = pk_bf16(v[2], v[3]);
            *(u32x2*)(p.hid + (size_t)row * HID + bcol + bj * 128 + wc * 32 + n * 16 + fq * 4) = o;
          }
      }
  } else {
    const bool latent = brow < NLAT;
    const int bidx = latent ? (brow >> 11) : 16;
    const float* gate = p.modv + ((size_t)(layer * 17 + bidx) * 6 + (EPI == EPI_OUT ? 2 : 5)) * DM;
    const float* src;
    float* dst;
    if (latent) {
      dst = p.out + (size_t)brow * DM;
      src = (EPI == EPI_OUT && layer == 0) ? p.x + (size_t)brow * DM : dst;
    } else {
      dst = p.xcw + (size_t)(brow - NLAT) * DM;
      src = (EPI == EPI_OUT && layer == 0) ? p.ctx + (size_t)(brow - NLAT) * DM : dst;
    }
#pragma unroll
    for (int ai = 0; ai < 2; ++ai)
#pragma unroll
      for (int m = 0; m < 4; ++m) {
        __builtin_amdgcn_sched_barrier(0);
        const int rl = ai * 128 + wr * 64 + m * 16 + fr;
#pragma unroll
        for (int bj = 0; bj < 2; ++bj)
#pragma unroll
          for (int n = 0; n < 2; ++n) {
            const int col = bcol + bj * 128 + wc * 32 + n * 16 + fq * 4;
            const f32x4 xv = *(const f32x4*)(src + (size_t)rl * DM + col);
            const f32x4 gv = *(const f32x4*)(gate + col);
            f32x4 o = xv + gv * acc[ai][bj][m][n];
            *(f32x4*)(dst + (size_t)rl * DM + col) = o;
          }
      }
  }
}

template <int EPI, int K>
__device__ void gemm_phase(const Params& p, int layer, const u16* __restrict__ A, const u16* __restrict__ Bt, int nM, int nN) {
  using namespace gm;
  extern __shared__ __attribute__((aligned(16))) unsigned char shm[];
  LAS unsigned char* lds = (LAS unsigned char*)shm;
  constexpr int HTB = HT * 2;
#define SAo(b, h) (((b) * 2 + (h)) * HTB)
#define SBo(b, h) ((4 + (b) * 2 + (h)) * HTB)
#define STAGE(bufoff, gbase, voff)                                                                   \
  do {                                                                                               \
    _Pragma("unroll") for (int _i = 0; _i < 2; ++_i)                                                 \
      __builtin_amdgcn_global_load_lds((const unsigned*)((const char*)(gbase) + (voff)[_i]),         \
                                       (LAS unsigned*)(lds + (bufoff) + ldsw + _i * 8192), 16, 0, 0); \
  } while (0)
#define LDA(dst, b, h)                                                                               \
  do {                                                                                               \
    _Pragma("unroll") for (int m = 0; m < 4; ++m) _Pragma("unroll") for (int k = 0; k < 2; ++k)      \
      dst[m][k] = *(const LAS bf16x8*)(lds + SAo(b, h) + aoff + m * 2048 + k * 1024);                \
  } while (0)
#define LDB(dst, b, h)                                                                               \
  do {                                                                                               \
    _Pragma("unroll") for (int n = 0; n < 2; ++n) _Pragma("unroll") for (int k = 0; k < 2; ++k)      \
      dst[n][k] = *(const LAS bf16x8*)(lds + SBo(b, h) + boff + n * 2048 + k * 1024);                \
  } while (0)
#define MMA(ai, bj, At_, Bt_)                                                                        \
  do {                                                                                               \
    __builtin_amdgcn_s_setprio(1);                                                                   \
    _Pragma("unroll") for (int m = 0; m < 4; ++m) _Pragma("unroll") for (int n = 0; n < 2; ++n)      \
      _Pragma("unroll") for (int k = 0; k < 2; ++k)                                                  \
        acc[ai][bj][m][n] = __builtin_amdgcn_mfma_f32_16x16x32_bf16(Bt_[n][k], At_[m][k], acc[ai][bj][m][n], 0, 0, 0); \
    __builtin_amdgcn_s_setprio(0);                                                                   \
  } while (0)
#define WAIT_V(n) asm volatile("s_waitcnt vmcnt(" #n ")" ::: "memory")
#define WAIT_L(n) asm volatile("s_waitcnt lgkmcnt(" #n ")" ::: "memory")
#define BAR __builtin_amdgcn_s_barrier()
#define SCHED __builtin_amdgcn_sched_barrier(0)

  const int nwg = nM * nN;
  const int tid = opaque_tid(), wid = __builtin_amdgcn_readfirstlane(tid >> 6), lane = tid & 63, wr = wid >> 2, wc = wid & 3,
            fr = lane & 15, fq = lane >> 4;
  constexpr int nt = K / BK;
  unsigned voff[2];
#pragma unroll
  for (int i = 0; i < 2; ++i) {
    int r_, c_;
    stage_rc(tid * 16 + i * 8192, r_, c_);
    voff[i] = (unsigned)(r_ * K + c_) * 2u;
  }
  const size_t kstep = (size_t)(BK * 2);
  const size_t hstep = (size_t)HALF * K * 2;
  const size_t tstep = 2 * hstep;
  const unsigned ldsw = (unsigned)wid * 1024u;
  const int aoff = lds_byte(wr * 64 + fr, fq * 8), boff = lds_byte(wc * 32 + fr, fq * 8);
  for (int it = 0;; ++it) {
    const long L = (long)it * gridDim.x + blockIdx.x;
    if (L >= nwg) break;
    int wgid = (int)L;
    {
      const int q = nwg / NXCD, r = nwg % NXCD, xcd = wgid % NXCD, off = wgid / NXCD;
      wgid = (xcd < r ? xcd * (q + 1) : r * (q + 1) + (xcd - r) * q) + off;
    }
    const int nig = WGM * nN, gid = wgid / nig, fm = gid * WGM, gsz = min(nM - fm, WGM);
    const int pm = fm + ((wgid % nig) % gsz), pn = (wgid % nig) / gsz, brow = pm * BM, bcol = pn * BM;
    const char* cA = (const char*)A + (size_t)pm * tstep;
    const char* cB = (const char*)Bt + (size_t)pn * tstep;

    f32x4 acc[2][2][4][2];
#pragma unroll
    for (int a = 0; a < 2; ++a)
#pragma unroll
      for (int b = 0; b < 2; ++b)
#pragma unroll
        for (int m = 0; m < 4; ++m)
#pragma unroll
          for (int n = 0; n < 2; ++n) acc[a][b][m][n] = (f32x4){0.f, 0.f, 0.f, 0.f};
    bf16x8 At[4][2], B0[2][2], B1[2][2];

    STAGE(SBo(0, 0), cB, voff); STAGE(SAo(0, 0), cA, voff);
    STAGE(SBo(0, 1), cB + hstep, voff); STAGE(SAo(0, 1), cA + hstep, voff);
    if (wr == 1) BAR;
    WAIT_V(4); BAR;
    STAGE(SBo(1, 0), cB + kstep, voff); STAGE(SAo(1, 0), cA + kstep, voff); STAGE(SBo(1, 1), cB + hstep + kstep, voff);
    WAIT_V(6); BAR;
    for (int t = 0; t < nt - 2; t += 2) {
      const char* a1 = cA + (size_t)(t + 1) * kstep;
      const char* a2 = cA + (size_t)(t + 2) * kstep;
      const char* b2 = cB + (size_t)(t + 2) * kstep;
      const char* a3 = a2 + kstep;
      const char* b3 = b2 + kstep;
      LDB(B0, 0, 0); SCHED; LDA(At, 0, 0); STAGE(SAo(1, 1), a1 + hstep, voff);
      WAIT_L(8); BAR; WAIT_L(0); MMA(0, 0, At, B0); BAR; SCHED;
      LDB(B1, 0, 1); STAGE(SBo(0, 0), b2, voff);
      BAR; WAIT_L(0); MMA(0, 1, At, B1); BAR;
      LDA(At, 0, 1); STAGE(SAo(0, 0), a2, voff);
      BAR; WAIT_L(0); MMA(1, 0, At, B0); BAR; SCHED;
      STAGE(SBo(0, 1), b2 + hstep, voff);
      WAIT_V(6); BAR; MMA(1, 1, At, B1); BAR;
      LDB(B0, 1, 0); SCHED; LDA(At, 1, 0); STAGE(SAo(0, 1), a2 + hstep, voff);
      WAIT_L(8); BAR; WAIT_L(0); MMA(0, 0, At, B0); BAR; SCHED;
      LDB(B1, 1, 1); STAGE(SBo(1, 0), b3, voff);
      BAR; WAIT_L(0); MMA(0, 1, At, B1); BAR;
      LDA(At, 1, 1); STAGE(SAo(1, 0), a3, voff);
      BAR; WAIT_L(0); MMA(1, 0, At, B0); BAR; SCHED;
      STAGE(SBo(1, 1), b3 + hstep, voff);
      WAIT_V(6); BAR; MMA(1, 1, At, B1); BAR;
    }
    { LDB(B0, 0, 0); LDA(At, 0, 0); STAGE(SAo(1, 1), cA + (size_t)(nt - 1) * kstep + hstep, voff);
      BAR; WAIT_L(0); MMA(0, 0, At, B0); BAR;
      LDB(B1, 0, 1); BAR; WAIT_L(0); MMA(0, 1, At, B1); BAR;
      LDA(At, 0, 1); WAIT_V(4); BAR; WAIT_L(0); MMA(1, 0, At, B0); MMA(1, 1, At, B1); BAR; }
    { LDB(B0, 1, 0); LDA(At, 1, 0); WAIT_V(2); BAR; WAIT_L(0); MMA(0, 0, At, B0); BAR;
      LDB(B1, 1, 1); WAIT_V(0); BAR; WAIT_L(0); MMA(0, 1, At, B1); BAR;
      LDA(At, 1, 1); BAR; WAIT_L(0); MMA(1, 0, At, B0); MMA(1, 1, At, B1); BAR; }
    if (wr == 0) BAR;
    __syncthreads();
    {
      const int tid2 = opaque_tid(), lane2 = tid2 & 63;
      gemm_epilogue<EPI>(p, layer, acc, brow, bcol, pn, wr, wc, lane2 & 15, lane2 >> 4, (char*)shm);
    }
    __syncthreads();
  }
#undef SAo
#undef SBo
#undef STAGE
#undef LDA
#undef LDB
#undef MMA
}

__device__ void transpose_tile(const float* __restrict__ src, int ldsrc, int scol0, int k0, u16* __restrict__ dst, int Kd, int drow0, char* smem) {
  float* ts = (float*)smem;
  const int tid = opaque_tid();
  {
    const int kk = tid >> 4, n4 = (tid & 15) * 4;
#pragma unroll
    for (int i = 0; i < 2; ++i) {
      const int k = kk + 32 * i;
      const f32x4 v = *(const f32x4*)(src + (size_t)(k0 + k) * ldsrc + scol0 + n4);
      ts[k * 65 + n4 + 0] = v[0];
      ts[k * 65 + n4 + 1] = v[1];
      ts[k * 65 + n4 + 2] = v[2];
      ts[k * 65 + n4 + 3] = v[3];
    }
  }
  __syncthreads();
  {
    const int n = tid >> 3, k8 = (tid & 7) * 8;
    u32x4 o;
#pragma unroll
    for (int j = 0; j < 4; ++j) o[j] = pk_bf16(ts[(k8 + 2 * j) * 65 + n], ts[(k8 + 2 * j + 1) * 65 + n]);
    *(u32x4*)(dst + (size_t)(drow0 + n) * Kd + k0 + k8) = o;
  }
  __syncthreads();
}

__device__ void mod_job(const Params& p, int job, char* smem) {
  const int l = job / 96, n0 = (job % 96) * 64;
  float* sc = (float*)smem;
  float* red = (float*)(smem + 17 * 1024 * 4);
  const int tid = opaque_tid();
  for (int i = tid; i < 17 * 1024; i += NTHR) {
    const int r = i >> 10, k = i & 1023;
    const float v = (r < 16) ? p.c[r * 1024 + k] : p.c_ctx[k];
    sc[i] = siluf(v);
  }
  __syncthreads();
  const int col = tid & 63, kq = tid >> 6;
  float acc[17];
#pragma unroll
  for (int r = 0; r < 17; ++r) acc[r] = 0.f;
  const float* w = p.w_mod + (size_t)l * 1024 * 6144 + n0 + col;
  for (int k = kq * 128; k < kq * 128 + 128; ++k) {
    const float wv = w[(size_t)k * 6144];
#pragma unroll
    for (int r = 0; r < 17; ++r) acc[r] += sc[r * 1024 + k] * wv;
  }
#pragma unroll
  for (int r = 0; r < 17; ++r) red[(kq * 17 + r) * 64 + col] = acc[r];
  __syncthreads();
  for (int i = tid; i < 17 * 64; i += NTHR) {
    const int r = i >> 6, cc = i & 63;
    float s = p.b_mod[l * 6144 + n0 + cc];
#pragma unroll
    for (int q = 0; q < 8; ++q) s += red[(q * 17 + r) * 64 + cc];
    const int n = n0 + cc;
    p.modv[((size_t)(l * 17 + r) * 6 + (n >> 10)) * DM + (n & 1023)] = s;
  }
  __syncthreads();
}

__device__ void prologue_phase(const Params& p, char* smem) {
  constexpr int NJ_MOD = 192, NJ_TR = 6400, NJ_G = 2, NJ_R = 16;
  for (int job = blockIdx.x; job < NJ_MOD + NJ_TR + NJ_G + NJ_R; job += gridDim.x) {
    if (job < NJ_MOD) {
      mod_job(p, job, smem);
    } else if (job < NJ_MOD + NJ_TR) {
      int j = job - NJ_MOD;
      const int l = j / 3200;
      j %= 3200;
      if (j < 896) {
        const int kt = j / 56, nt = j % 56;
        const int scol = nt * 64 + (nt >= 36 ? 16 : 0);
        transpose_tile(p.w_in + (size_t)l * DM * INW, INW, scol, kt * 64, p.WinT + (size_t)l * ZW * DM, DM, nt * 64, smem);
      } else if (j < 896 + 256) {
        j -= 896;
        const int kt = j / 16, nt = j % 16;
        transpose_tile(p.w_out + (size_t)l * DM * DM, DM, nt * 64, kt * 64, p.WoutT + (size_t)l * DM * DM, DM, nt * 64, smem);
      } else if (j < 896 + 256 + 1024) {
        j -= 896 + 256;
        const int kt = j / 64, nt = j % 64;
        transpose_tile(p.w1 + (size_t)l * DM * HID, HID, nt * 64, kt * 64, p.W1T + (size_t)l * HID * DM, DM, nt * 64, smem);
      } else {
        j -= 896 + 256 + 1024;
        const int kt = j / 16, nt = j % 16;
        transpose_tile(p.w2 + (size_t)l * HID * DM, DM, nt * 64, kt * 64, p.W2T + (size_t)l * DM * HID, HID, nt * 64, smem);
      }
    } else if (job < NJ_MOD + NJ_TR + NJ_G) {
      const int l = job - NJ_MOD - NJ_TR;
      for (int i = threadIdx.x; i < 16 * 1024; i += NTHR) {
        const int n = i & 15, k = i >> 4;
        p.wg[(size_t)(l * 16 + n) * DM + k] = p.w_in[(size_t)l * DM * INW + (size_t)k * INW + 2304 + n];
      }
    } else {
      const int j = job - NJ_MOD - NJ_TR - NJ_G;
      for (int i = threadIdx.x; i < 4096; i += NTHR) {
        const int e = j * 4096 + i;
        const int s = e >> 5, idx = e & 31;
        const int row = s >> 6, col = s & 63;
        const int fi = idx & 15;
        const float inv = powf(10000.f, -2.0f * (float)fi / 32.f);
        const float ang = (idx < 16 ? (float)row : (float)col) * inv;
        p.ropec[e] = cosf(ang);
        p.ropes[e] = sinf(ang);
      }
    }
  }
}

__device__ void norm_phase(const Params& p, int layer, int which, int nrows, char* smem) {
  const int tid_ = opaque_tid();
  const int lane = tid_ & 63, wid = tid_ >> 6;
  const float* g = (which == 0 ? p.g1 : p.g2) + layer * DM;
  float* wgs = (float*)smem;
  if (which == 0) {
    const float* wgl = p.wg + (size_t)layer * 16 * DM;
    for (int i = tid_; i < 16 * DM / 4; i += NTHR) *(f32x4*)(wgs + i * 4) = *(const f32x4*)(wgl + i * 4);
    __syncthreads();
  }
  for (int pr = blockIdx.x * 8 + wid; pr < nrows / 2; pr += gridDim.x * 8) {
    const int row0 = pr * 2;
    const bool latent = row0 < NLAT;
    const float* src;
    if (which == 0 && layer == 0) src = latent ? p.x + (size_t)row0 * DM : p.ctx + (size_t)(row0 - NLAT) * DM;
    else src = latent ? p.out + (size_t)row0 * DM : p.xcw + (size_t)(row0 - NLAT) * DM;
    const int bidx = latent ? (row0 >> 11) : 16;
    const float* shift = p.modv + ((size_t)(layer * 17 + bidx) * 6 + (which == 0 ? 0 : 3)) * DM;
    const float* scale = shift + DM;
    f32x4 v[2][4];
    float ss0 = 0.f, ss1 = 0.f;
#pragma unroll
    for (int i = 0; i < 4; ++i) {
      v[0][i] = *(const f32x4*)(src + i * 256 + lane * 4);
      v[1][i] = *(const f32x4*)(src + DM + i * 256 + lane * 4);
    }
#pragma unroll
    for (int i = 0; i < 4; ++i) {
      ss0 += v[0][i][0] * v[0][i][0] + v[0][i][1] * v[0][i][1] + v[0][i][2] * v[0][i][2] + v[0][i][3] * v[0][i][3];
      ss1 += v[1][i][0] * v[1][i][0] + v[1][i][1] * v[1][i][1] + v[1][i][2] * v[1][i][2] + v[1][i][3] * v[1][i][3];
    }
#pragma unroll
    for (int o = 32; o > 0; o >>= 1) { ss0 += __shfl_xor(ss0, o); ss1 += __shfl_xor(ss1, o); }
    const float rs0 = __builtin_amdgcn_rsqf(ss0 * (1.f / DM) + EPSN), rs1 = __builtin_amdgcn_rsqf(ss1 * (1.f / DM) + EPSN);
#pragma unroll
    for (int i = 0; i < 4; ++i) {
      const int c0 = i * 256 + lane * 4;
      const f32x4 gv = *(const f32x4*)(g + c0), sh = *(const f32x4*)(shift + c0), sc = *(const f32x4*)(scale + c0) + 1.f;
      v[0][i] = (v[0][i] * rs0 * gv) * sc + sh;
      v[1][i] = (v[1][i] * rs1 * gv) * sc + sh;
      u32x2 o;
      o[0] = pk_bf16(v[0][i][0], v[0][i][1]);
      o[1] = pk_bf16(v[0][i][2], v[0][i][3]);
      *(u32x2*)(p.xn + (size_t)row0 * DM + c0) = o;
      o[0] = pk_bf16(v[1][i][0], v[1][i][1]);
      o[1] = pk_bf16(v[1][i][2], v[1][i][3]);
      *(u32x2*)(p.xn + (size_t)(row0 + 1) * DM + c0) = o;
    }
    if (which == 0) {
      float a32[32];
#pragma unroll
      for (int n = 0; n < 16; ++n) {
        float a0 = 0.f, a1 = 0.f;
#pragma unroll
        for (int i = 0; i < 4; ++i) {
          const f32x4 wv = *(const f32x4*)(wgs + n * DM + i * 256 + lane * 4);
          a0 += v[0][i][0] * wv[0] + v[0][i][1] * wv[1] + v[0][i][2] * wv[2] + v[0][i][3] * wv[3];
          a1 += v[1][i][0] * wv[0] + v[1][i][1] * wv[1] + v[1][i][2] * wv[2] + v[1][i][3] * wv[3];
        }
        a32[n] = a0;
        a32[16 + n] = a1;
        if ((n & 1) == 1) __builtin_amdgcn_sched_barrier(0);
      }
#pragma unroll
      for (int half = 16; half >= 1; half >>= 1) {
        const int mask = half * 2;
        const bool up = (lane & mask) != 0;
#pragma unroll
        for (int i = 0; i < half; ++i) {
          const float send = up ? a32[i] : a32[i + half];
          const float keep = up ? a32[i + half] : a32[i];
          a32[i] = keep + __shfl_xor(send, mask);
        }
      }
      const float tot = a32[0] + __shfl_xor(a32[0], 1);
      if ((lane & 1) == 0) {
        const int gi = (lane >> 1) & 15;
        p.gates[(size_t)(row0 + (lane >> 5)) * 16 + gi] = tot + p.mlstm_b[layer * 16 + gi];
      }
    }
  }
}

__device__ void final_norm_phase(const Params& p) {
  const int tid_ = opaque_tid();
  const int lane = tid_ & 63, wid = tid_ >> 6;
  for (int row = blockIdx.x * 8 + wid; row < NLAT; row += gridDim.x * 8) {
    float* src = p.out + (size_t)row * DM;
    f32x4 v[4];
    float ss = 0.f;
#pragma unroll
    for (int i = 0; i < 4; ++i) {
      v[i] = *(const f32x4*)(src + i * 256 + lane * 4);
      ss += v[i][0] * v[i][0] + v[i][1] * v[i][1] + v[i][2] * v[i][2] + v[i][3] * v[i][3];
    }
    ss = wave_sum(ss);
    const float rs = __builtin_amdgcn_rsqf(ss * (1.f / DM) + EPSN);
#pragma unroll
    for (int i = 0; i < 4; ++i) {
      const int c0 = i * 256 + lane * 4;
      const f32x4 gv = *(const f32x4*)(p.final_g + c0);
      *(f32x4*)(src + c0) = v[i] * rs * gv;
    }
  }
}

constexpr int KS_STRIDE = 72, VT_STRIDE = 66;
DI bf16x8 ld_frag16(const u16* base) { return *(const bf16x8*)base; }
DI bf16x8 ld_frag4x4(const u16* a, const u16* b) {
  u32x4 r;
  const unsigned* pa = (const unsigned*)a;
  const unsigned* pb = (const unsigned*)b;
  r[0] = pa[0]; r[1] = pa[1]; r[2] = pb[0]; r[3] = pb[1];
  return as_bf16x8(r);
}

__device__ void attn_job(const Params& p, int layer, int kind, int idx, char* smem) {
  u16* Ks = (u16*)smem;
  u16* Vt = (u16*)(smem + 2 * 64 * KS_STRIDE * 2);
  float* rpbs = (float*)(smem + 2 * 64 * KS_STRIDE * 2 + 2 * 64 * VT_STRIDE * 2);
  const int tid = opaque_tid(), lane = tid & 63, w = __builtin_amdgcn_readfirstlane(tid >> 6), tq = lane & 31, hh = lane >> 5;
  int b, qrow0, qcol, ocol, kcol, vcol, nlat = 0, lat0 = 0, r = 0, r0w = 0, R0 = 0, hN = 0;
  if (kind == 0) {
    b = idx >> 5; const int kvh = (idx >> 4) & 1, qt = idx & 15;
    const int head = kvh * 2 + (w >> 2);
    qrow0 = b * SEQ + qt * 128 + (w & 3) * 32; qcol = GQ + head * 64; ocol = 512 + head * 64;
    kcol = GK + kvh * 64; vcol = GV + kvh * 64; nlat = 32; lat0 = b * SEQ;
  } else if (kind == 1) {
    b = idx >> 5; hN = (idx >> 3) & 3; const int rg = idx & 7;
    r = rg * 4 + (w >> 1);
    qrow0 = b * SEQ + r * 64 + (w & 1) * 32; qcol = NQ + hN * 64; ocol = 768 + hN * 64;
    kcol = NK + hN * 64; vcol = NV + hN * 64;
    R0 = min(max(rg * 4 - 4, 0), 24);
    const int R1 = min(max(rg * 4 + 3 - 4, 0), 24) + 8;
    nlat = R1 - R0; lat0 = b * SEQ + R0 * 64;
    r0w = min(max(r - 4, 0), 24);
  } else if (kind == 2) {
    b = idx >> 2; const int kvh = (idx >> 1) & 1, half = idx & 1;
    const int head = kvh * 2 + (w >> 2);
    qrow0 = NLAT + b * CTXL + half * 128 + (w & 3) * 32; qcol = GQ + head * 64; ocol = 512 + head * 64;
    kcol = GK + kvh * 64; vcol = GV + kvh * 64;
  } else {
    b = idx >> 2; hN = idx & 3;
    qrow0 = NLAT + b * CTXL + w * 32; qcol = NQ + hN * 64; ocol = 768 + hN * 64;
    kcol = NK + hN * 64; vcol = NV + hN * 64;
  }
  const int ntiles = 4 + nlat;
  const u16* Z = p.z;
  if (kind == 1) {
    for (int i = tid; i < 15 * 32; i += NTHR) {
      const int rr = i >> 5, cc = i & 31;
      rpbs[i] = (cc < 31) ? p.rpb[((size_t)(layer * 4 + hN) * 15 + rr) * 31 + cc] : 0.f;
    }
  }
  bf16x8 qf[4];
#pragma unroll
  for (int st = 0; st < 4; ++st) qf[st] = *(const bf16x8*)(Z + (size_t)(qrow0 + tq) * ZW + qcol + 16 * st + 8 * hh);
  const int qc = (w & 1) * 32 + tq;
  const int cs = min(max(qc - 8, 0), 48);
  float mrun = -1e30f, lsum = 0.f;
  f32x16 O[2];
#pragma unroll
  for (int i = 0; i < 16; ++i) { O[0][i] = 0.f; O[1][i] = 0.f; }
  const int lkey = tid >> 3, lc = tid & 7;
  auto tile_row0 = [&](int i) { return (i < 4) ? (NLAT + b * CTXL + i * 64) : (lat0 + (i - 4) * 64); };
  u32x4 kreg, vreg;
  {
    const size_t ro = (size_t)(tile_row0(0) + lkey) * ZW;
    kreg = *(const u32x4*)(Z + ro + kcol + lc * 8);
    vreg = *(const u32x4*)(Z + ro + vcol + lc * 8);
  }
  for (int i = 0; i < ntiles; ++i) {
    u16* Kb = Ks + (i & 1) * 64 * KS_STRIDE;
    u16* Vb = Vt + (i & 1) * 64 * VT_STRIDE;
    *(u32x4*)(Kb + lkey * KS_STRIDE + lc * 8) = kreg;
#pragma unroll
    for (int j = 0; j < 4; ++j) {
      Vb[(lc * 8 + 2 * j) * VT_STRIDE + lkey] = (u16)(vreg[j] & 0xffffu);
      Vb[(lc * 8 + 2 * j + 1) * VT_STRIDE + lkey] = (u16)(vreg[j] >> 16);
    }
    __syncthreads();
    if (i + 1 < ntiles) {
      const size_t ro = (size_t)(tile_row0(i + 1) + lkey) * ZW;
      kreg = *(const u32x4*)(Z + ro + kcol + lc * 8);
      vreg = *(const u32x4*)(Z + ro + vcol + lc * 8);
    }
    bool active = true;
    int kr = 0;
    if (kind == 1 && i >= 4) {
      kr = R0 + i - 4;
      active = (kr >= r0w) && (kr < r0w + 8);
    }
    if (active) {
      f32x16 s[2];
#pragma unroll
      for (int kb = 0; kb < 2; ++kb) {
#pragma unroll
        for (int e = 0; e < 16; ++e) s[kb][e] = 0.f;
#pragma unroll
        for (int st = 0; st < 4; ++st) {
          const bf16x8 a = ld_frag16(Kb + (kb * 32 + tq) * KS_STRIDE + 16 * st + 8 * hh);
          s[kb] = mfma32(a, qf[st], s[kb]);
        }
      }
      if (kind == 1 && i >= 4) {
        const int rowoff = (kr - r + 7) * 32;
#pragma unroll
        for (int kb = 0; kb < 2; ++kb)
#pragma unroll
          for (int e = 0; e < 16; ++e) {
            const int kc = kb * 32 + (e & 3) + 8 * (e >> 2) + 4 * hh;
            const bool valid = (kc >= cs) && (kc < cs + 16);
            const int dc = min(max(kc - qc + 15, 0), 30);
            const float bias = rpbs[rowoff + dc];
            s[kb][e] = valid ? s[kb][e] + bias : -1e30f;
          }
      }
      float mx = -1e30f;
#pragma unroll
      for (int kb = 0; kb < 2; ++kb)
#pragma unroll
        for (int e = 0; e < 16; ++e) mx = fmaxf(mx, s[kb][e]);
      mx = fmaxf(mx, __shfl_xor(mx, 32));
      const float mnew = fmaxf(mrun, mx);
      const float alpha = __builtin_amdgcn_exp2f((mrun - mnew) * L2E);
      mrun = mnew;
      float ps = 0.f;
      const float mb = mnew * L2E;
#pragma unroll
      for (int kb = 0; kb < 2; ++kb)
#pragma unroll
        for (int e = 0; e < 16; ++e) {
          const float pv = __builtin_amdgcn_exp2f(s[kb][e] * L2E - mb);
          s[kb][e] = pv;
          ps += pv;
        }
      lsum = lsum * alpha + ps;
#pragma unroll
      for (int e = 0; e < 16; ++e) { O[0][e] *= alpha; O[1][e] *= alpha; }
#pragma unroll
      for (int kb = 0; kb < 2; ++kb)
#pragma unroll
        for (int st = 0; st < 2; ++st) {
          u32x4 pp;
#pragma unroll
          for (int j = 0; j < 4; ++j) pp[j] = pk_bf16(s[kb][8 * st + 2 * j], s[kb][8 * st + 2 * j + 1]);
          const bf16x8 pf = as_bf16x8(pp);
#pragma unroll
          for (int db = 0; db < 2; ++db) {
            const u16* vrow = Vb + (db * 32 + tq) * VT_STRIDE + kb * 32 + 16 * st + 4 * hh;
            const bf16x8 a = ld_frag4x4(vrow, vrow + 8);
            O[db] = mfma32(a, pf, O[db]);
          }
        }
    }
  }
  lsum += __shfl_xor(lsum, 32);
  const float inv = 1.f / lsum;
  u16* dst = p.xn + (size_t)(qrow0 + tq) * DM + ocol;
#pragma unroll
  for (int db = 0; db < 2; ++db)
#pragma unroll
    for (int g4 = 0; g4 < 4; ++g4) {
      u32x2 o;
      o[0] = pk_bf16(O[db][4 * g4 + 0] * inv, O[db][4 * g4 + 1] * inv);
      o[1] = pk_bf16(O[db][4 * g4 + 2] * inv, O[db][4 * g4 + 3] * inv);
      *(u32x2*)(dst + db * 32 + 8 * g4 + 4 * hh) = o;
    }
  __syncthreads();
}

__device__ void hgrn_chain(const Params& p, int layer, int idx, char* smem) {
  const int b = idx >> 3, h = (idx >> 1) & 3, dir = idx & 1;
  u16* Qs = (u16*)smem;
  u16* VT = (u16*)(smem + 9216);
  float* bb = (float*)(smem + 17664);
  float* kkf = (float*)(smem + 34304);
  u16* KdT = (u16*)(smem + 50944);
  u16* ST = (u16*)(smem + 59392);
  float* tot = (float*)(smem + 68608);
  float* bend = (float*)(smem + 70656);
  const int tid = opaque_tid(), lane = tid & 63, w = __builtin_amdgcn_readfirstlane(tid >> 6), c = lane & 15, g = lane >> 4;
  const int d_ = tid & 63, part = w;
  const int lrow = tid >> 3, c8 = tid & 7;
  float lb = 0.f;
  if (layer == 1) {
    const float l0 = p.lb_logits[(0 * 2 + dir) * 256 + h * 64 + d_], l1 = p.lb_logits[(1 * 2 + dir) * 256 + h * 64 + d_];
    lb = 1.f / (1.f + __expf(l0 - l1));
  }
  const int fcol = (dir ? HFB : HFF) + h * 64;
  const u16* Z = p.z;
  u16* ob = p.obuf + (size_t)(0 * 2 + dir) * NTOK * 256;
  f32x4 cst[2];
  cst[0] = (f32x4){0.f, 0.f, 0.f, 0.f};
  cst[1] = cst[0];
  for (int i = tid; i < 64 * 72; i += NTHR) ST[i] = 0;
  auto chunk_base = [&](int i) {
    if (i < 4) { const int cc = dir ? 3 - i : i; return NLAT + b * CTXL + cc * 64; }
    const int cc = dir ? 31 - (i - 4) : (i - 4);
    return b * SEQ + cc * 64;
  };
  u32x4 nq, nv;
  u16 nf[8];
  {
    const int base = chunk_base(0);
    const size_t ro = (size_t)(base + (dir ? 63 - lrow : lrow)) * ZW;
    nq = *(const u32x4*)(Z + ro + HQ + h * 64 + c8 * 8);
    nv = *(const u32x4*)(Z + ro + HI_ + h * 64 + c8 * 8);
#pragma unroll
    for (int e = 0; e < 8; ++e) {
      const int t = part * 8 + e;
      nf[e] = Z[(size_t)(base + (dir ? 63 - t : t)) * ZW + fcol + d_];
    }
  }
  __syncthreads();
  for (int i = 0; i < 36; ++i) {
    const int base = chunk_base(i);
    *(u32x4*)(Qs + lrow * 72 + c8 * 8) = nq;
#pragma unroll
    for (int j = 0; j < 4; ++j) {
      VT[(c8 * 8 + 2 * j) * 66 + lrow] = (u16)(nv[j] & 0xffffu);
      VT[(c8 * 8 + 2 * j + 1) * 66 + lrow] = (u16)(nv[j] >> 16);
    }
    float cl[8], kf[8];
    {
      float cum = 0.f;
#pragma unroll
      for (int e = 0; e < 8; ++e) {
        const float f = bf2f(nf[e]);
        const float ef = __expf(-f);
        const float sig = 1.f / (1.f + ef);
        const float forget = lb + (1.f - lb) * sig;
        cum += __logf(fmaxf(forget, 1e-20f));
        cl[e] = cum;
        kf[e] = (1.f - lb) * (ef / (1.f + ef));
      }
      tot[part * 64 + d_] = cum;
    }
    __syncthreads();
    {
      float off = 0.f, bendv = 0.f;
#pragma unroll
      for (int q = 0; q < 8; ++q) {
        const float tv = tot[q * 64 + d_];
        bendv += tv;
        if (q < part) off += tv;
      }
      float kd[8];
#pragma unroll
      for (int e = 0; e < 8; ++e) {
        const int t = part * 8 + e;
        const float bv = off + cl[e];
        bb[t * 65 + d_] = bv;
        kkf[t * 65 + d_] = kf[e];
        kd[e] = kf[e] * __expf(bendv - bv);
      }
      unsigned* kdp = (unsigned*)(KdT + d_ * 66 + part * 8);
#pragma unroll
      for (int j = 0; j < 4; ++j) kdp[j] = pk_bf16(kd[2 * j], kd[2 * j + 1]);
      if (part == 0) bend[d_] = bendv;
    }
    if (i + 1 < 36) {
      const int nb = chunk_base(i + 1);
      const size_t ro = (size_t)(nb + (dir ? 63 - lrow : lrow)) * ZW;
      nq = *(const u32x4*)(Z + ro + HQ + h * 64 + c8 * 8);
      nv = *(const u32x4*)(Z + ro + HI_ + h * 64 + c8 * 8);
#pragma unroll
      for (int e = 0; e < 8; ++e) {
        const int t = part * 8 + e;
        nf[e] = Z[(size_t)(nb + (dir ? 63 - t : t)) * ZW + fcol + d_];
      }
    }
    __syncthreads();
    {
      const int tb = w & 3, vh = w >> 2;
      const int t = tb * 16 + c;
      bf16x8 qt[2], qe[2];
      float rref[2][8];
#pragma unroll
      for (int kk = 0; kk < 2; ++kk) {
        const u32x4 qraw = *(const u32x4*)(Qs + t * 72 + 32 * kk + 8 * g);
        u32x4 a, e2;
#pragma unroll
        for (int j = 0; j < 4; ++j) {
          const int d0 = 32 * kk + 8 * g + 2 * j;
          const float r0 = tb ? bb[(16 * tb - 1) * 65 + d0] : 0.f, r1 = tb ? bb[(16 * tb - 1) * 65 + d0 + 1] : 0.f;
          rref[kk][2 * j] = r0;
          rref[kk][2 * j + 1] = r1;
          const float b0 = bb[t * 65 + d0], b1 = bb[t * 65 + d0 + 1];
          const float q0 = bf_lo(qraw[j]), q1 = bf_hi(qraw[j]);
          a[j] = pk_bf16(q0 * __expf(b0 - r0), q1 * __expf(b1 - r1));
          e2[j] = pk_bf16(q0 * __expf(b0), q1 * __expf(b1));
        }
        qt[kk] = as_bf16x8(a);
        qe[kk] = as_bf16x8(e2);
      }
      unsigned pp[4][2];
#pragma unroll
      for (int st = 0; st < 4; ++st) {
        f32x4 sacc = (f32x4){0.f, 0.f, 0.f, 0.f};
        if (st <= tb) {
          const int s = st * 16 + c;
#pragma unroll
          for (int kk = 0; kk < 2; ++kk) {
            u32x4 a;
#pragma unroll
            for (int j = 0; j < 4; ++j) {
              const int d0 = 32 * kk + 8 * g + 2 * j;
              const float k0 = kkf[s * 65 + d0], k1 = kkf[s * 65 + d0 + 1];
              const float b0 = bb[s * 65 + d0], b1 = bb[s * 65 + d0 + 1];
              a[j] = pk_bf16(k0 * __expf(rref[kk][2 * j] - b0), k1 * __expf(rref[kk][2 * j + 1] - b1));
            }
            sacc = mfma16(as_bf16x8(a), qt[kk], sacc);
          }
          if (st == tb) {
#pragma unroll
            for (int rg = 0; rg < 4; ++rg)
              if (4 * g + rg > c) sacc[rg] = 0.f;
          }
        }
        pp[st][0] = pk_bf16(sacc[0], sacc[1]);
        pp[st][1] = pk_bf16(sacc[2], sacc[3]);
      }
      bf16x8 pf[2];
#pragma unroll
      for (int kk = 0; kk < 2; ++kk) {
        u32x4 a;
        a[0] = pp[2 * kk][0]; a[1] = pp[2 * kk][1]; a[2] = pp[2 * kk + 1][0]; a[3] = pp[2 * kk + 1][1];
        pf[kk] = as_bf16x8(a);
      }
      const int tok = base + (dir ? 63 - t : t);
#pragma unroll
      for (int vi = 0; vi < 2; ++vi) {
        const int vt = vh * 2 + vi;
        f32x4 o = (f32x4){0.f, 0.f, 0.f, 0.f};
#pragma unroll
        for (int kk = 0; kk < 2; ++kk) {
          const bf16x8 a = ld_frag16(ST + (vt * 16 + c) * 72 + 32 * kk + 8 * g);
          o = mfma16(a, qe[kk], o);
          const u16* vrow = VT + (vt * 16 + c) * 66 + 32 * kk + 4 * g;
          const bf16x8 a2 = ld_frag4x4(vrow, vrow + 16);
          o = mfma16(a2, pf[kk], o);
        }
        u32x2 ov;
        ov[0] = pk_bf16(o[0], o[1]);
        ov[1] = pk_bf16(o[2], o[3]);
        *(u32x2*)(ob + (size_t)tok * 256 + h * 64 + vt * 16 + 4 * g) = ov;
      }
    }
    __syncthreads();
    {
      const int vt = w >> 1, dh = w & 1;
#pragma unroll
      for (int i2 = 0; i2 < 2; ++i2) {
        const int dt = 2 * dh + i2, dcol = dt * 16 + c;
        const float dec = __expf(bend[dcol]);
        f32x4 a4 = cst[i2] * dec;
#pragma unroll
        for (int kk = 0; kk < 2; ++kk) {
          const u16* ar = VT + (vt * 16 + c) * 66 + 32 * kk + 8 * g;
          const u16* br = KdT + (dt * 16 + c) * 66 + 32 * kk + 8 * g;
          a4 = mfma16(ld_frag4x4(ar, ar + 4), ld_frag4x4(br, br + 4), a4);
        }
        cst[i2] = a4;
#pragma unroll
        for (int rg = 0; rg < 4; ++rg) ST[(vt * 16 + 4 * g + rg) * 72 + dcol] = f2bf(a4[rg]);
      }
    }
    __syncthreads();
  }
}

__device__ void mlstm_chain(const Params& p, int layer, int idx, char* smem) {
  const int b = idx >> 3, h = (idx >> 1) & 3, dir = idx & 1;
  u16* Qs = (u16*)smem;
  u16* Ksm = (u16*)(smem + 9216);
  u16* VT = (u16*)(smem + 18432);
  u16* KTw = (u16*)(smem + 26880);
  u16* CT = (u16*)(smem + 35328);
  float* nvv = (float*)(smem + 44544);
  float* us = (float*)(smem + 44800);
  float* Ms = (float*)(smem + 45056);
  float* bs = (float*)(smem + 45312);
  float* scl = (float*)(smem + 45568);
  const int tid = opaque_tid(), lane = tid & 63, w = __builtin_amdgcn_readfirstlane(tid >> 6), c = lane & 15, g = lane >> 4;
  const int lrow = tid >> 3, c8 = tid & 7;
  const u16* Z = p.z;
  u16* ob = p.obuf + (size_t)(2 + dir) * NTOK * 256;
  f32x4 cst[2];
  cst[0] = (f32x4){0.f, 0.f, 0.f, 0.f};
  cst[1] = cst[0];
  for (int i = tid; i < 64 * 72; i += NTHR) CT[i] = 0;
  if (tid < 64) nvv[tid] = 0.f;
  float mprev = 0.f;
  auto chunk_base = [&](int i) {
    if (i < 4) { const int cc = dir ? 3 - i : i; return NLAT + b * CTXL + cc * 64; }
    const int cc = dir ? 31 - (i - 4) : (i - 4);
    return b * SEQ + cc * 64;
  };
  u32x4 nq, nk, nv;
  float nig = 0.f, nfg = 0.f;
  {
    const int base = chunk_base(0);
    const size_t ro = (size_t)(base + (dir ? 63 - lrow : lrow)) * ZW;
    nq = *(const u32x4*)(Z + ro + MQ + h * 64 + c8 * 8);
    nk = *(const u32x4*)(Z + ro + MK + h * 64 + c8 * 8);
    nv = *(const u32x4*)(Z + ro + MV + h * 64 + c8 * 8);
    if (w == 0) {
      const size_t tg = (size_t)(base + (dir ? 63 - lane : lane)) * 16;
      nig = p.gates[tg + dir * 4 + h];
      nfg = p.gates[tg + 8 + dir * 4 + h];
    }
  }
  __syncthreads();
  for (int i = 0; i < 36; ++i) {
    const int base = chunk_base(i);
    *(u32x4*)(Qs + lrow * 72 + c8 * 8) = nq;
    *(u32x4*)(Ksm + lrow * 72 + c8 * 8) = nk;
#pragma unroll
    for (int j = 0; j < 4; ++j) {
      VT[(c8 * 8 + 2 * j) * 66 + lrow] = (u16)(nv[j] & 0xffffu);
      VT[(c8 * 8 + 2 * j + 1) * 66 + lrow] = (u16)(nv[j] >> 16);
    }
    const u32x4 kcur = nk;
    if (w == 0) {
      const float fg = nfg, ig = nig;
      const float lf = fminf(fg, 0.f) - __logf(1.f + __expf(-fabsf(fg)));
      float bc = lf;
#pragma unroll
      for (int o = 1; o < 64; o <<= 1) {
        const float t = __shfl_up(bc, o);
        if (lane >= o) bc += t;
      }
      const float u = ig - bc;
      float cm = u;
#pragma unroll
      for (int o = 1; o < 64; o <<= 1) {
        const float t = __shfl_up(cm, o);
        if (lane >= o) cm = fmaxf(cm, t);
      }
      const float M = fmaxf(mprev, cm);
      us[lane] = u;
      Ms[lane] = M;
      bs[lane] = bc;
      if (lane == 63) {
        scl[0] = __expf(mprev - M);
        scl[1] = bc + M;
      }
    }
    __syncthreads();
    if (i + 1 < 36) {
      const int nb = chunk_base(i + 1);
      const size_t ro = (size_t)(nb + (dir ? 63 - lrow : lrow)) * ZW;
      nq = *(const u32x4*)(Z + ro + MQ + h * 64 + c8 * 8);
      nk = *(const u32x4*)(Z + ro + MK + h * 64 + c8 * 8);
      nv = *(const u32x4*)(Z + ro + MV + h * 64 + c8 * 8);
      if (w == 0) {
        const size_t tg = (size_t)(nb + (dir ? 63 - lane : lane)) * 16;
        nig = p.gates[tg + dir * 4 + h];
        nfg = p.gates[tg + 8 + dir * 4 + h];
      }
    }
    const float Mend = Ms[63];
    {
      const float ws = __expf(us[lrow] - Mend);
#pragma unroll
      for (int j = 0; j < 4; ++j) {
        KTw[(c8 * 8 + 2 * j) * 66 + lrow] = f2bf(bf_lo(kcur[j]) * ws);
        KTw[(c8 * 8 + 2 * j + 1) * 66 + lrow] = f2bf(bf_hi(kcur[j]) * ws);
      }
    }
    {
      const int tb = w & 3, vh = w >> 2;
      const int t = tb * 16 + c;
      const float Mt = Ms[t];
      const float win = __expf(mprev - Mt);
      bf16x8 qf[2];
#pragma unroll
      for (int kk = 0; kk < 2; ++kk) qf[kk] = ld_frag16(Qs + t * 72 + 32 * kk + 8 * g);
      float psum = 0.f;
      unsigned pp[4][2];
#pragma unroll
      for (int st = 0; st < 4; ++st) {
        f32x4 sacc = (f32x4){0.f, 0.f, 0.f, 0.f};
        if (st <= tb) {
#pragma unroll
          for (int kk = 0; kk < 2; ++kk) sacc = mfma16(ld_frag16(Ksm + (st * 16 + c) * 72 + 32 * kk + 8 * g), qf[kk], sacc);
#pragma unroll
          for (int rg = 0; rg < 4; ++rg) {
            const int s = st * 16 + 4 * g + rg;
            const float dv = (s <= t) ? __expf(us[s] - Mt) : 0.f;
            sacc[rg] *= dv;
            psum += sacc[rg];
          }
        }
        pp[st][0] = pk_bf16(sacc[0], sacc[1]);
        pp[st][1] = pk_bf16(sacc[2], sacc[3]);
      }
      psum += __shfl_xor(psum, 16);
      psum += __shfl_xor(psum, 32);
      float qn = 0.f;
      {
        const u32x4 q0 = *(const u32x4*)(Qs + t * 72 + 16 * g), q1 = *(const u32x4*)(Qs + t * 72 + 16 * g + 8);
#pragma unroll
        for (int j = 0; j < 4; ++j) {
          qn += bf_lo(q0[j]) * nvv[16 * g + 2 * j] + bf_hi(q0[j]) * nvv[16 * g + 2 * j + 1];
          qn += bf_lo(q1[j]) * nvv[16 * g + 8 + 2 * j] + bf_hi(q1[j]) * nvv[16 * g + 8 + 2 * j + 1];
        }
      }
      qn += __shfl_xor(qn, 16);
      qn += __shfl_xor(qn, 32);
      const float den = win * qn + psum;
      const float mt = bs[t] + Mt;
      const float hs = 1.f / fmaxf(fabsf(den), __expf(-mt));
      bf16x8 pf[2];
#pragma unroll
      for (int kk = 0; kk < 2; ++kk) {
        u32x4 a;
        a[0] = pp[2 * kk][0]; a[1] = pp[2 * kk][1]; a[2] = pp[2 * kk + 1][0]; a[3] = pp[2 * kk + 1][1];
        pf[kk] = as_bf16x8(a);
      }
      const int tok = base + (dir ? 63 - t : t);
#pragma unroll
      for (int vi = 0; vi < 2; ++vi) {
        const int vt = vh * 2 + vi;
        f32x4 o = (f32x4){0.f, 0.f, 0.f, 0.f};
#pragma unroll
        for (int kk = 0; kk < 2; ++kk) o = mfma16(ld_frag16(CT + (vt * 16 + c) * 72 + 32 * kk + 8 * g), qf[kk], o);
        o = o * win;
#pragma unroll
        for (int kk = 0; kk < 2; ++kk) {
          const u16* vrow = VT + (vt * 16 + c) * 66 + 32 * kk + 4 * g;
          o = mfma16(ld_frag4x4(vrow, vrow + 16), pf[kk], o);
        }
        o = o * hs;
        u32x2 ov;
        ov[0] = pk_bf16(o[0], o[1]);
        ov[1] = pk_bf16(o[2], o[3]);
        *(u32x2*)(ob + (size_t)tok * 256 + h * 64 + vt * 16 + 4 * g) = ov;
      }
    }
    __syncthreads();
    {
      const float wold = scl[0];
      const float mnew = scl[1];
      const int vt = w >> 1, dh = w & 1;
#pragma unroll
      for (int i2 = 0; i2 < 2; ++i2) {
        const int dt = 2 * dh + i2, dcol = dt * 16 + c;
        f32x4 a4 = cst[i2] * wold;
#pragma unroll
        for (int kk = 0; kk < 2; ++kk) {
          const u16* ar = VT + (vt * 16 + c) * 66 + 32 * kk + 8 * g;
          const u16* br = KTw + (dt * 16 + c) * 66 + 32 * kk + 8 * g;
          a4 = mfma16(ld_frag4x4(ar, ar + 4), ld_frag4x4(br, br + 4), a4);
        }
        cst[i2] = a4;
#pragma unroll
        for (int rg = 0; rg < 4; ++rg) CT[(vt * 16 + 4 * g + rg) * 72 + dcol] = f2bf(a4[rg]);
      }
      {
        const int dn = tid >> 3, p8 = tid & 7;
        const unsigned* kr = (const unsigned*)(KTw + dn * 66 + p8 * 8);
        float s = 0.f;
#pragma unroll
        for (int j = 0; j < 4; ++j) s += bf_lo(kr[j]) + bf_hi(kr[j]);
        s += __shfl_xor(s, 1);
        s += __shfl_xor(s, 2);
        s += __shfl_xor(s, 4);
        if (p8 == 0) nvv[dn] = wold * nvv[dn] + s;
      }
      mprev = mnew;
    }
    __syncthreads();
  }
}

__device__ void mixer_phase(const Params& p, int layer, char* smem) {
  const int njobs = 256 + 512 + 512 + (layer == 0 ? 128 : 0);
  for (int job = blockIdx.x; job < njobs; job += gridDim.x) {
    if (job < 256) {
      for (int rep = 0; rep < REP_CHAIN; ++rep) {
        if (job < 128) hgrn_chain(p, layer, job, smem);
        else mlstm_chain(p, layer, job - 128, smem);
        __syncthreads();
      }
    } else {
      for (int rep = 0; rep < REP_ATT; ++rep) {
        if (job < 768) attn_job(p, layer, 0, job - 256, smem);
        else if (job < 1280) attn_job(p, layer, 1, job - 768, smem);
        else if (job < 1344) attn_job(p, layer, 2, job - 1280, smem);
        else attn_job(p, layer, 3, job - 1344, smem);
        __syncthreads();
      }
    }
    __syncthreads();
  }
}

__device__ void combine_phase(const Params& p, int layer, int nrows) {
  const int tid_ = opaque_tid();
  const int lane = tid_ & 63, wid = tid_ >> 6;
  const int mixer = lane >> 5;
  const int col = (lane & 31) * 8;
  const float* gsrc = (mixer == 0 ? p.hgrn_g : p.mlstm_g) + layer * 64 + (col & 63);
  float gv[8];
#pragma unroll
  for (int j = 0; j < 8; ++j) gv[j] = gsrc[j];
  for (int row = blockIdx.x * 8 + wid; row < nrows; row += gridDim.x * 8) {
    const u32x4 a = *(const u32x4*)(p.obuf + ((size_t)(mixer * 2 + 0) * NTOK + row) * 256 + col);
    const u32x4 bq = *(const u32x4*)(p.obuf + ((size_t)(mixer * 2 + 1) * NTOK + row) * 256 + col);
    const u32x4 gz = *(const u32x4*)(p.z + (size_t)row * ZW + (mixer == 0 ? HG : MO) + col);
    float o[8];
    float ss = 0.f;
#pragma unroll
    for (int j = 0; j < 4; ++j) {
      o[2 * j] = bf_lo(a[j]) + bf_lo(bq[j]);
      o[2 * j + 1] = bf_hi(a[j]) + bf_hi(bq[j]);
      ss += o[2 * j] * o[2 * j] + o[2 * j + 1] * o[2 * j + 1];
    }
    ss += __shfl_xor(ss, 1);
    ss += __shfl_xor(ss, 2);
    ss += __shfl_xor(ss, 4);
    const float rs = __builtin_amdgcn_rsqf(ss * (1.f / 64.f) + EPSN);
    u32x4 outv;
#pragma unroll
    for (int j = 0; j < 4; ++j) {
      const float z0 = bf_lo(gz[j]), z1 = bf_hi(gz[j]);
      const float g0 = mixer == 0 ? siluf(z0) : sigmf(z0), g1 = mixer == 0 ? siluf(z1) : sigmf(z1);
      outv[j] = pk_bf16(o[2 * j] * rs * gv[2 * j] * g0, o[2 * j + 1] * rs * gv[2 * j + 1] * g1);
    }
    *(u32x4*)(p.xn + (size_t)row * DM + mixer * 256 + col) = outv;
  }
}

__global__ void __launch_bounds__(NTHR) fwd_megakernel(Params p) {
  extern __shared__ __attribute__((aligned(16))) char smem_raw[];
  cg::grid_group grid = cg::this_grid();
  volatile LAS unsigned* xst = (volatile LAS unsigned*)(smem_raw + ST_OFF);
  if (threadIdx.x == 0) { xst[0] = 0u; xst[1] = 0u; }
  __syncthreads();
  const XcdBarrier xb = xcd_barrier_post(p.bar, xst);
#define SEAM() xcd_barrier(xb)
  prologue_phase(p, smem_raw);
  grid.sync();
  for (int l = 0; l < 2; ++l) {
    const int nMr = (l == 0) ? 144 : 128;
    const int nrows2 = (l == 0) ? NTOK : NLAT;
    for (int rep = 0; rep < REP_NORM; ++rep) { norm_phase(p, l, 0, NTOK, smem_raw); SEAM(); }
    for (int rep = 0; rep < REP_GIN; ++rep) { gemm_phase<EPI_IN, 1024>(p, l, p.xn, p.WinT + (size_t)l * ZW * DM, 144, 14); SEAM(); }
    for (int rep = 0; rep < REP_MIXER; ++rep) { mixer_phase(p, l, smem_raw); SEAM(); }
    for (int rep = 0; rep < REP_COMB; ++rep) { combine_phase(p, l, nrows2); SEAM(); }
    gemm_phase<EPI_OUT, 1024>(p, l, p.xn, p.WoutT + (size_t)l * DM * DM, nMr, 4);
    SEAM();
    for (int rep = 0; rep < REP_NORM; ++rep) { norm_phase(p, l, 1, nrows2, smem_raw); SEAM(); }
    for (int rep = 0; rep < REP_MLP1; ++rep) { gemm_phase<EPI_MLP1, 1024>(p, l, p.xn, p.W1T + (size_t)l * HID * DM, nMr, 16); SEAM(); }
    gemm_phase<EPI_MLP2, 4096>(p, l, p.hid, p.W2T + (size_t)l * DM * HID, nMr, 4);
    SEAM();
  }
  for (int e = 0; e < EXTRA_SYNC; ++e) SEAM();
  final_norm_phase(p);
}

extern "C" void kernel_launch(void* const* d_in, const int* in_sizes, int n_in, void* d_out, int out_size, void* d_ws,
                              size_t ws_size, hipStream_t stream) {
  static int grid_blocks = 0;
  if (!grid_blocks) {
    hipFuncSetAttribute((const void*)fwd_megakernel, hipFuncAttributeMaxDynamicSharedMemorySize, LDS_BYTES);
    int dev = 0, cus = 0, per_cu = 0;
    hipGetDevice(&dev);
    hipDeviceGetAttribute(&cus, hipDeviceAttributeMultiprocessorCount, dev);
    hipOccupancyMaxActiveBlocksPerMultiprocessor(&per_cu, fwd_megakernel, NTHR, LDS_BYTES);
    if (per_cu < 1) per_cu = 1;
    if (per_cu > 1) per_cu = 1;
    grid_blocks = cus * per_cu;
  }
  Params p{};
  const float* const* in = (const float* const*)d_in;
  p.x = in[0]; p.c = in[1]; p.ctx = in[2]; p.c_ctx = in[3]; p.w_mod = in[4]; p.b_mod = in[5]; p.g1 = in[6]; p.g2 = in[7];
  p.w_in = in[8]; p.lb_logits = in[9]; p.hgrn_g = in[10]; p.mlstm_b = in[11]; p.mlstm_g = in[12]; p.qn_g = in[13];
  p.kn_g = in[14]; p.rpb = in[15]; p.w_out = in[16]; p.w1 = in[17]; p.w2 = in[18]; p.final_g = in[19];
  p.out = (float*)d_out;
  char* ws = (char*)d_ws;
  size_t off = 0;
  auto take = [&](size_t bytes) { char* r = ws + off; off += (bytes + 255) & ~(size_t)255; return r; };
  p.WinT = (u16*)take((size_t)2 * ZW * DM * 2);
  p.WoutT = (u16*)take((size_t)2 * DM * DM * 2);
  p.W1T = (u16*)take((size_t)2 * HID * DM * 2);
  p.W2T = (u16*)take((size_t)2 * DM * HID * 2);
  p.wg = (float*)take((size_t)2 * 16 * DM * 4);
  p.modv = (float*)take((size_t)2 * 17 * 6 * DM * 4);
  p.ropec = (float*)take((size_t)SEQ * 32 * 4);
  p.ropes = (float*)take((size_t)SEQ * 32 * 4);
  p.gates = (float*)take((size_t)NTOK * 16 * 4);
  p.xcw = (float*)take((size_t)NBATCH * CTXL * DM * 4);
  p.xn = (u16*)take((size_t)NTOK * DM * 2);
  p.z = (u16*)take((size_t)NTOK * ZW * 2);
  p.obuf = (u16*)take((size_t)4 * NTOK * 256 * 2);
  p.hid = p.z;
  p.bar = (unsigned*)take((size_t)XCD_BAR_WORDS * 4);
  if (off > ws_size) fprintf(stderr, "workspace too small: need %zu have %zu\n", off, ws_size);
  (void)hipMemsetAsync(p.bar, 0, (size_t)XCD_BAR_WORDS * 4, stream);
  void* args[] = {&p};
  hipError_t e = hipLaunchCooperativeKernel((const void*)fwd_megakernel, dim3(grid_blocks), dim3(NTHR), args, LDS_BYTES, stream);
  if (e != hipSuccess) fprintf(stderr, "cooperative launch failed: %s (grid %d)\n", hipGetErrorString(e), grid_blocks);
}
```

```cpp
#include <hip/hip_runtime.h>
#include <hip/hip_cooperative_groups.h>
#include <cstdio>
#include <cstdint>
namespace cg = cooperative_groups;

typedef unsigned short u16;
typedef short bf16x8 __attribute__((ext_vector_type(8)));
typedef float f32x4 __attribute__((ext_vector_type(4)));
typedef float f32x16 __attribute__((ext_vector_type(16)));
typedef unsigned u32x4 __attribute__((ext_vector_type(4)));
typedef unsigned u32x2 __attribute__((ext_vector_type(2)));
#define DI __device__ __forceinline__

#ifndef PHASE_LIMIT
#define PHASE_LIMIT 1000
#endif
#define REP_MIXER 1
#define REP_GIN 1
#define REP_MLP1 1
#define REP_PROL 1
#define REP_NORM 1
#define REP_COMB 1
#define REP_CHAIN 1
#define REP_ATT 1
#define EXTRA_SYNC 0

constexpr int DM = 1024, NBATCH = 16, SEQ = 2048, CTXL = 256;
constexpr int NLAT = NBATCH * SEQ;
constexpr int NTOK = NLAT + NBATCH * CTXL;
constexpr int ZW = 3584;
constexpr int INW = 3600;
constexpr int HID = 4096;
constexpr int HQ = 0, HI_ = 256, HG = 512, HFF = 768, HFB = 1024, MQ = 1280, MK = 1536, MV = 1792, MO = 2048,
              GQ = 2304, GK = 2560, GV = 2688, NQ = 2816, NK = 3072, NV = 3328;
constexpr float EPSN = 1e-6f;
constexpr float L2E = 1.4426950408889634f;
constexpr int NTHR = 512;
constexpr int LDS_BYTES = 131072 + 8192 + 16;
constexpr int XCH_OFF = 131072, ST_OFF = 131072 + 8192;

struct Params {
  const float *x, *c, *ctx, *c_ctx, *w_mod, *b_mod, *g1, *g2, *w_in, *lb_logits, *hgrn_g, *mlstm_b, *mlstm_g,
      *qn_g, *kn_g, *rpb, *w_out, *w1, *w2, *final_g;
  float* out;
  u16 *WinT, *WoutT, *W1T, *W2T;
  float *wg, *modv, *ropec, *ropes, *gates, *xcw;
  u16 *xn, *z, *obuf, *hid;
  unsigned* bar;
  float *rowss, *bias1, *rowssF;
  unsigned* cntF;
  u16* xn2;
};

DI unsigned pk_bf16(float a, float b) {
  typedef __bf16 bf2 __attribute__((ext_vector_type(2)));
  typedef float f2 __attribute__((ext_vector_type(2)));
  f2 v = {a, b};
  bf2 r = __builtin_convertvector(v, bf2);
  return __builtin_bit_cast(unsigned, r);
}
DI u16 f2bf(float a) { return (u16)(pk_bf16(a, 0.f) & 0xffffu); }
DI float bf_lo(unsigned u) { return __uint_as_float(u << 16); }
DI float bf_hi(unsigned u) { return __uint_as_float(u & 0xffff0000u); }
DI float bf2f(u16 h) { return __uint_as_float(((unsigned)h) << 16); }
DI f32x16 mfma32(bf16x8 a, bf16x8 b, f32x16 c) { return __builtin_amdgcn_mfma_f32_32x32x16_bf16(a, b, c, 0, 0, 0); }
DI f32x4 mfma16(bf16x8 a, bf16x8 b, f32x4 c) { return __builtin_amdgcn_mfma_f32_16x16x32_bf16(a, b, c, 0, 0, 0); }
DI bf16x8 as_bf16x8(u32x4 v) { return __builtin_bit_cast(bf16x8, v); }
DI float xsum32(float x) { auto r = __builtin_amdgcn_permlane32_swap(__float_as_uint(x), __float_as_uint(x), false, false); return __uint_as_float(r[0]) + __uint_as_float(r[1]); }
DI float xsum16(float x) { auto r = __builtin_amdgcn_permlane16_swap(__float_as_uint(x), __float_as_uint(x), false, false); return __uint_as_float(r[0]) + __uint_as_float(r[1]); }
DI float xmax32(float x) { auto r = __builtin_amdgcn_permlane32_swap(__float_as_uint(x), __float_as_uint(x), false, false); return fmaxf(__uint_as_float(r[0]), __uint_as_float(r[1])); }
DI float bfly32(float lo, float hi) { auto r = __builtin_amdgcn_permlane32_swap(__float_as_uint(lo), __float_as_uint(hi), false, false); return __uint_as_float(r[0]) + __uint_as_float(r[1]); }
DI float bfly16(float lo, float hi) { auto r = __builtin_amdgcn_permlane16_swap(__float_as_uint(lo), __float_as_uint(hi), false, false); return __uint_as_float(r[0]) + __uint_as_float(r[1]); }
DI float wave_sum(float v) {
  v = xsum32(v);
  v = xsum16(v);
#pragma unroll
  for (int o = 8; o > 0; o >>= 1) v += __shfl_xor(v, o);
  return v;
}
DI int opaque_tid() { int t = threadIdx.x; asm volatile("" : "+v"(t)); return t; }
DI void lds_barrier() { asm volatile("s_waitcnt lgkmcnt(0)" ::: "memory"); __builtin_amdgcn_s_barrier(); asm volatile("" ::: "memory"); }
DI float fexp(float x) { return __builtin_amdgcn_exp2f(x * L2E); }
DI float siluf(float x) { return x * __builtin_amdgcn_rcpf(1.f + __expf(-x)); }
DI float sigmf(float x) { return __builtin_amdgcn_rcpf(1.f + __expf(-x)); }

#define XB_TMO      128
#define XB_XCNT(j)  (256  + 64 * (j))
#define XB_XSUB(j)  (1280 + 64 * (j))
#define XB_XGEN(j)  (2304 + 64 * (j))
#define XB_TOP      3328
#define XB_TOPGEN   3392
#define XCD_BAR_WORDS 3456
#define XB_SPIN_CAP (1u << 20)
#define LAS __attribute__((address_space(3)))
DI unsigned xb_ld(unsigned* p) { return __hip_atomic_load(p, __ATOMIC_RELAXED, __HIP_MEMORY_SCOPE_AGENT); }
DI unsigned xb_add(unsigned* p, unsigned v) { return __hip_atomic_fetch_add(p, v, __ATOMIC_RELAXED, __HIP_MEMORY_SCOPE_AGENT); }
DI unsigned xb_xcc_id() { return (unsigned)__builtin_amdgcn_s_getreg((3 << 11) | 20) & 0xFu; }
#define XB_SPIN(cond, bar) do { unsigned _sp = 0; while (cond) { __builtin_amdgcn_s_sleep(1); \
    if ((++_sp & 255u) == 0u) { if (xb_ld(&(bar)[XB_TMO])) break; if (_sp > XB_SPIN_CAP) { atomicAdd(&(bar)[XB_TMO], 1u); break; } } } } while (0)
struct XcdBarrier { unsigned* bar; unsigned x; volatile LAS unsigned* st; };
DI XcdBarrier xcd_barrier_post(unsigned* bar, volatile LAS unsigned* st) {
  XcdBarrier b; b.bar = bar; b.x = xb_xcc_id(); b.st = st;
  if (threadIdx.x == 0) (void)xb_add(&bar[XB_XCNT(b.x)], 1u);
  return b;
}
DI void xcd_barrier_complete(unsigned* bar, unsigned x, unsigned& nloc, unsigned& nx) {
  const unsigned G = gridDim.x * gridDim.y * gridDim.z;
  unsigned sum, cnt, mine, sp = 0u;
  for (;;) {
    sum = 0u; cnt = 0u; mine = 0u;
#pragma unroll
    for (unsigned j = 0; j < 16; ++j) { const unsigned c = xb_ld(&bar[XB_XCNT(j)]); sum += c; cnt += (c > 0u) ? 1u : 0u; mine = (j == x) ? c : mine; }
    if (sum == G) break;
    __builtin_amdgcn_s_sleep(1);
    if ((++sp & 255u) == 0u) { if (xb_ld(&bar[XB_TMO])) break; if (sp > XB_SPIN_CAP) { atomicAdd(&bar[XB_TMO], 1u); break; } }
  }
  nloc = mine > 0u ? mine : 1u; nx = cnt > 0u ? cnt : 1u;
}
DI void xcd_barrier(const XcdBarrier& b) {
  asm volatile("s_waitcnt vmcnt(0)" ::: "memory");
  __syncthreads();
  if (threadIdx.x == 0) {
    unsigned* bar = b.bar;
    __builtin_amdgcn_s_waitcnt(0);
    unsigned nloc = b.st[0], nx = b.st[1];
    if (nloc == 0u) { xcd_barrier_complete(bar, b.x, nloc, nx); b.st[0] = nloc; b.st[1] = nx; }
    const unsigned old = xb_add(&bar[XB_XSUB(b.x)], 1u);
    const unsigned gen = old / nloc;
    if (old + 1u == (gen + 1u) * nloc) {
      __builtin_amdgcn_fence(__ATOMIC_RELEASE, "agent");
      asm volatile("s_waitcnt vmcnt(0)" ::: "memory");
      const unsigned og = xb_add(&bar[XB_TOP], 1u);
      const unsigned tg = og / nx;
      if (og + 1u == (tg + 1u) * nx) xb_add(&bar[XB_TOPGEN], 1u);
      else XB_SPIN(xb_ld(&bar[XB_TOPGEN]) == tg, bar);
      __builtin_amdgcn_fence(__ATOMIC_ACQUIRE, "agent");
      xb_add(&bar[XB_XGEN(b.x)], 1u);
      asm volatile("s_waitcnt vmcnt(0)" ::: "memory");
    } else {
      XB_SPIN(xb_ld(&bar[XB_XGEN(b.x)]) == gen, bar);
      __builtin_amdgcn_fence(__ATOMIC_ACQUIRE, "agent");
      asm volatile("s_waitcnt vmcnt(0)" ::: "memory");
    }
  }
  __syncthreads();
}

namespace gm {
constexpr int BM = 256, BK = 64, HALF = 128, HT = HALF * BK, NXCD = 8, WGM = 8;
DI int lds_byte(int r, int c) {
  int st = (r >> 4) * 2 + (c >> 5), rr = r & 15, cc = c & 31, ob = rr * 64 + cc * 2;
  return st * 1024 + (ob ^ (((ob >> 9) & 1) << 5));
}
DI void stage_rc(int b, int& R, int& C) {
  int st = b / 1024, sb = b % 1024, swz = sb ^ (((sb >> 9) & 1) << 5);
  R = (st >> 1) * 16 + swz / 64;
  C = (st & 1) * 32 + (swz % 64) / 2;
}
}

enum { EPI_IN = 0, EPI_OUT = 1, EPI_MLP1 = 2, EPI_MLP2 = 3, EPI_MLP2F = 4 };

template <int EPI>
DI void gemm_epilogue(const Params& p, int layer, f32x4 (&acc)[2][2][4][2], int brow, int bcol, int pn, int wr, int wc,
                      int fr, int fq, char* smem, int ksplit = -1) {
  using namespace gm;
  if (EPI == EPI_IN) {
    u16* Z = p.z;
    const bool latent = brow < NLAT;
    if (pn == 9 || pn == 10) {
      float* xch = (float*)smem;
#pragma unroll
      for (int ai = 0; ai < 2; ++ai)
#pragma unroll
        for (int m = 0; m < 4; ++m)
#pragma unroll
          for (int bj = 0; bj < 2; ++bj) {
            float s = 0.f;
#pragma unroll
            for (int n = 0; n < 2; ++n)
#pragma unroll
              for (int j = 0; j < 4; ++j) s += acc[ai][bj][m][n][j] * acc[ai][bj][m][n][j];
            s = xsum16(s);
            s = xsum32(s);
            if (fq == 0) xch[(ai * 128 + wr * 64 + m * 16 + fr) * 8 + bj * 4 + wc] = s;
          }
      __syncthreads();
      const float* gq = (pn == 9 ? p.qn_g : p.kn_g) + layer * 64;
#pragma unroll
      for (int ai = 0; ai < 2; ++ai)
#pragma unroll
        for (int m = 0; m < 4; ++m) {
          __builtin_amdgcn_sched_barrier(0);
          const int rl = ai * 128 + wr * 64 + m * 16 + fr;
          const int row = brow + rl;
          const int spos = row & (SEQ - 1);
#pragma unroll
          for (int bj = 0; bj < 2; ++bj) {
            const bool normed = (pn == 9) || (bj == 0);
            float rs = 1.f;
            if (normed) {
              float tot = xch[rl * 8 + bj * 4 + wc] + xch[rl * 8 + bj * 4 + (wc ^ 1)];
              rs = __builtin_amdgcn_rsqf(tot * (1.f / 64.f) + EPSN);
            }
            u32x4 o;
#pragma unroll
            for (int n = 0; n < 2; ++n) {
              const int cih = (wc & 1) * 32 + fq * 8 + n * 4;
              f32x4 v = acc[ai][bj][m][n];
              if (normed) {
                f32x4 g = *(const f32x4*)(gq + cih);
                v = v * rs * g;
                if (latent) {
                  const float2 cs = *(const float2*)(p.ropec + spos * 32 + (cih >> 1));
                  const float2 sn = *(const float2*)(p.ropes + spos * 32 + (cih >> 1));
                  f32x4 r;
                  r[0] = v[0] * cs.x - v[1] * sn.x;
                  r[1] = v[0] * sn.x + v[1] * cs.x;
                  r[2] = v[2] * cs.y - v[3] * sn.y;
                  r[3] = v[2] * sn.y + v[3] * cs.y;
                  v = r;
                }
                if (pn == 9) v = v * 0.125f;
              }
              o[2 * n] = pk_bf16(v[0], v[1]);
              o[2 * n + 1] = pk_bf16(v[2], v[3]);
            }
            *(u32x4*)(Z + (size_t)row * ZW + bcol + bj * 128 + wc * 32 + fq * 8) = o;
          }
        }
    } else {
      const float sc = (pn == 0 || pn == 6 || pn == 11) ? 0.125f : 1.f;
      const bool dosilu = (pn == 0);
#pragma unroll
      for (int ai = 0; ai < 2; ++ai)
#pragma unroll
        for (int m = 0; m < 4; ++m) {
          __builtin_amdgcn_sched_barrier(0);
          const int row = brow + ai * 128 + wr * 64 + m * 16 + fr;
#pragma unroll
          for (int bj = 0; bj < 2; ++bj) {
            u32x4 o;
#pragma unroll
            for (int n = 0; n < 2; ++n) {
              f32x4 v = acc[ai][bj][m][n];
              if (dosilu) {
#pragma unroll
                for (int j = 0; j < 4; ++j) v[j] = siluf(v[j]);
              }
              v = v * sc;
              o[2 * n] = pk_bf16(v[0], v[1]);
              o[2 * n + 1] = pk_bf16(v[2], v[3]);
            }
            *(u32x4*)(Z + (size_t)row * ZW + bcol + bj * 128 + wc * 32 + fq * 8) = o;
          }
        }
    }
  } else if (EPI == EPI_MLP1) {
    const int bidx = (brow < NLAT) ? (brow >> 11) : 16;
    const float* bias = p.bias1 + (size_t)(layer * 17 + bidx) * HID;
    const int colb = bcol + wc * 32 + fq * 8;
    f32x4 bv[2][2];
    float rsv[2][4];
#pragma unroll
    for (int bj = 0; bj < 2; ++bj)
#pragma unroll
      for (int n = 0; n < 2; ++n) bv[bj][n] = *(const f32x4*)(bias + colb + bj * 128 + n * 4);
#pragma unroll
    for (int ai = 0; ai < 2; ++ai)
#pragma unroll
      for (int m = 0; m < 4; ++m) rsv[ai][m] = p.rowss[(size_t)layer * NTOK + brow + ai * 128 + wr * 64 + m * 16 + fr];
#pragma unroll
    for (int ai = 0; ai < 2; ++ai)
#pragma unroll
      for (int m = 0; m < 4; ++m) {
        __builtin_amdgcn_sched_barrier(0);
        const int row = brow + ai * 128 + wr * 64 + m * 16 + fr;
        const float rs = __builtin_amdgcn_rsqf(rsv[ai][m] * (1.f / DM) + EPSN);
#pragma unroll
        for (int bj = 0; bj < 2; ++bj) {
          u32x4 o;
#pragma unroll
          for (int n = 0; n < 2; ++n) {
            f32x4 v = acc[ai][bj][m][n] * rs + bv[bj][n];
#pragma unroll
            for (int j = 0; j < 4; ++j) {
              float r = fmaxf(v[j], 0.f);
              v[j] = r * r;
            }
            o[2 * n] = pk_bf16(v[0], v[1]);
            o[2 * n + 1] = pk_bf16(v[2], v[3]);
          }
          *(u32x4*)(p.hid + (size_t)row * HID + colb + bj * 128) = o;
        }
      }
  } else if (EPI == EPI_MLP2F) {
    const int bidx = brow >> 11;
    const float* gate = p.modv + ((size_t)(layer * 17 + bidx) * 6 + 5) * DM;
    const float* src = p.out + (size_t)brow * DM;
    const int colb = bcol + wc * 32 + fq * 8;
    f32x4 gv[2][2];
#pragma unroll
    for (int bj = 0; bj < 2; ++bj)
#pragma unroll
      for (int n = 0; n < 2; ++n) gv[bj][n] = *(const f32x4*)(gate + colb + bj * 128 + n * 4);
#pragma unroll
    for (int am = 0; am < 4; ++am) {
      const int ai = am >> 1, m0 = (am & 1) * 2;
      __builtin_amdgcn_sched_barrier(0);
      f32x4 xv[2][2][2];
#pragma unroll
      for (int mm = 0; mm < 2; ++mm)
#pragma unroll
        for (int bj = 0; bj < 2; ++bj)
#pragma unroll
          for (int n = 0; n < 2; ++n)
            xv[mm][bj][n] = *(const f32x4*)(src + (size_t)(ai * 128 + wr * 64 + (m0 + mm) * 16 + fr) * DM + colb + bj * 128 + n * 4);
      __builtin_amdgcn_sched_barrier(0);
#pragma unroll
      for (int mm = 0; mm < 2; ++mm) {
        const int m = m0 + mm;
        float ssq = 0.f;
#pragma unroll
        for (int bj = 0; bj < 2; ++bj)
#pragma unroll
          for (int n = 0; n < 2; ++n) {
            const f32x4 o = xv[mm][bj][n] + gv[bj][n] * acc[ai][bj][m][n];
            acc[ai][bj][m][n] = o;
            ssq += o[0] * o[0] + o[1] * o[1] + o[2] * o[2] + o[3] * o[3];
          }
        ssq = xsum16(ssq);
        ssq = xsum32(ssq);
        if (fq == 0) atomicAdd(p.rowssF + brow + ai * 128 + wr * 64 + m * 16 + fr, ssq);
      }
    }
    asm volatile("s_waitcnt vmcnt(0)" ::: "memory");
    __syncthreads();
    if (threadIdx.x == 0) {
      unsigned* cnt = p.cntF + (brow >> 8);
      __builtin_amdgcn_fence(__ATOMIC_RELEASE, "agent");
      __hip_atomic_fetch_add(cnt, 1u, __ATOMIC_RELAXED, __HIP_MEMORY_SCOPE_AGENT);
      unsigned spins = 0;
      while (__hip_atomic_load(cnt, __ATOMIC_RELAXED, __HIP_MEMORY_SCOPE_AGENT) < 4u) {
        __builtin_amdgcn_s_sleep(1);
        if (++spins > (1u << 24)) break;
      }
      __builtin_amdgcn_fence(__ATOMIC_ACQUIRE, "agent");
    }
    __syncthreads();
    float rsv[2][4];
#pragma unroll
    for (int ai = 0; ai < 2; ++ai)
#pragma unroll
      for (int m = 0; m < 4; ++m)
        rsv[ai][m] = __hip_atomic_load(p.rowssF + brow + ai * 128 + wr * 64 + m * 16 + fr, __ATOMIC_RELAXED, __HIP_MEMORY_SCOPE_AGENT);
    f32x4 fg[2][2];
#pragma unroll
    for (int bj = 0; bj < 2; ++bj)
#pragma unroll
      for (int n = 0; n < 2; ++n) fg[bj][n] = *(const f32x4*)(p.final_g + colb + bj * 128 + n * 4);
#pragma unroll
    for (int ai = 0; ai < 2; ++ai)
#pragma unroll
      for (int m = 0; m < 4; ++m) {
        __builtin_amdgcn_sched_barrier(0);
        const float rs = __builtin_amdgcn_rsqf(rsv[ai][m] * (1.f / DM) + EPSN);
        float* drow = p.out + (size_t)(brow + ai * 128 + wr * 64 + m * 16 + fr) * DM;
#pragma unroll
        for (int bj = 0; bj < 2; ++bj)
#pragma unroll
          for (int n = 0; n < 2; ++n) *(f32x4*)(drow + colb + bj * 128 + n * 4) = acc[ai][bj][m][n] * rs * fg[bj][n];
      }
  } else {
    const bool latent = brow < NLAT;
    const int bidx = latent ? (brow >> 11) : 16;
    const float* gate = p.modv + ((size_t)(layer * 17 + bidx) * 6 + (EPI == EPI_OUT ? 2 : 5)) * DM;
    const float* src;
    float* dst;
    if (latent) {
      dst = p.out + (size_t)brow * DM;
      src = (EPI == EPI_OUT && layer == 0) ? p.x + (size_t)brow * DM : dst;
    } else {
      dst = p.xcw + (size_t)(brow - NLAT) * DM;
      src = (EPI == EPI_OUT && layer == 0) ? p.ctx + (size_t)(brow - NLAT) * DM : dst;
    }
    const float* sc2 = p.modv + ((size_t)(layer * 17 + bidx) * 6 + 4) * DM;
    const float* g2 = p.g2 + layer * DM;
    const int colb = bcol + wc * 32 + fq * 8;
    if (EPI == EPI_MLP2 && ksplit >= 0) {
      float* pb = (float*)p.obuf + ((size_t)ksplit * (NBATCH * CTXL) + (brow - NLAT)) * DM;
#pragma unroll
      for (int ai = 0; ai < 2; ++ai)
#pragma unroll
        for (int m = 0; m < 4; ++m) {
          __builtin_amdgcn_sched_barrier(0);
          float* drow = pb + (size_t)(ai * 128 + wr * 64 + m * 16 + fr) * DM;
#pragma unroll
          for (int bj = 0; bj < 2; ++bj)
#pragma unroll
            for (int n = 0; n < 2; ++n) {
              const int col = colb + bj * 128 + n * 4;
              *(f32x4*)(drow + col) = *(const f32x4*)(gate + col) * acc[ai][bj][m][n];
            }
        }
      return;
    }
    f32x4 gv[2][2], gs[2][2];
#pragma unroll
    for (int bj = 0; bj < 2; ++bj)
#pragma unroll
      for (int n = 0; n < 2; ++n) {
        const int col = colb + bj * 128 + n * 4;
        gv[bj][n] = *(const f32x4*)(gate + col);
        if (EPI == EPI_OUT) gs[bj][n] = *(const f32x4*)(g2 + col) * (*(const f32x4*)(sc2 + col) + 1.f);
      }
#pragma unroll
    for (int am = 0; am < 4; ++am) {
      const int ai = am >> 1, m0 = (am & 1) * 2;
      __builtin_amdgcn_sched_barrier(0);
      f32x4 xv[2][2][2];
#pragma unroll
      for (int mm = 0; mm < 2; ++mm)
#pragma unroll
        for (int bj = 0; bj < 2; ++bj)
#pragma unroll
          for (int n = 0; n < 2; ++n)
            xv[mm][bj][n] = *(const f32x4*)(src + (size_t)(ai * 128 + wr * 64 + (m0 + mm) * 16 + fr) * DM + colb + bj * 128 + n * 4);
      __builtin_amdgcn_sched_barrier(0);
#pragma unroll
      for (int mm = 0; mm < 2; ++mm) {
        const int m = m0 + mm;
        const int rl = ai * 128 + wr * 64 + m * 16 + fr;
        float ssq = 0.f;
#pragma unroll
        for (int bj = 0; bj < 2; ++bj) {
          u32x4 ob;
#pragma unroll
          for (int n = 0; n < 2; ++n) {
            const int col = colb + bj * 128 + n * 4;
            f32x4 o = xv[mm][bj][n] + gv[bj][n] * acc[ai][bj][m][n];
            *(f32x4*)(dst + (size_t)rl * DM + col) = o;
            if (EPI == EPI_OUT) {
              ssq += o[0] * o[0] + o[1] * o[1] + o[2] * o[2] + o[3] * o[3];
              o = o * gs[bj][n];
              ob[2 * n] = pk_bf16(o[0], o[1]);
              ob[2 * n + 1] = pk_bf16(o[2], o[3]);
            }
          }
          if (EPI == EPI_OUT) *(u32x4*)(p.xn2 + (size_t)(brow + rl) * DM + colb + bj * 128) = ob;
        }
        if (EPI == EPI_OUT) {
          ssq = xsum16(ssq);
          ssq = xsum32(ssq);
          if (fq == 0) atomicAdd(p.rowss + (size_t)layer * NTOK + brow + rl, ssq);
        }
      }
    }
  }
}

template <int EPI, int K, bool SPLIT = false>
__device__ void gemm_phase(const Params& p, int layer, const u16* __restrict__ A, const u16* __restrict__ Bt, int nM, int nN, int nMsplit = 0) {
  using namespace gm;
  extern __shared__ __attribute__((aligned(16))) unsigned char shm[];
  LAS unsigned char* lds = (LAS unsigned char*)shm;
  constexpr int HTB = HT * 2;
#define SAo(b, h) (((b) * 2 + (h)) * HTB)
#define SBo(b, h) ((4 + (b) * 2 + (h)) * HTB)
#define STAGE(bufoff, gbase, voff)                                                                   \
  do {                                                                                               \
    _Pragma("unroll") for (int _i = 0; _i < 2; ++_i)                                                 \
      __builtin_amdgcn_global_load_lds((const unsigned*)((const char*)(gbase) + (voff)[_i]),         \
                                       (LAS unsigned*)(lds + (bufoff) + ldsw + _i * 8192), 16, 0, 0); \
  } while (0)
#define LDA(dst, b, h)                                                                               \
  do {                                                                                               \
    _Pragma("unroll") for (int m = 0; m < 4; ++m) _Pragma("unroll") for (int k = 0; k < 2; ++k)      \
      dst[m][k] = *(const LAS bf16x8*)(lds + SAo(b, h) + aoff + m * 2048 + k * 1024);                \
  } while (0)
#define LDB(dst, b, h)                                                                               \
  do {                                                                                               \
    _Pragma("unroll") for (int n = 0; n < 2; ++n) _Pragma("unroll") for (int k = 0; k < 2; ++k)      \
      dst[n][k] = *(const LAS bf16x8*)(lds + SBo(b, h) + boff + n * 2048 + k * 1024);                \
  } while (0)
#define MMA(ai, bj, At_, Bt_)                                                                        \
  do {                                                                                               \
    __builtin_amdgcn_s_setprio(1);                                                                   \
    _Pragma("unroll") for (int m = 0; m < 4; ++m) _Pragma("unroll") for (int n = 0; n < 2; ++n)      \
      _Pragma("unroll") for (int k = 0; k < 2; ++k)                                                  \
        acc[ai][bj][m][n] = __builtin_amdgcn_mfma_f32_16x16x32_bf16(Bt_[n][k], At_[m][k], acc[ai][bj][m][n], 0, 0, 0); \
    __builtin_amdgcn_s_setprio(0);                                                                   \
  } while (0)
#define WAIT_V(n) asm volatile("s_waitcnt vmcnt(" #n ")" ::: "memory")
#define WAIT_L(n) asm volatile("s_waitcnt lgkmcnt(" #n ")" ::: "memory")
#define BAR __builtin_amdgcn_s_barrier()
#define SCHED __builtin_amdgcn_sched_barrier(0)

  const int nwg = nM * nN;
  const int tid = opaque_tid(), wid = __builtin_amdgcn_readfirstlane(tid >> 6), lane = tid & 63, wr = wid >> 2, wc = wid & 3;
  constexpr int nt = K / BK;
  unsigned voff[2], voffB[2];
#pragma unroll
  for (int i = 0; i < 2; ++i) {
    int r_, c_;
    stage_rc(tid * 16 + i * 8192, r_, c_);
    voff[i] = (unsigned)(r_ * K + c_) * 2u;
    const int rho = r_ & 31, nn = rho >> 4, ii = rho & 15;
    const int rb = (r_ & ~31) + 8 * (ii >> 2) + 4 * nn + (ii & 3);
    voffB[i] = (unsigned)(rb * K + c_) * 2u;
  }
  const size_t kstep = (size_t)(BK * 2);
  const size_t hstep = (size_t)HALF * K * 2;
  const size_t tstep = 2 * hstep;
  const unsigned ldsw = (unsigned)wid * 1024u;
  const int aoff = lds_byte(wr * 64 + (lane & 15), (lane >> 4) * 8), boff = lds_byte(wc * 32 + (lane & 15), (lane >> 4) * 8);
  auto unit = [&](int i, int& pm, int& pn, int& kq) -> bool {
    const long L = (long)i * gridDim.x + blockIdx.x;
    kq = -1;
    if (SPLIT && L >= nwg) {
      const int u = (int)(L - nwg);
      if (u >= 16 * nMsplit) return false;
      pm = nM + (u >> 4); pn = (u >> 2) & 3; kq = u & 3;
      return true;
    }
    if (L >= nwg) return false;
    int wgid = (int)L;
    {
      const int q = nwg / NXCD, r = nwg % NXCD, xcd = wgid % NXCD, off = wgid / NXCD;
      wgid = (xcd < r ? xcd * (q + 1) : r * (q + 1) + (xcd - r) * q) + off;
    }
    const int nig = WGM * nN, gid = wgid / nig, fm = gid * WGM, gsz = min(nM - fm, WGM);
    pm = fm + ((wgid % nig) % gsz);
    pn = (wgid % nig) / gsz;
    return true;
  };
  int pm, pn, kq, npm = 0, npn = 0, nkq = -1, ui = 0;
  if (!unit(0, pm, pn, kq)) return;
  const char* cA = (const char*)A + (size_t)pm * tstep + (kq > 0 ? (size_t)kq * (K / 4) * 2 : 0);
  const char* cB = (const char*)Bt + (size_t)pn * tstep + (kq > 0 ? (size_t)kq * (K / 4) * 2 : 0);
  f32x4 acc[2][2][4][2];
#pragma unroll
  for (int a = 0; a < 2; ++a)
#pragma unroll
    for (int b = 0; b < 2; ++b)
#pragma unroll
      for (int m = 0; m < 4; ++m)
#pragma unroll
        for (int n = 0; n < 2; ++n) acc[a][b][m][n] = (f32x4){0.f, 0.f, 0.f, 0.f};
  bf16x8 At[4][2], B0[2][2], B1[2][2];
  STAGE(SBo(0, 0), cB, voffB); STAGE(SBo(0, 1), cB + hstep, voffB); STAGE(SAo(0, 0), cA, voff); STAGE(SAo(0, 1), cA + hstep, voff);
  if (wr == 1) BAR;
  WAIT_V(2); BAR;
  STAGE(SBo(1, 0), cB + kstep, voffB); STAGE(SAo(1, 0), cA + kstep, voff); STAGE(SBo(1, 1), cB + hstep + kstep, voffB);
  WAIT_V(6); BAR;
  for (;;) {
    const bool has_next = unit(ui + 1, npm, npn, nkq);
    const char* nA = has_next ? (const char*)A + (size_t)npm * tstep + (nkq > 0 ? (size_t)nkq * (K / 4) * 2 : 0) : cA;
    const char* nB = has_next ? (const char*)Bt + (size_t)npn * tstep + (nkq > 0 ? (size_t)nkq * (K / 4) * 2 : 0) : cB;
    const int ntu = (SPLIT && kq >= 0) ? nt / 4 : nt;
    for (int t = 0; t < ntu; t += 2) {
      const bool last = (t == ntu - 2);
      const char* a1 = cA + (size_t)(t + 1) * kstep;
      const char* a2 = last ? nA : cA + (size_t)(t + 2) * kstep;
      const char* b2 = last ? nB : cB + (size_t)(t + 2) * kstep;
      const char* a3 = a2 + kstep;
      const char* b3 = b2 + kstep;
      LDB(B0, 0, 0); LDB(B1, 0, 1); SCHED; LDA(At, 0, 0); STAGE(SAo(1, 1), a1 + hstep, voff);
      WAIT_V(8); WAIT_L(0); BAR; MMA(0, 0, At, B0); MMA(0, 1, At, B1); BAR; SCHED;
      LDA(At, 0, 1); STAGE(SBo(0, 0), b2, voffB); STAGE(SBo(0, 1), b2 + hstep, voffB); STAGE(SAo(0, 0), a2, voff);
      WAIT_V(8); WAIT_L(0); BAR; MMA(1, 0, At, B0); MMA(1, 1, At, B1); BAR; SCHED;
      LDB(B0, 1, 0); LDB(B1, 1, 1); SCHED; LDA(At, 1, 0); STAGE(SAo(0, 1), a2 + hstep, voff);
      WAIT_V(8); WAIT_L(0); BAR; MMA(0, 0, At, B0); MMA(0, 1, At, B1); BAR; SCHED;
      LDA(At, 1, 1); STAGE(SBo(1, 0), b3, voffB); STAGE(SBo(1, 1), b3 + hstep, voffB); STAGE(SAo(1, 0), a3, voff);
      WAIT_V(8); WAIT_L(0); BAR; MMA(1, 0, At, B0); MMA(1, 1, At, B1); BAR; SCHED;
    }
    if (wr == 0) BAR;
    {
      const int tid2 = opaque_tid(), lane2 = tid2 & 63;
      gemm_epilogue<EPI>(p, layer, acc, pm * BM, pn * BM, pn, wr, wc, lane2 & 15, lane2 >> 4, (char*)shm + XCH_OFF, SPLIT ? kq : -1);
    }
    if (!has_next) break;
#pragma unroll
    for (int a = 0; a < 2; ++a)
#pragma unroll
      for (int b = 0; b < 2; ++b)
#pragma unroll
        for (int m = 0; m < 4; ++m)
#pragma unroll
          for (int n = 0; n < 2; ++n) acc[a][b][m][n] = (f32x4){0.f, 0.f, 0.f, 0.f};
    pm = npm; pn = npn; kq = nkq; cA = nA; cB = nB; ++ui;
    if (wr == 1) BAR;
  }
  WAIT_V(0);
  __syncthreads();
#undef SAo
#undef SBo
#undef STAGE
#undef LDA
#undef LDB
#undef MMA
}

__device__ void transpose_tile(const float* __restrict__ src, int ldsrc, int scol0, int k0, u16* __restrict__ dst, int Kd, int drow0, char* smem) {
  float* ts = (float*)smem;
  const int tid = opaque_tid();
  {
    const int kk = tid >> 4, n4 = (tid & 15) * 4;
#pragma unroll
    for (int i = 0; i < 2; ++i) {
      const int k = kk + 32 * i;
      const f32x4 v = *(const f32x4*)(src + (size_t)(k0 + k) * ldsrc + scol0 + n4);
      ts[k * 65 + n4 + 0] = v[0];
      ts[k * 65 + n4 + 1] = v[1];
      ts[k * 65 + n4 + 2] = v[2];
      ts[k * 65 + n4 + 3] = v[3];
    }
  }
  __syncthreads();
  {
    const int n = tid >> 3, k8 = (tid & 7) * 8;
    u32x4 o;
#pragma unroll
    for (int j = 0; j < 4; ++j) o[j] = pk_bf16(ts[(k8 + 2 * j) * 65 + n], ts[(k8 + 2 * j + 1) * 65 + n]);
    *(u32x4*)(dst + (size_t)(drow0 + n) * Kd + k0 + k8) = o;
  }
  __syncthreads();
}

__device__ void mod_job(const Params& p, int job, char* smem) {
  const int l = job / 96, n0 = (job % 96) * 64;
  float* sc = (float*)smem;
  float* red = (float*)(smem + 17 * 1024 * 4);
  const int tid = opaque_tid();
  for (int i = tid; i < 17 * 1024; i += NTHR) {
    const int r = i >> 10, k = i & 1023;
    const float v = (r < 16) ? p.c[r * 1024 + k] : p.c_ctx[k];
    sc[i] = siluf(v);
  }
  __syncthreads();
  const int col = tid & 63, kq = tid >> 6;
  float acc[17];
#pragma unroll
  for (int r = 0; r < 17; ++r) acc[r] = 0.f;
  const float* w = p.w_mod + (size_t)l * 1024 * 6144 + n0 + col;
  for (int k = kq * 128; k < kq * 128 + 128; k += 16) {
    float wv[16];
#pragma unroll
    for (int u = 0; u < 16; ++u) wv[u] = w[(size_t)(k + u) * 6144];
#pragma unroll
    for (int u = 0; u < 16; ++u)
#pragma unroll
      for (int r = 0; r < 17; ++r) acc[r] += sc[r * 1024 + k + u] * wv[u];
  }
#pragma unroll
  for (int r = 0; r < 17; ++r) red[(kq * 17 + r) * 64 + col] = acc[r];
  __syncthreads();
  for (int i = tid; i < 17 * 64; i += NTHR) {
    const int r = i >> 6, cc = i & 63;
    float s = p.b_mod[l * 6144 + n0 + cc];
#pragma unroll
    for (int q = 0; q < 8; ++q) s += red[(q * 17 + r) * 64 + cc];
    const int n = n0 + cc;
    p.modv[((size_t)(l * 17 + r) * 6 + (n >> 10)) * DM + (n & 1023)] = s;
  }
  __syncthreads();
}

__device__ void bias_job(const Params& p, int l, int job, char* smem) {
  const int n0 = job * 64;
  float* sc = (float*)smem;
  float* red = (float*)(smem + 17 * 1024 * 4);
  const int tid = opaque_tid();
  for (int i = tid; i < 17 * 1024; i += NTHR) {
    const int r = i >> 10, k = i & 1023;
    sc[i] = p.modv[((size_t)(l * 17 + r) * 6 + 3) * DM + k];
  }
  __syncthreads();
  const int col = tid & 63, kq = tid >> 6;
  float acc[17];
#pragma unroll
  for (int r = 0; r < 17; ++r) acc[r] = 0.f;
  const float* w = p.w1 + (size_t)l * DM * HID + n0 + col;
  for (int k = kq * 128; k < kq * 128 + 128; k += 16) {
    float wv[16];
#pragma unroll
    for (int u = 0; u < 16; ++u) wv[u] = w[(size_t)(k + u) * HID];
#pragma unroll
    for (int u = 0; u < 16; ++u)
#pragma unroll
      for (int r = 0; r < 17; ++r) acc[r] += sc[r * 1024 + k + u] * wv[u];
  }
#pragma unroll
  for (int r = 0; r < 17; ++r) red[(kq * 17 + r) * 64 + col] = acc[r];
  __syncthreads();
  for (int i = tid; i < 17 * 64; i += NTHR) {
    const int r = i >> 6, cc = i & 63;
    float sum = 0.f;
#pragma unroll
    for (int q = 0; q < 8; ++q) sum += red[(q * 17 + r) * 64 + cc];
    p.bias1[(size_t)(l * 17 + r) * HID + n0 + cc] = sum;
  }
  __syncthreads();
}

__device__ void prologue_phase(const Params& p, char* smem) {
  constexpr int NJ_MOD = 192, NJ_TR = 6400, NJ_G = 2, NJ_R = 16;
  for (int job = blockIdx.x; job < NJ_MOD + NJ_TR + NJ_G + NJ_R; job += gridDim.x) {
    if (job < NJ_MOD) {
      mod_job(p, job, smem);
    } else if (job < NJ_MOD + NJ_TR) {
      int j = job - NJ_MOD;
      const int l = j / 3200;
      j %= 3200;
      if (j < 896) {
        const int kt = j / 56, nt = j % 56;
        const int scol = nt * 64 + (nt >= 36 ? 16 : 0);
        transpose_tile(p.w_in + (size_t)l * DM * INW, INW, scol, kt * 64, p.WinT + (size_t)l * ZW * DM, DM, nt * 64, smem);
      } else if (j < 896 + 256) {
        j -= 896;
        const int kt = j / 16, nt = j % 16;
        transpose_tile(p.w_out + (size_t)l * DM * DM, DM, nt * 64, kt * 64, p.WoutT + (size_t)l * DM * DM, DM, nt * 64, smem);
      } else if (j < 896 + 256 + 1024) {
        j -= 896 + 256;
        const int kt = j / 64, nt = j % 64;
        transpose_tile(p.w1 + (size_t)l * DM * HID, HID, nt * 64, kt * 64, p.W1T + (size_t)l * HID * DM, DM, nt * 64, smem);
      } else {
        j -= 896 + 256 + 1024;
        const int kt = j / 16, nt = j % 16;
        transpose_tile(p.w2 + (size_t)l * HID * DM, DM, nt * 64, kt * 64, p.W2T + (size_t)l * DM * HID, HID, nt * 64, smem);
      }
    } else if (job < NJ_MOD + NJ_TR + NJ_G) {
      const int l = job - NJ_MOD - NJ_TR;
      for (int i = threadIdx.x; i < 16 * 1024; i += NTHR) {
        const int n = i & 15, k = i >> 4;
        p.wg[(size_t)(l * 16 + n) * DM + k] = p.w_in[(size_t)l * DM * INW + (size_t)k * INW + 2304 + n];
      }
    } else {
      const int j = job - NJ_MOD - NJ_TR - NJ_G;
      for (int i = threadIdx.x; i < 4096; i += NTHR) {
        const int e = j * 4096 + i;
        const int s = e >> 5, idx = e & 31;
        const int row = s >> 6, col = s & 63;
        const int fi = idx & 15;
        const float inv = powf(10000.f, -2.0f * (float)fi / 32.f);
        const float ang = (idx < 16 ? (float)row : (float)col) * inv;
        p.ropec[e] = cosf(ang);
        p.ropes[e] = sinf(ang);
      }
    }
  }
}

__device__ void norm_phase(const Params& p, int layer, int which, int nrows, char* smem) {
  const int tid_ = opaque_tid();
  const int lane = tid_ & 63, wid = tid_ >> 6;
  const float* g = (which == 0 ? p.g1 : p.g2) + layer * DM;
  float* wgs = (float*)smem;
  if (which == 0) {
    const float* wgl = p.wg + (size_t)layer * 16 * DM;
    for (int i = tid_; i < 16 * DM / 4; i += NTHR) *(f32x4*)(wgs + i * 4) = *(const f32x4*)(wgl + i * 4);
    __syncthreads();
  }
  for (int pr = blockIdx.x * 8 + wid; pr < nrows / 2; pr += gridDim.x * 8) {
    const int row0 = pr * 2;
    const bool latent = row0 < NLAT;
    const float* src;
    if (which == 0 && layer == 0) src = latent ? p.x + (size_t)row0 * DM : p.ctx + (size_t)(row0 - NLAT) * DM;
    else src = latent ? p.out + (size_t)row0 * DM : p.xcw + (size_t)(row0 - NLAT) * DM;
    const int bidx = latent ? (row0 >> 11) : 16;
    const float* shift = p.modv + ((size_t)(layer * 17 + bidx) * 6 + (which == 0 ? 0 : 3)) * DM;
    const float* scale = shift + DM;
    f32x4 v[2][4];
    float ss0 = 0.f, ss1 = 0.f;
#pragma unroll
    for (int i = 0; i < 4; ++i) {
      v[0][i] = *(const f32x4*)(src + i * 256 + lane * 4);
      v[1][i] = *(const f32x4*)(src + DM + i * 256 + lane * 4);
    }
    if (which == 0 && layer == 1 && !latent) {
      const float* pb = (const float*)p.obuf + (size_t)(row0 - NLAT) * DM;
#pragma unroll
      for (int q = 0; q < 4; ++q)
#pragma unroll
        for (int i = 0; i < 4; ++i) {
          v[0][i] += *(const f32x4*)(pb + (size_t)q * (NBATCH * CTXL) * DM + i * 256 + lane * 4);
          v[1][i] += *(const f32x4*)(pb + (size_t)q * (NBATCH * CTXL) * DM + DM + i * 256 + lane * 4);
        }
    }
#pragma unroll
    for (int i = 0; i < 4; ++i) {
      ss0 += v[0][i][0] * v[0][i][0] + v[0][i][1] * v[0][i][1] + v[0][i][2] * v[0][i][2] + v[0][i][3] * v[0][i][3];
      ss1 += v[1][i][0] * v[1][i][0] + v[1][i][1] * v[1][i][1] + v[1][i][2] * v[1][i][2] + v[1][i][3] * v[1][i][3];
    }
    ss0 = xsum16(xsum32(ss0)); ss1 = xsum16(xsum32(ss1));
#pragma unroll
    for (int o = 8; o > 0; o >>= 1) { ss0 += __shfl_xor(ss0, o); ss1 += __shfl_xor(ss1, o); }
    const float rs0 = __builtin_amdgcn_rsqf(ss0 * (1.f / DM) + EPSN), rs1 = __builtin_amdgcn_rsqf(ss1 * (1.f / DM) + EPSN);
#pragma unroll
    for (int i = 0; i < 4; ++i) {
      const int c0 = i * 256 + lane * 4;
      const f32x4 gv = *(const f32x4*)(g + c0), sh = *(const f32x4*)(shift + c0), sc = *(const f32x4*)(scale + c0) + 1.f;
      v[0][i] = (v[0][i] * rs0 * gv) * sc + sh;
      v[1][i] = (v[1][i] * rs1 * gv) * sc + sh;
      u32x2 o;
      o[0] = pk_bf16(v[0][i][0], v[0][i][1]);
      o[1] = pk_bf16(v[0][i][2], v[0][i][3]);
      *(u32x2*)(p.xn + (size_t)row0 * DM + c0) = o;
      o[0] = pk_bf16(v[1][i][0], v[1][i][1]);
      o[1] = pk_bf16(v[1][i][2], v[1][i][3]);
      *(u32x2*)(p.xn + (size_t)(row0 + 1) * DM + c0) = o;
    }
    if (which == 0) {
      float a32[32];
      typedef float f32x2 __attribute__((ext_vector_type(2)));
#pragma unroll
      for (int n = 0; n < 16; ++n) {
        f32x2 a0 = {0.f, 0.f}, a1 = {0.f, 0.f};
#pragma unroll
        for (int i = 0; i < 4; ++i) {
          const f32x4 wv = *(const f32x4*)(wgs + n * DM + i * 256 + lane * 4);
          const f32x2 wlo = {wv[0], wv[1]}, whi = {wv[2], wv[3]};
          a0 += (f32x2){v[0][i][0], v[0][i][1]} * wlo;
          a0 += (f32x2){v[0][i][2], v[0][i][3]} * whi;
          a1 += (f32x2){v[1][i][0], v[1][i][1]} * wlo;
          a1 += (f32x2){v[1][i][2], v[1][i][3]} * whi;
        }
        a32[n] = a0[0] + a0[1];
        a32[16 + n] = a1[0] + a1[1];
        if ((n & 1) == 1) __builtin_amdgcn_sched_barrier(0);
      }
#pragma unroll
      for (int i = 0; i < 16; ++i) a32[i] = bfly32(a32[i], a32[i + 16]);
#pragma unroll
      for (int i = 0; i < 8; ++i) a32[i] = bfly16(a32[i], a32[i + 8]);
#pragma unroll
      for (int half = 4; half >= 1; half >>= 1) {
        const int mask = half * 2;
        const bool up = (lane & mask) != 0;
#pragma unroll
        for (int i = 0; i < half; ++i) {
          const float send = up ? a32[i] : a32[i + half];
          const float keep = up ? a32[i + half] : a32[i];
          a32[i] = keep + __shfl_xor(send, mask);
        }
      }
      const float tot = a32[0] + __shfl_xor(a32[0], 1);
      if ((lane & 1) == 0) {
        const int gi = (lane >> 1) & 15;
        p.gates[(size_t)(row0 + (lane >> 5)) * 16 + gi] = tot + p.mlstm_b[layer * 16 + gi];
      }
    }
  }
}

__device__ void final_norm_phase(const Params& p) {
  const int tid_ = opaque_tid();
  const int lane = tid_ & 63, wid = tid_ >> 6;
  for (int row = blockIdx.x * 8 + wid; row < NLAT; row += gridDim.x * 8) {
    float* src = p.out + (size_t)row * DM;
    f32x4 v[4];
    float ss = 0.f;
#pragma unroll
    for (int i = 0; i < 4; ++i) {
      v[i] = *(const f32x4*)(src + i * 256 + lane * 4);
      ss += v[i][0] * v[i][0] + v[i][1] * v[i][1] + v[i][2] * v[i][2] + v[i][3] * v[i][3];
    }
    ss = wave_sum(ss);
    const float rs = __builtin_amdgcn_rsqf(ss * (1.f / DM) + EPSN);
#pragma unroll
    for (int i = 0; i < 4; ++i) {
      const int c0 = i * 256 + lane * 4;
      const f32x4 gv = *(const f32x4*)(p.final_g + c0);
      *(f32x4*)(src + c0) = v[i] * rs * gv;
    }
  }
}

constexpr int KS_STRIDE = 72, VT_STRIDE = 66;
DI bf16x8 ld_frag16(const u16* base) { return *(const bf16x8*)base; }
DI bf16x8 ld_frag4x4(const u16* a, const u16* b) {
  u32x4 r;
  const unsigned* pa = (const unsigned*)a;
  const unsigned* pb = (const unsigned*)b;
  r[0] = pa[0]; r[1] = pa[1]; r[2] = pb[0]; r[3] = pb[1];
  return as_bf16x8(r);
}


#define TRR(i, off) "ds_read_b64_tr_b16 %" #i ", %16 offset:" #off "\n\t"
DI void tr_read_vtile(u32x2 (&r)[16], unsigned addr) {
  asm volatile(
      TRR(0, 0)     TRR(1, 1152)  TRR(2, 64)    TRR(3, 1216)
      TRR(4, 2304)  TRR(5, 3456)  TRR(6, 2368)  TRR(7, 3520)
      TRR(8, 4608)  TRR(9, 5760)  TRR(10, 4672) TRR(11, 5824)
      TRR(12, 6912) TRR(13, 8064) TRR(14, 6976) TRR(15, 8128)
      "s_waitcnt lgkmcnt(0)"
      : "=&v"(r[0]), "=&v"(r[1]), "=&v"(r[2]), "=&v"(r[3]), "=&v"(r[4]), "=&v"(r[5]), "=&v"(r[6]), "=&v"(r[7]),
        "=&v"(r[8]), "=&v"(r[9]), "=&v"(r[10]), "=&v"(r[11]), "=&v"(r[12]), "=&v"(r[13]), "=&v"(r[14]), "=&v"(r[15])
      : "v"(addr)
      : "memory");
}

DI void tr_read_vtile8(u32x2 (&r)[8], unsigned addr) {
  asm volatile(
      "ds_read_b64_tr_b16 %0, %8 offset:0\n\tds_read_b64_tr_b16 %1, %8 offset:1152\n\t"
      "ds_read_b64_tr_b16 %2, %8 offset:64\n\tds_read_b64_tr_b16 %3, %8 offset:1216\n\t"
      "ds_read_b64_tr_b16 %4, %8 offset:2304\n\tds_read_b64_tr_b16 %5, %8 offset:3456\n\t"
      "ds_read_b64_tr_b16 %6, %8 offset:2368\n\tds_read_b64_tr_b16 %7, %8 offset:3520\n\t"
      "s_waitcnt lgkmcnt(0)"
      : "=&v"(r[0]), "=&v"(r[1]), "=&v"(r[2]), "=&v"(r[3]), "=&v"(r[4]), "=&v"(r[5]), "=&v"(r[6]), "=&v"(r[7])
      : "v"(addr)
      : "memory");
}

template <int NB>
DI void softmax_pv(f32x16 (&s)[2], float& mrun, float& lsum, f32x16 (&O)[2], unsigned vaddr) {
  u32x2 vf[16];
  u32x2 vf8[8];
  if (NB == 2) tr_read_vtile(vf, vaddr);
  else tr_read_vtile8(vf8, vaddr);
  float mx = -1e30f;
#pragma unroll
  for (int kb = 0; kb < NB; ++kb)
#pragma unroll
    for (int e = 0; e < 16; ++e) mx = fmaxf(mx, s[kb][e]);
  mx = xmax32(mx);
  constexpr float THR = 6.f;
  float alpha = 1.f;
  if (__builtin_amdgcn_ballot_w64(mx - mrun > THR) != 0ull) {
    const float mnew = fmaxf(mrun, mx);
    alpha = __builtin_amdgcn_exp2f((mrun - mnew) * L2E);
    mrun = mnew;
#pragma unroll
    for (int e = 0; e < 16; ++e) { O[0][e] *= alpha; O[1][e] *= alpha; }
  }
  typedef float f32x2 __attribute__((ext_vector_type(2)));
  const float mb = mrun * L2E;
  f32x2 ps2 = {0.f, 0.f};
  const f32x2 l2e2 = {L2E, L2E}, mb2 = {mb, mb};
  if (NB == 2) {
#pragma unroll
    for (int kb = 0; kb < 2; ++kb) {
#pragma unroll
      for (int e = 0; e < 16; e += 2) {
        f32x2 t = {s[kb][e], s[kb][e + 1]};
        t = t * l2e2 - mb2;
        f32x2 pv;
        pv[0] = __builtin_amdgcn_exp2f(t[0]);
        pv[1] = __builtin_amdgcn_exp2f(t[1]);
        s[kb][e] = pv[0];
        s[kb][e + 1] = pv[1];
        ps2 += pv;
      }
      u32x4 pp[2];
#pragma unroll
      for (int st = 0; st < 2; ++st)
#pragma unroll
        for (int j = 0; j < 4; ++j) pp[st][j] = pk_bf16(s[kb][8 * st + 2 * j], s[kb][8 * st + 2 * j + 1]);
      __builtin_amdgcn_sched_barrier(0);
      __builtin_amdgcn_s_setprio(1);
#pragma unroll
      for (int st = 0; st < 2; ++st) {
        const bf16x8 pf = as_bf16x8(pp[st]);
#pragma unroll
        for (int db = 0; db < 2; ++db) {
          const int ix = ((kb * 2 + st) * 2 + db) * 2;
          u32x4 av;
          av[0] = vf[ix][0]; av[1] = vf[ix][1]; av[2] = vf[ix + 1][0]; av[3] = vf[ix + 1][1];
          O[db] = mfma32(as_bf16x8(av), pf, O[db]);
        }
      }
      __builtin_amdgcn_s_setprio(0);
      __builtin_amdgcn_sched_barrier(0);
    }
  } else {
#pragma unroll
    for (int e = 0; e < 16; e += 2) {
      f32x2 t = {s[0][e], s[0][e + 1]};
      t = t * l2e2 - mb2;
      f32x2 pv;
      pv[0] = __builtin_amdgcn_exp2f(t[0]);
      pv[1] = __builtin_amdgcn_exp2f(t[1]);
      s[0][e] = pv[0];
      s[0][e + 1] = pv[1];
      ps2 += pv;
    }
    __builtin_amdgcn_s_setprio(1);
#pragma unroll
    for (int st = 0; st < 2; ++st) {
      u32x4 pp;
#pragma unroll
      for (int j = 0; j < 4; ++j) pp[j] = pk_bf16(s[0][8 * st + 2 * j], s[0][8 * st + 2 * j + 1]);
      const bf16x8 pf = as_bf16x8(pp);
#pragma unroll
      for (int db = 0; db < 2; ++db) {
        const int ix = (st * 2 + db) * 2;
        u32x4 av;
        av[0] = vf8[ix][0]; av[1] = vf8[ix][1]; av[2] = vf8[ix + 1][0]; av[3] = vf8[ix + 1][1];
        O[db] = mfma32(as_bf16x8(av), pf, O[db]);
      }
    }
    __builtin_amdgcn_s_setprio(0);
  }
  lsum = lsum * alpha + (ps2[0] + ps2[1]);
}

template <int kind>
__device__ void attn_job(const Params& p, int layer, int idx, char* smem) {
  u16* Ks = (u16*)smem;
  u16* Vt = (u16*)(smem + 2 * 64 * KS_STRIDE * 2);
  float* rpbs = (float*)(smem + 4 * 64 * KS_STRIDE * 2);
  const int tid = opaque_tid(), lane = tid & 63, w = __builtin_amdgcn_readfirstlane(tid >> 6), tq = lane & 31, hh = lane >> 5;
  int b, qtok, qcol, ocol, kcol, vcol, nlat = 0, lat0 = 0, R0 = 0, hN = 0;
  int qrow_l = 0, qc = 0, k0 = 0, r0A = 0, r0l = 0;
  if (kind == 0) {
    b = idx >> 5; const int kvh = (idx >> 4) & 1, qt = idx & 15;
    const int head = kvh * 2 + (w >> 2);
    qtok = b * SEQ + qt * 128 + (w & 3) * 32 + tq; qcol = GQ + head * 64; ocol = 512 + head * 64;
    kcol = GK + kvh * 64; vcol = GV + kvh * 64; nlat = 32; lat0 = b * SEQ;
  } else if (kind == 1) {
    b = idx >> 5; hN = (idx >> 3) & 3; const int rg = idx & 7;
    const int rA = rg * 4 + 2 * (w >> 2), cb = w & 3;
    qrow_l = rA + (tq >> 4); qc = 16 * cb + (tq & 15);
    qtok = b * SEQ + qrow_l * 64 + qc; qcol = NQ + hN * 64; ocol = 768 + hN * 64;
    kcol = NK + hN * 64; vcol = NV + hN * 64;
    R0 = min(max(rg * 4 - 4, 0), 24);
    const int R1 = min(max(rg * 4 + 3 - 4, 0), 24) + 8;
    nlat = R1 - R0; lat0 = b * SEQ + R0 * 64;
    k0 = min(max(16 * cb - 8, 0), 32);
    r0A = min(max(rA - 4, 0), 24);
    r0l = min(max(qrow_l - 4, 0), 24);
  } else if (kind == 2) {
    b = idx >> 2; const int kvh = (idx >> 1) & 1, half = idx & 1;
    const int head = kvh * 2 + (w >> 2);
    qtok = NLAT + b * CTXL + half * 128 + (w & 3) * 32 + tq; qcol = GQ + head * 64; ocol = 512 + head * 64;
    kcol = GK + kvh * 64; vcol = GV + kvh * 64;
  } else {
    b = idx >> 2; hN = idx & 3;
    qtok = NLAT + b * CTXL + w * 32 + tq; qcol = NQ + hN * 64; ocol = 768 + hN * 64;
    kcol = NK + hN * 64; vcol = NV + hN * 64;
  }
  const int ntiles = 4 + nlat;
  const u16* Z = p.z;
  if (kind == 1) {
    for (int i = tid; i < 16 + 15 * 32 + 32; i += NTHR) {
      const int j = i - 16, rr = j >> 5, cc = j & 31;
      rpbs[i] = (j >= 0 && rr < 15 && cc < 31) ? p.rpb[((size_t)(layer * 4 + hN) * 15 + rr) * 31 + cc] : 0.f;
    }
  }
  bf16x8 qf[4];
#pragma unroll
  for (int st = 0; st < 4; ++st) qf[st] = *(const bf16x8*)(Z + (size_t)qtok * ZW + qcol + 16 * st + 8 * hh);
  unsigned colmask = 0;
  int dcbase = 0;
  if (kind == 1) {
    const int cs = min(max(qc - 8, 0), 48);
#pragma unroll
    for (int e = 0; e < 16; ++e) {
      const int kc = k0 + (e & 3) + 8 * (e >> 2) + 4 * hh;
      colmask |= ((kc >= cs) && (kc < cs + 16)) ? (1u << e) : 0u;
    }
    dcbase = 16 + k0 + 4 * hh - qc + 15;
  }
  float mrun = -1e30f, lsum = 0.f;
  f32x16 O[2], zero16;
#pragma unroll
  for (int i = 0; i < 16; ++i) { O[0][i] = 0.f; O[1][i] = 0.f; zero16[i] = 0.f; }
  asm volatile("" : "+v"(zero16));
  const int lkey = tid >> 3, lc = tid & 7;
  const unsigned vlane_off = (unsigned)((4 * (lane >> 5) + ((lane & 15) >> 2)) * (KS_STRIDE * 2) + (((lane >> 4) & 1) * 16 + 4 * (lane & 3)) * 2);
  auto tile_row0 = [&](int i) { return (i < 4) ? (NLAT + b * CTXL + i * 64) : (lat0 + (i - 4) * 64); };
  u32x4 kreg, vreg;
  {
    const size_t ro = (size_t)(tile_row0(0) + lkey) * ZW;
    kreg = *(const u32x4*)(Z + ro + kcol + lc * 8);
    vreg = *(const u32x4*)(Z + ro + vcol + lc * 8);
  }
  for (int i = 0; i < ntiles; ++i) {
    u16* Kb = Ks + (i & 1) * 64 * KS_STRIDE;
    u16* Vb = Vt + (i & 1) * 64 * KS_STRIDE;
    *(u32x4*)(Kb + lkey * KS_STRIDE + lc * 8) = kreg;
    *(u32x4*)(Vb + lkey * KS_STRIDE + lc * 8) = vreg;
    lds_barrier();
    if (i + 1 < ntiles) {
      const size_t ro = (size_t)(tile_row0(i + 1) + lkey) * ZW;
      kreg = *(const u32x4*)(Z + ro + kcol + lc * 8);
      vreg = *(const u32x4*)(Z + ro + vcol + lc * 8);
    }
    if (kind == 1 && i >= 4) {
      const int kr = R0 + i - 4;
      if (kr >= r0A && kr < r0A + 9) {
        f32x16 s[2];
#pragma unroll
        for (int st = 0; st < 4; ++st) s[0] = mfma32(ld_frag16(Kb + (k0 + tq) * KS_STRIDE + 16 * st + 8 * hh), qf[st], st == 0 ? zero16 : s[0]);
        const bool rowvalid = (kr >= r0l) && (kr < r0l + 8);
        const unsigned m = rowvalid ? colmask : 0u;
        const float* brow = rpbs + (kr - qrow_l + 7) * 32 + dcbase;
#pragma unroll
        for (int e = 0; e < 16; ++e) {
          const float bias = brow[(e & 3) + 8 * (e >> 2)];
          s[0][e] = ((m >> e) & 1u) ? s[0][e] + bias : -1e30f;
        }
        softmax_pv<1>(s, mrun, lsum, O, (unsigned)(size_t)Vb + vlane_off + (unsigned)(k0 * KS_STRIDE * 2));
      }
    } else {
      f32x16 s[2];
      __builtin_amdgcn_s_setprio(1);
#pragma unroll
      for (int kb = 0; kb < 2; ++kb) {
#pragma unroll
        for (int st = 0; st < 4; ++st) s[kb] = mfma32(ld_frag16(Kb + (kb * 32 + tq) * KS_STRIDE + 16 * st + 8 * hh), qf[st], st == 0 ? zero16 : s[kb]);
      }
      __builtin_amdgcn_s_setprio(0);
      softmax_pv<2>(s, mrun, lsum, O, (unsigned)(size_t)Vb + vlane_off);
    }
  }
  lsum = xsum32(lsum);
  const float inv = 1.f / lsum;
  u16* dst = p.xn + (size_t)qtok * DM + ocol;
#pragma unroll
  for (int db = 0; db < 2; ++db)
#pragma unroll
    for (int g4 = 0; g4 < 4; ++g4) {
      u32x2 o;
      o[0] = pk_bf16(O[db][4 * g4 + 0] * inv, O[db][4 * g4 + 1] * inv);
      o[1] = pk_bf16(O[db][4 * g4 + 2] * inv, O[db][4 * g4 + 3] * inv);
      *(u32x2*)(dst + db * 32 + 8 * g4 + 4 * hh) = o;
    }
  __syncthreads();
}

__device__ void hgrn_chain(const Params& p, int layer, int idx, char* smem) {
  const int b = idx >> 3, h = (idx >> 1) & 3, dir = idx & 1;
  u16* Qs0 = (u16*)smem;
  u16* Qs1 = (u16*)(smem + 92928);
  u16* VT0 = (u16*)(smem + 9216);
  u16* VT1 = (u16*)(smem + 75264);
  float* bb = (float*)(smem + 17664);
  u16* KD = (u16*)(smem + 34304);
  u16* KE = (u16*)(smem + 43520);
  u16* KdT = (u16*)(smem + 52736);
  u16* ST0 = (u16*)(smem + 61184);
  u16* ST1 = (u16*)(smem + 83712);
  float* tot = (float*)(smem + 70400);
  float* bend = (float*)(smem + 72448);
  float* Ftab = (float*)(smem + 72704);
  float* rtab = (float*)(smem + 74240);
  const int tid = opaque_tid(), lane = tid & 63, w = __builtin_amdgcn_readfirstlane(tid >> 6), c = lane & 15, g = lane >> 4;
  const int d_ = tid & 63, part = w;
  const int lrow = tid >> 3, c8 = tid & 7;
  float lb = 0.f;
  if (layer == 1) {
    const float l0 = p.lb_logits[(0 * 2 + dir) * 256 + h * 64 + d_], l1 = p.lb_logits[(1 * 2 + dir) * 256 + h * 64 + d_];
    lb = 1.f / (1.f + __expf(l0 - l1));
  }
  const int fcol = (dir ? HFB : HFF) + h * 64;
  const u16* Z = p.z;
  u16* ob = p.obuf + (size_t)(0 * 2 + dir) * NTOK * 256;
  f32x4 cst[2];
  cst[0] = (f32x4){0.f, 0.f, 0.f, 0.f};
  cst[1] = cst[0];
  for (int i = tid; i < 64 * 72; i += NTHR) ST0[i] = 0;
  auto chunk_base = [&](int i) {
    if (i < 4) { const int cc = dir ? 3 - i : i; return NLAT + b * CTXL + cc * 64; }
    const int cc = dir ? 31 - (i - 4) : (i - 4);
    return b * SEQ + cc * 64;
  };
  u32x4 nq, nv;
  u16 nf[8];
  {
    const int base = chunk_base(0);
    const size_t ro = (size_t)(base + (dir ? 63 - lrow : lrow)) * ZW;
    nq = *(const u32x4*)(Z + ro + HQ + h * 64 + c8 * 8);
    nv = *(const u32x4*)(Z + ro + HI_ + h * 64 + c8 * 8);
#pragma unroll
    for (int e = 0; e < 8; ++e) {
      const int t = part * 8 + e;
      nf[e] = Z[(size_t)(base + (dir ? 63 - t : t)) * ZW + fcol + d_];
    }
  }
  __syncthreads();
  for (int i = 0; i < 36; ++i) {
    const int base = chunk_base(i);
    u16* VT = (i & 1) ? VT1 : VT0;
    u16* Qs = (i & 1) ? Qs1 : Qs0;
    const u16* ST = (i & 1) ? ST1 : ST0;
    u16* STn = (i & 1) ? ST0 : ST1;
    *(u32x4*)(Qs + lrow * 72 + c8 * 8) = nq;
#pragma unroll
    for (int j = 0; j < 4; ++j) {
      VT[(c8 * 8 + 2 * j) * 66 + lrow] = (u16)(nv[j] & 0xffffu);
      VT[(c8 * 8 + 2 * j + 1) * 66 + lrow] = (u16)(nv[j] >> 16);
    }
    float cl[8], kf[8];
    {
      float cum = 0.f;
#pragma unroll
      for (int e = 0; e < 8; ++e) {
        const float f = bf2f(nf[e]);
        const float ef = __expf(-f);
        const float sig = __builtin_amdgcn_rcpf(1.f + ef);
        const float forget = lb + (1.f - lb) * sig;
        cum += __logf(fmaxf(forget, 1e-20f));
        cl[e] = cum;
        kf[e] = (1.f - lb) * (ef * sig);
      }
      tot[part * 64 + d_] = cum;
    }
    lds_barrier();
    if (i + 1 < 36) {
      const int nb = chunk_base(i + 1);
      const size_t ro = (size_t)(nb + (dir ? 63 - lrow : lrow)) * ZW;
      nq = *(const u32x4*)(Z + ro + HQ + h * 64 + c8 * 8);
      nv = *(const u32x4*)(Z + ro + HI_ + h * 64 + c8 * 8);
#pragma unroll
      for (int e = 0; e < 8; ++e) {
        const int t = part * 8 + e;
        nf[e] = Z[(size_t)(nb + (dir ? 63 - t : t)) * ZW + fcol + d_];
      }
    }
    {
      const int jsub = part >> 1;
      float off = 0.f, bendv = 0.f, rj = 0.f, rj1 = 0.f, r1 = 0.f, r2 = 0.f, r3 = 0.f;
#pragma unroll
      for (int q = 0; q < 8; ++q) {
        const float tv = tot[q * 64 + d_];
        bendv += tv;
        if (q < part) off += tv;
        if (q < 2 * jsub) rj += tv;
        if (q < 2 * jsub + 2) rj1 += tv;
        if (q < 2) r1 += tv;
        if (q < 4) r2 += tv;
        if (q < 6) r3 += tv;
      }
      float kd[8];
      const float e_next = __expf(rj1 - rj), e_end = __expf(bendv - rj);
#pragma unroll
      for (int e = 0; e < 8; ++e) {
        const int t = part * 8 + e;
        const float bv = off + cl[e];
        bb[t * 65 + d_] = bv;
        const float kE = kf[e] * __expf(fminf(rj - bv, 80.f));
        kd[e] = kE * e_end;
        KD[t * 72 + d_] = f2bf(kE);
        KE[t * 72 + d_] = f2bf(kE * e_next);
      }
      unsigned* kdp = (unsigned*)(KdT + d_ * 66 + part * 8);
#pragma unroll
      for (int j = 0; j < 4; ++j) kdp[j] = pk_bf16(kd[2 * j], kd[2 * j + 1]);
      if (part == 0) Ftab[0 * 64 + d_] = __expf(r1);
      else if (part == 1) Ftab[1 * 64 + d_] = __expf(r2);
      else if (part == 2) Ftab[2 * 64 + d_] = __expf(r3);
      else if (part == 3) Ftab[3 * 64 + d_] = __expf(r2 - r1);
      else if (part == 4) Ftab[4 * 64 + d_] = __expf(r3 - r1);
      else if (part == 5) Ftab[5 * 64 + d_] = __expf(r3 - r2);
      else if (part == 6) { rtab[d_] = 0.f; rtab[64 + d_] = r1; rtab[128 + d_] = r2; rtab[192 + d_] = r3; }
      else bend[d_] = bendv;
    }
    lds_barrier();
    {
      const int tb = (w < 4) ? w : 7 - w, vh = w >> 2;
      const int t = tb * 16 + c;
      float qtf[2][8];
      bf16x8 qd[2], qe[2];
#pragma unroll
      for (int kk = 0; kk < 2; ++kk) {
        const u32x4 qraw = *(const u32x4*)(Qs + t * 72 + 32 * kk + 8 * g);
        u32x4 a, e2;
#pragma unroll
        for (int j = 0; j < 4; ++j) {
          const int d0 = 32 * kk + 8 * g + 2 * j;
          const float r0 = rtab[tb * 64 + d0], r1 = rtab[tb * 64 + d0 + 1];
          const float b0 = bb[t * 65 + d0], b1 = bb[t * 65 + d0 + 1];
          const float e0 = tb ? Ftab[(tb - 1) * 64 + d0] : 1.f, e1 = tb ? Ftab[(tb - 1) * 64 + d0 + 1] : 1.f;
          const float q0 = bf_lo(qraw[j]) * __expf(b0 - r0), q1 = bf_hi(qraw[j]) * __expf(b1 - r1);
          qtf[kk][2 * j] = q0;
          qtf[kk][2 * j + 1] = q1;
          a[j] = pk_bf16(q0, q1);
          e2[j] = pk_bf16(q0 * e0, q1 * e1);
        }
        qd[kk] = as_bf16x8(a);
        qe[kk] = as_bf16x8(e2);
      }
      unsigned pp[4][2];
#pragma unroll
      for (int st = 0; st < 4; ++st) {
        f32x4 sacc = (f32x4){0.f, 0.f, 0.f, 0.f};
        if (st <= tb) {
          const int s = st * 16 + c;
          if (st == tb) {
#pragma unroll
            for (int kk = 0; kk < 2; ++kk) sacc = mfma16(ld_frag16(KD + s * 72 + 32 * kk + 8 * g), qd[kk], sacc);
#pragma unroll
            for (int rg = 0; rg < 4; ++rg)
              if (4 * g + rg > c) sacc[rg] = 0.f;
          } else if (st + 1 == tb) {
#pragma unroll
            for (int kk = 0; kk < 2; ++kk) sacc = mfma16(ld_frag16(KE + s * 72 + 32 * kk + 8 * g), qd[kk], sacc);
          } else {
            const float* F = Ftab + ((tb == 2) ? 3 : 4 + st) * 64;
#pragma unroll
            for (int kk = 0; kk < 2; ++kk) {
              u32x4 bq;
#pragma unroll
              for (int j = 0; j < 4; ++j) {
                const int d0 = 32 * kk + 8 * g + 2 * j;
                bq[j] = pk_bf16(qtf[kk][2 * j] * F[d0], qtf[kk][2 * j + 1] * F[d0 + 1]);
              }
              sacc = mfma16(ld_frag16(KE + s * 72 + 32 * kk + 8 * g), as_bf16x8(bq), sacc);
            }
          }
        }
        pp[st][0] = pk_bf16(sacc[0], sacc[1]);
        pp[st][1] = pk_bf16(sacc[2], sacc[3]);
      }
      bf16x8 pf[2];
#pragma unroll
      for (int kk = 0; kk < 2; ++kk) {
        u32x4 a;
        a[0] = pp[2 * kk][0]; a[1] = pp[2 * kk][1]; a[2] = pp[2 * kk + 1][0]; a[3] = pp[2 * kk + 1][1];
        pf[kk] = as_bf16x8(a);
      }
      const int tok = base + (dir ? 63 - t : t);
#pragma unroll
      for (int vi = 0; vi < 2; ++vi) {
        const int vt = vh * 2 + vi;
        f32x4 o = (f32x4){0.f, 0.f, 0.f, 0.f};
#pragma unroll
        for (int kk = 0; kk < 2; ++kk) {
          const bf16x8 a = ld_frag16(ST + (vt * 16 + c) * 72 + 32 * kk + 8 * g);
          o = mfma16(a, qe[kk], o);
          const u16* vrow = VT + (vt * 16 + c) * 66 + 32 * kk + 4 * g;
          const bf16x8 a2 = ld_frag4x4(vrow, vrow + 16);
          o = mfma16(a2, pf[kk], o);
        }
        u32x2 ov;
        ov[0] = pk_bf16(o[0], o[1]);
        ov[1] = pk_bf16(o[2], o[3]);
        *(u32x2*)(ob + (size_t)tok * 256 + h * 64 + vt * 16 + 4 * g) = ov;
      }
    }
    {
      const int vt = w >> 1, dh = w & 1;
#pragma unroll
      for (int i2 = 0; i2 < 2; ++i2) {
        const int dt = 2 * dh + i2, dcol = dt * 16 + c;
        const float dec = __expf(bend[dcol]);
        f32x4 a4 = cst[i2] * dec;
#pragma unroll
        for (int kk = 0; kk < 2; ++kk) {
          const u16* ar = VT + (vt * 16 + c) * 66 + 32 * kk + 8 * g;
          const u16* br = KdT + (dt * 16 + c) * 66 + 32 * kk + 8 * g;
          a4 = mfma16(ld_frag4x4(ar, ar + 4), ld_frag4x4(br, br + 4), a4);
        }
        cst[i2] = a4;
#pragma unroll
        for (int rg = 0; rg < 4; ++rg) STn[(vt * 16 + 4 * g + rg) * 72 + dcol] = f2bf(a4[rg]);
      }
    }
  }
}

__device__ void mlstm_chain(const Params& p, int layer, int idx, char* smem) {
  const int b = idx >> 3, h = (idx >> 1) & 3, dir = idx & 1;
  u16* Qs0 = (u16*)smem;
  u16* Ksm0 = (u16*)(smem + 9216);
  u16* VTb = (u16*)(smem + 18432);
  u16* KTwb = (u16*)(smem + 26880);
  u16* CT0 = (u16*)(smem + 35328);
  float* nvv0 = (float*)(smem + 44544);
  float* bsA = (float*)(smem + 45056);
  float* usA = (float*)(smem + 45056 + 9216);
  float* cmA = (float*)(smem + 45056 + 18432);
  const int tid = opaque_tid(), lane = tid & 63, w = __builtin_amdgcn_readfirstlane(tid >> 6), c = lane & 15, g = lane >> 4;
  const int lrow = tid >> 3, c8 = tid & 7;
  const u16* Z = p.z;
  u16* ob = p.obuf + (size_t)(2 + dir) * NTOK * 256;
  f32x4 cst[2];
  cst[0] = (f32x4){0.f, 0.f, 0.f, 0.f};
  cst[1] = cst[0];
  for (int i = tid; i < 64 * 72; i += NTHR) CT0[i] = 0;
  if (tid < 64) nvv0[tid] = 0.f;
  float mprev = 0.f;
  auto chunk_base = [&](int i) {
    if (i < 4) { const int cc = dir ? 3 - i : i; return NLAT + b * CTXL + cc * 64; }
    const int cc = dir ? 31 - (i - 4) : (i - 4);
    return b * SEQ + cc * 64;
  };
  for (int ci = w; ci < 36; ci += 8) {
    const size_t tg = (size_t)(chunk_base(ci) + (dir ? 63 - lane : lane)) * 16;
    const float ig = p.gates[tg + dir * 4 + h], fg = p.gates[tg + 8 + dir * 4 + h];
    const float lf = fminf(fg, 0.f) - __logf(1.f + __expf(-fabsf(fg)));
    float bc = lf;
#pragma unroll
    for (int o = 1; o < 64; o <<= 1) {
      const float t = __shfl_up(bc, o);
      if (lane >= o) bc += t;
    }
    const float u = ig - bc;
    float cm = u;
#pragma unroll
    for (int o = 1; o < 64; o <<= 1) {
      const float t = __shfl_up(cm, o);
      if (lane >= o) cm = fmaxf(cm, t);
    }
    bsA[ci * 64 + lane] = bc;
    usA[ci * 64 + lane] = u;
    cmA[ci * 64 + lane] = cm;
  }
  u32x4 nq, nk, nv;
  {
    const int base = chunk_base(0);
    const size_t ro = (size_t)(base + (dir ? 63 - lrow : lrow)) * ZW;
    nq = *(const u32x4*)(Z + ro + MQ + h * 64 + c8 * 8);
    nk = *(const u32x4*)(Z + ro + MK + h * 64 + c8 * 8);
    nv = *(const u32x4*)(Z + ro + MV + h * 64 + c8 * 8);
  }
  __syncthreads();
  for (int i = 0; i < 36; ++i) {
    const int base = chunk_base(i);
    u16* VT = (i & 1) ? (u16*)(smem + 72704) : VTb;
    u16* KTw = (i & 1) ? (u16*)(smem + 72704 + 8448) : KTwb;
    u16* Qs = (i & 1) ? (u16*)(smem + 89600) : Qs0;
    u16* Ksm = (i & 1) ? (u16*)(smem + 98816) : Ksm0;
    const u16* CT = (i & 1) ? (const u16*)(smem + 108032) : CT0;
    u16* CTn = (i & 1) ? CT0 : (u16*)(smem + 108032);
    const float* nvv = (i & 1) ? (const float*)(smem + 117248) : nvv0;
    float* nvn = (i & 1) ? nvv0 : (float*)(smem + 117248);
    const float* bs = bsA + i * 64;
    const float* us = usA + i * 64;
    const float* cms = cmA + i * 64;
    const float Mend = fmaxf(mprev, cms[63]);
    const float wold = __expf(mprev - Mend);
    const float mnew = bs[63] + Mend;
    *(u32x4*)(Qs + lrow * 72 + c8 * 8) = nq;
    *(u32x4*)(Ksm + lrow * 72 + c8 * 8) = nk;
    {
      const float ws = __expf(us[lrow] - Mend);
#pragma unroll
      for (int j = 0; j < 4; ++j) {
        VT[(c8 * 8 + 2 * j) * 66 + lrow] = (u16)(nv[j] & 0xffffu);
        VT[(c8 * 8 + 2 * j + 1) * 66 + lrow] = (u16)(nv[j] >> 16);
        KTw[(c8 * 8 + 2 * j) * 66 + lrow] = f2bf(bf_lo(nk[j]) * ws);
        KTw[(c8 * 8 + 2 * j + 1) * 66 + lrow] = f2bf(bf_hi(nk[j]) * ws);
      }
    }
    lds_barrier();
    if (i + 1 < 36) {
      const int nb = chunk_base(i + 1);
      const size_t ro = (size_t)(nb + (dir ? 63 - lrow : lrow)) * ZW;
      nq = *(const u32x4*)(Z + ro + MQ + h * 64 + c8 * 8);
      nk = *(const u32x4*)(Z + ro + MK + h * 64 + c8 * 8);
      nv = *(const u32x4*)(Z + ro + MV + h * 64 + c8 * 8);
    }
    {
      const int tb = (w < 4) ? w : 7 - w, vh = w >> 2;
      const int t = tb * 16 + c;
      const float Mt = fmaxf(mprev, cms[t]);
      const float win = __expf(mprev - Mt);
      bf16x8 qf[2];
#pragma unroll
      for (int kk = 0; kk < 2; ++kk) qf[kk] = ld_frag16(Qs + t * 72 + 32 * kk + 8 * g);
      float psum = 0.f;
      unsigned pp[4][2];
#pragma unroll
      for (int st = 0; st < 4; ++st) {
        f32x4 sacc = (f32x4){0.f, 0.f, 0.f, 0.f};
        if (st <= tb) {
#pragma unroll
          for (int kk = 0; kk < 2; ++kk) sacc = mfma16(ld_frag16(Ksm + (st * 16 + c) * 72 + 32 * kk + 8 * g), qf[kk], sacc);
#pragma unroll
          for (int rg = 0; rg < 4; ++rg) {
            const int s = st * 16 + 4 * g + rg;
            const float dv = (s <= t) ? __expf(us[s] - Mt) : 0.f;
            sacc[rg] *= dv;
            psum += sacc[rg];
          }
        }
        pp[st][0] = pk_bf16(sacc[0], sacc[1]);
        pp[st][1] = pk_bf16(sacc[2], sacc[3]);
      }
      psum = xsum16(psum);
      psum = xsum32(psum);
      float qn = 0.f;
      {
        const u32x4 q0 = *(const u32x4*)(Qs + t * 72 + 16 * g), q1 = *(const u32x4*)(Qs + t * 72 + 16 * g + 8);
#pragma unroll
        for (int j = 0; j < 4; ++j) {
          qn += bf_lo(q0[j]) * nvv[16 * g + 2 * j] + bf_hi(q0[j]) * nvv[16 * g + 2 * j + 1];
          qn += bf_lo(q1[j]) * nvv[16 * g + 8 + 2 * j] + bf_hi(q1[j]) * nvv[16 * g + 8 + 2 * j + 1];
        }
      }
      qn = xsum16(qn);
      qn = xsum32(qn);
      const float den = win * qn + psum;
      const float mt = bs[t] + Mt;
      const float hs = __builtin_amdgcn_rcpf(fmaxf(fabsf(den), __expf(-mt)));
      bf16x8 pf[2];
#pragma unroll
      for (int kk = 0; kk < 2; ++kk) {
        u32x4 a;
        a[0] = pp[2 * kk][0]; a[1] = pp[2 * kk][1]; a[2] = pp[2 * kk + 1][0]; a[3] = pp[2 * kk + 1][1];
        pf[kk] = as_bf16x8(a);
      }
      const int tok = base + (dir ? 63 - t : t);
#pragma unroll
      for (int vi = 0; vi < 2; ++vi) {
        const int vt = vh * 2 + vi;
        f32x4 o = (f32x4){0.f, 0.f, 0.f, 0.f};
#pragma unroll
        for (int kk = 0; kk < 2; ++kk) o = mfma16(ld_frag16(CT + (vt * 16 + c) * 72 + 32 * kk + 8 * g), qf[kk], o);
        o = o * win;
#pragma unroll
        for (int kk = 0; kk < 2; ++kk) {
          const u16* vrow = VT + (vt * 16 + c) * 66 + 32 * kk + 4 * g;
          o = mfma16(ld_frag4x4(vrow, vrow + 16), pf[kk], o);
        }
        o = o * hs;
        u32x2 ov;
        ov[0] = pk_bf16(o[0], o[1]);
        ov[1] = pk_bf16(o[2], o[3]);
        *(u32x2*)(ob + (size_t)tok * 256 + h * 64 + vt * 16 + 4 * g) = ov;
      }
    }
    {
      const int vt = w >> 1, dh = w & 1;
#pragma unroll
      for (int i2 = 0; i2 < 2; ++i2) {
        const int dt = 2 * dh + i2, dcol = dt * 16 + c;
        f32x4 a4 = cst[i2] * wold;
#pragma unroll
        for (int kk = 0; kk < 2; ++kk) {
          const u16* ar = VT + (vt * 16 + c) * 66 + 32 * kk + 8 * g;
          const u16* br = KTw + (dt * 16 + c) * 66 + 32 * kk + 8 * g;
          a4 = mfma16(ld_frag4x4(ar, ar + 4), ld_frag4x4(br, br + 4), a4);
        }
        cst[i2] = a4;
#pragma unroll
        for (int rg = 0; rg < 4; ++rg) CTn[(vt * 16 + 4 * g + rg) * 72 + dcol] = f2bf(a4[rg]);
      }
      {
        const int dn = tid >> 3, p8 = tid & 7;
        const unsigned* kr = (const unsigned*)(KTw + dn * 66 + p8 * 8);
        float s = 0.f;
#pragma unroll
        for (int j = 0; j < 4; ++j) s += bf_lo(kr[j]) + bf_hi(kr[j]);
        s += __shfl_xor(s, 1);
        s += __shfl_xor(s, 2);
        s += __shfl_xor(s, 4);
        if (p8 == 0) nvn[dn] = wold * nvv[dn] + s;
      }
      mprev = mnew;
    }
  }
}

__device__ void mixer_phase(const Params& p, int layer, char* smem) {
  const int natt = 256 + 512 + 512 + (layer == 0 ? 128 : 0);
  const int njobs = natt + 64;
  volatile LAS unsigned* slot = (volatile LAS unsigned*)(smem + ST_OFF + 8);
  unsigned* ctr = p.bar + XCD_BAR_WORDS + 64 * layer;
  for (;;) {
    if (threadIdx.x == 0) *slot = atomicAdd(ctr, 1u);
    __syncthreads();
    int job = (int)*slot;
    __syncthreads();
    if (job >= njobs) break;
    if (job >= 256 && job < 320) {
      bias_job(p, layer, job - 256, smem);
      continue;
    }
    if (job >= 320) job -= 64;
    if (job < 256) {
      for (int rep = 0; rep < REP_CHAIN; ++rep) {
        if (job < 128) hgrn_chain(p, layer, job, smem);
        else mlstm_chain(p, layer, job - 128, smem);
        __syncthreads();
      }
    } else {
      for (int rep = 0; rep < REP_ATT; ++rep) {
        if (job < 768) attn_job<0>(p, layer, job - 256, smem);
        else if (job < 1280) attn_job<1>(p, layer, job - 768, smem);
        else if (job < 1344) attn_job<2>(p, layer, job - 1280, smem);
        else attn_job<3>(p, layer, job - 1344, smem);
        __syncthreads();
      }
    }
  }
}

__device__ void combine_phase(const Params& p, int layer, int nrows) {
  const int tid_ = opaque_tid();
  const int lane = tid_ & 63, wid = tid_ >> 6;
  const int mixer = lane >> 5;
  const int col = (lane & 31) * 8;
  const float* gsrc = (mixer == 0 ? p.hgrn_g : p.mlstm_g) + layer * 64 + (col & 63);
  float gv[8];
#pragma unroll
  for (int j = 0; j < 8; ++j) gv[j] = gsrc[j];
  for (int row = blockIdx.x * 8 + wid; row < nrows; row += gridDim.x * 8) {
    const u32x4 a = *(const u32x4*)(p.obuf + ((size_t)(mixer * 2 + 0) * NTOK + row) * 256 + col);
    const u32x4 bq = *(const u32x4*)(p.obuf + ((size_t)(mixer * 2 + 1) * NTOK + row) * 256 + col);
    const u32x4 gz = *(const u32x4*)(p.z + (size_t)row * ZW + (mixer == 0 ? HG : MO) + col);
    float o[8];
    float ss = 0.f;
#pragma unroll
    for (int j = 0; j < 4; ++j) {
      o[2 * j] = bf_lo(a[j]) + bf_lo(bq[j]);
      o[2 * j + 1] = bf_hi(a[j]) + bf_hi(bq[j]);
      ss += o[2 * j] * o[2 * j] + o[2 * j + 1] * o[2 * j + 1];
    }
    ss += __shfl_xor(ss, 1);
    ss += __shfl_xor(ss, 2);
    ss += __shfl_xor(ss, 4);
    const float rs = __builtin_amdgcn_rsqf(ss * (1.f / 64.f) + EPSN);
    u32x4 outv;
#pragma unroll
    for (int j = 0; j < 4; ++j) {
      const float z0 = bf_lo(gz[j]), z1 = bf_hi(gz[j]);
      const float g0 = mixer == 0 ? siluf(z0) : sigmf(z0), g1 = mixer == 0 ? siluf(z1) : sigmf(z1);
      outv[j] = pk_bf16(o[2 * j] * rs * gv[2 * j] * g0, o[2 * j + 1] * rs * gv[2 * j + 1] * g1);
    }
    *(u32x4*)(p.xn + (size_t)row * DM + mixer * 256 + col) = outv;
  }
}

__global__ void __launch_bounds__(NTHR) fwd_megakernel(Params p) {
  extern __shared__ __attribute__((aligned(16))) char smem_raw[];
  cg::grid_group grid = cg::this_grid();
  volatile LAS unsigned* xst = (volatile LAS unsigned*)(smem_raw + ST_OFF);
  if (threadIdx.x == 0) { xst[0] = 0u; xst[1] = 0u; }
  __syncthreads();
  const XcdBarrier xb = xcd_barrier_post(p.bar, xst);
#define SEAM() xcd_barrier(xb)
  prologue_phase(p, smem_raw);
  grid.sync();
  for (int l = 0; l < 2; ++l) {
    const int nMr = (l == 0) ? 144 : 128;
    const int nrows2 = (l == 0) ? NTOK : NLAT;
    for (int rep = 0; rep < REP_NORM; ++rep) { norm_phase(p, l, 0, NTOK, smem_raw); SEAM(); }
    for (int rep = 0; rep < REP_GIN; ++rep) { gemm_phase<EPI_IN, 1024>(p, l, p.xn, p.WinT + (size_t)l * ZW * DM, 144, 14); SEAM(); }
    for (int rep = 0; rep < REP_MIXER; ++rep) { mixer_phase(p, l, smem_raw); SEAM(); }
    for (int rep = 0; rep < REP_COMB; ++rep) { combine_phase(p, l, nrows2); SEAM(); }
    gemm_phase<EPI_OUT, 1024>(p, l, p.xn, p.WoutT + (size_t)l * DM * DM, nMr, 4);
    SEAM();
    for (int rep = 0; rep < REP_MLP1; ++rep) { gemm_phase<EPI_MLP1, 1024>(p, l, p.xn2, p.W1T + (size_t)l * HID * DM, nMr, 16); SEAM(); }
    if (l == 0) gemm_phase<EPI_MLP2, 4096, true>(p, l, p.hid, p.W2T + (size_t)l * DM * HID, 128, 4, 16);
    else if (gridDim.x == 256) gemm_phase<EPI_MLP2F, 4096>(p, l, p.hid, p.W2T + (size_t)l * DM * HID, nMr, 4);
    else { gemm_phase<EPI_MLP2, 4096>(p, l, p.hid, p.W2T + (size_t)l * DM * HID, nMr, 4); SEAM(); final_norm_phase(p); }
    if (l == 0) SEAM();
  }
  for (int e = 0; e < EXTRA_SYNC; ++e) SEAM();
}

extern "C" void kernel_launch(void* const* d_in, const int* in_sizes, int n_in, void* d_out, int out_size, void* d_ws,
                              size_t ws_size, hipStream_t stream) {
  static int grid_blocks = 0;
  if (!grid_blocks) {
    hipFuncSetAttribute((const void*)fwd_megakernel, hipFuncAttributeMaxDynamicSharedMemorySize, LDS_BYTES);
    int dev = 0, cus = 0, per_cu = 0;
    hipGetDevice(&dev);
    hipDeviceGetAttribute(&cus, hipDeviceAttributeMultiprocessorCount, dev);
    hipOccupancyMaxActiveBlocksPerMultiprocessor(&per_cu, fwd_megakernel, NTHR, LDS_BYTES);
    if (per_cu < 1) per_cu = 1;
    if (per_cu > 1) per_cu = 1;
    grid_blocks = cus * per_cu;
  }
  Params p{};
  const float* const* in = (const float* const*)d_in;
  p.x = in[0]; p.c = in[1]; p.ctx = in[2]; p.c_ctx = in[3]; p.w_mod = in[4]; p.b_mod = in[5]; p.g1 = in[6]; p.g2 = in[7];
  p.w_in = in[8]; p.lb_logits = in[9]; p.hgrn_g = in[10]; p.mlstm_b = in[11]; p.mlstm_g = in[12]; p.qn_g = in[13];
  p.kn_g = in[14]; p.rpb = in[15]; p.w_out = in[16]; p.w1 = in[17]; p.w2 = in[18]; p.final_g = in[19];
  p.out = (float*)d_out;
  char* ws = (char*)d_ws;
  size_t off = 0;
  auto take = [&](size_t bytes) { char* r = ws + off; off += (bytes + 255) & ~(size_t)255; return r; };
  p.WinT = (u16*)take((size_t)2 * ZW * DM * 2);
  p.WoutT = (u16*)take((size_t)2 * DM * DM * 2);
  p.W1T = (u16*)take((size_t)2 * HID * DM * 2);
  p.W2T = (u16*)take((size_t)2 * DM * HID * 2);
  p.wg = (float*)take((size_t)2 * 16 * DM * 4);
  p.modv = (float*)take((size_t)2 * 17 * 6 * DM * 4);
  p.ropec = (float*)take((size_t)SEQ * 32 * 4);
  p.ropes = (float*)take((size_t)SEQ * 32 * 4);
  p.gates = (float*)take((size_t)NTOK * 16 * 4);
  p.xcw = (float*)take((size_t)NBATCH * CTXL * DM * 4);
  p.z = (u16*)take((size_t)NTOK * ZW * 2);
  p.xn = (u16*)take((size_t)NTOK * DM * 2);
  p.obuf = (u16*)take((size_t)4 * NTOK * 256 * 2);
  p.hid = p.z;
  p.xn2 = p.obuf;
  p.bias1 = (float*)take((size_t)2 * 17 * HID * 4);
  p.bar = (unsigned*)take((size_t)(XCD_BAR_WORDS + 128 + 2 * NTOK + NLAT + 128) * 4);
  p.rowss = (float*)(p.bar + XCD_BAR_WORDS + 128);
  p.rowssF = p.rowss + 2 * NTOK;
  p.cntF = (unsigned*)(p.rowssF + NLAT);
  if (off > ws_size) fprintf(stderr, "workspace too small: need %zu have %zu\n", off, ws_size);
  (void)hipMemsetAsync(p.bar, 0, (size_t)(XCD_BAR_WORDS + 128 + 2 * NTOK + NLAT + 128) * 4, stream);
  void* args[] = {&p};
  hipError_t e = hipLaunchCooperativeKernel((const void*)fwd_megakernel, dim3(grid_blocks), dim3(NTHR), args, LDS_BYTES, stream);
  if (e != hipSuccess) fprintf(stderr, "cooperative launch failed: %s (grid %d)\n", hipGetErrorString(e), grid_blocks);
}
```

```cpp
#include <hip/hip_runtime.h>
#include <hip/hip_cooperative_groups.h>
#include <cstdio>
#include <cstdint>
namespace cg = cooperative_groups;

typedef unsigned short u16;
typedef short bf16x8 __attribute__((ext_vector_type(8)));
typedef float f32x4 __attribute__((ext_vector_type(4)));
typedef float f32x16 __attribute__((ext_vector_type(16)));
typedef unsigned u32x4 __attribute__((ext_vector_type(4)));
typedef unsigned u32x2 __attribute__((ext_vector_type(2)));
#define DI __device__ __forceinline__

#ifndef PHASE_LIMIT
#define PHASE_LIMIT 1000
#endif
#define REP_MIXER 1
#define REP_GIN 1
#define REP_MLP1 1
#define REP_PROL 1
#define REP_NORM 1
#define REP_COMB 1
#define REP_CHAIN 1
#define REP_ATT 1
#define EXTRA_SYNC 0

constexpr int DM = 1024, NBATCH = 16, SEQ = 2048, CTXL = 256;
constexpr int NLAT = NBATCH * SEQ;
constexpr int NTOK = NLAT + NBATCH * CTXL;
constexpr int ZW = 3584;
constexpr int INW = 3600;
constexpr int HID = 4096;
constexpr int HQ = 0, HI_ = 256, HG = 512, HFF = 768, HFB = 1024, MQ = 1280, MK = 1536, MV = 1792, MO = 2048,
              GQ = 2304, GK = 2560, GV = 2688, NQ = 2816, NK = 3072, NV = 3328;
constexpr float EPSN = 1e-6f;
constexpr float L2E = 1.4426950408889634f;
constexpr int NTHR = 512;
constexpr int LDS_BYTES = 131072 + 8192 + 16;
constexpr int XCH_OFF = 131072, ST_OFF = 131072 + 8192;

struct Params {
  const float *x, *c, *ctx, *c_ctx, *w_mod, *b_mod, *g1, *g2, *w_in, *lb_logits, *hgrn_g, *mlstm_b, *mlstm_g,
      *qn_g, *kn_g, *rpb, *w_out, *w1, *w2, *final_g;
  float* out;
  u16 *WinT, *WoutT, *W1T, *W2T;
  float *wg, *modv, *ropec, *ropes, *gates, *xcw;
  u16 *xn, *z, *obuf, *hid;
  unsigned* bar;
  float *rowss, *bias1, *rowssF;
  unsigned* cntF;
  u16* xn2;
};

DI unsigned pk_bf16(float a, float b) {
  typedef __bf16 bf2 __attribute__((ext_vector_type(2)));
  typedef float f2 __attribute__((ext_vector_type(2)));
  f2 v = {a, b};
  bf2 r = __builtin_convertvector(v, bf2);
  return __builtin_bit_cast(unsigned, r);
}
DI u16 f2bf(float a) { return (u16)(pk_bf16(a, 0.f) & 0xffffu); }
DI float bf_lo(unsigned u) { return __uint_as_float(u << 16); }
DI float bf_hi(unsigned u) { return __uint_as_float(u & 0xffff0000u); }
DI float bf2f(u16 h) { return __uint_as_float(((unsigned)h) << 16); }
DI f32x16 mfma32(bf16x8 a, bf16x8 b, f32x16 c) { return __builtin_amdgcn_mfma_f32_32x32x16_bf16(a, b, c, 0, 0, 0); }
DI f32x4 mfma16(bf16x8 a, bf16x8 b, f32x4 c) { return __builtin_amdgcn_mfma_f32_16x16x32_bf16(a, b, c, 0, 0, 0); }
DI bf16x8 as_bf16x8(u32x4 v) { return __builtin_bit_cast(bf16x8, v); }
DI float xsum32(float x) { auto r = __builtin_amdgcn_permlane32_swap(__float_as_uint(x), __float_as_uint(x), false, false); return __uint_as_float(r[0]) + __uint_as_float(r[1]); }
DI float xsum16(float x) { auto r = __builtin_amdgcn_permlane16_swap(__float_as_uint(x), __float_as_uint(x), false, false); return __uint_as_float(r[0]) + __uint_as_float(r[1]); }
DI float xmax32(float x) { auto r = __builtin_amdgcn_permlane32_swap(__float_as_uint(x), __float_as_uint(x), false, false); return fmaxf(__uint_as_float(r[0]), __uint_as_float(r[1])); }
DI float bfly32(float lo, float hi) { auto r = __builtin_amdgcn_permlane32_swap(__float_as_uint(lo), __float_as_uint(hi), false, false); return __uint_as_float(r[0]) + __uint_as_float(r[1]); }
DI float bfly16(float lo, float hi) { auto r = __builtin_amdgcn_permlane16_swap(__float_as_uint(lo), __float_as_uint(hi), false, false); return __uint_as_float(r[0]) + __uint_as_float(r[1]); }
DI float wave_sum(float v) {
  v = xsum32(v);
  v = xsum16(v);
#pragma unroll
  for (int o = 8; o > 0; o >>= 1) v += __shfl_xor(v, o);
  return v;
}
DI int opaque_tid() { int t = threadIdx.x; asm volatile("" : "+v"(t)); return t; }
DI void lds_barrier() { asm volatile("s_waitcnt lgkmcnt(0)" ::: "memory"); __builtin_amdgcn_s_barrier(); asm volatile("" ::: "memory"); }
DI float fexp(float x) { return __builtin_amdgcn_exp2f(x * L2E); }
DI float siluf(float x) { return x * __builtin_amdgcn_rcpf(1.f + __expf(-x)); }
DI float sigmf(float x) { return __builtin_amdgcn_rcpf(1.f + __expf(-x)); }

#define XB_TMO      128
#define XB_XCNT(j)  (256  + 64 * (j))
#define XB_XSUB(j)  (1280 + 64 * (j))
#define XB_XGEN(j)  (2304 + 64 * (j))
#define XB_TOP      3328
#define XB_TOPGEN   3392
#define XCD_BAR_WORDS 3456
#define XB_SPIN_CAP (1u << 20)
#define LAS __attribute__((address_space(3)))
DI unsigned xb_ld(unsigned* p) { return __hip_atomic_load(p, __ATOMIC_RELAXED, __HIP_MEMORY_SCOPE_AGENT); }
DI unsigned xb_add(unsigned* p, unsigned v) { return __hip_atomic_fetch_add(p, v, __ATOMIC_RELAXED, __HIP_MEMORY_SCOPE_AGENT); }
DI unsigned xb_xcc_id() { return (unsigned)__builtin_amdgcn_s_getreg((3 << 11) | 20) & 0xFu; }
#define XB_SPIN(cond, bar) do { unsigned _sp = 0; while (cond) { __builtin_amdgcn_s_sleep(1); \
    if ((++_sp & 255u) == 0u) { if (xb_ld(&(bar)[XB_TMO])) break; if (_sp > XB_SPIN_CAP) { atomicAdd(&(bar)[XB_TMO], 1u); break; } } } } while (0)
struct XcdBarrier { unsigned* bar; unsigned x; volatile LAS unsigned* st; };
DI XcdBarrier xcd_barrier_post(unsigned* bar, volatile LAS unsigned* st) {
  XcdBarrier b; b.bar = bar; b.x = xb_xcc_id(); b.st = st;
  if (threadIdx.x == 0) (void)xb_add(&bar[XB_XCNT(b.x)], 1u);
  return b;
}
DI void xcd_barrier_complete(unsigned* bar, unsigned x, unsigned& nloc, unsigned& nx) {
  const unsigned G = gridDim.x * gridDim.y * gridDim.z;
  unsigned sum, cnt, mine, sp = 0u;
  for (;;) {
    sum = 0u; cnt = 0u; mine = 0u;
#pragma unroll
    for (unsigned j = 0; j < 16; ++j) { const unsigned c = xb_ld(&bar[XB_XCNT(j)]); sum += c; cnt += (c > 0u) ? 1u : 0u; mine = (j == x) ? c : mine; }
    if (sum == G) break;
    __builtin_amdgcn_s_sleep(1);
    if ((++sp & 255u) == 0u) { if (xb_ld(&bar[XB_TMO])) break; if (sp > XB_SPIN_CAP) { atomicAdd(&bar[XB_TMO], 1u); break; } }
  }
  nloc = mine > 0u ? mine : 1u; nx = cnt > 0u ? cnt : 1u;
}
DI void xcd_barrier(const XcdBarrier& b) {
  asm volatile("s_waitcnt vmcnt(0)" ::: "memory");
  __syncthreads();
  if (threadIdx.x == 0) {
    unsigned* bar = b.bar;
    __builtin_amdgcn_s_waitcnt(0);
    unsigned nloc = b.st[0], nx = b.st[1];
    if (nloc == 0u) { xcd_barrier_complete(bar, b.x, nloc, nx); b.st[0] = nloc; b.st[1] = nx; }
    const unsigned old = xb_add(&bar[XB_XSUB(b.x)], 1u);
    const unsigned gen = old / nloc;
    if (old + 1u == (gen + 1u) * nloc) {
      __builtin_amdgcn_fence(__ATOMIC_RELEASE, "agent");
      asm volatile("s_waitcnt vmcnt(0)" ::: "memory");
      const unsigned og = xb_add(&bar[XB_TOP], 1u);
      const unsigned tg = og / nx;
      if (og + 1u == (tg + 1u) * nx) xb_add(&bar[XB_TOPGEN], 1u);
      else XB_SPIN(xb_ld(&bar[XB_TOPGEN]) == tg, bar);
      __builtin_amdgcn_fence(__ATOMIC_ACQUIRE, "agent");
      xb_add(&bar[XB_XGEN(b.x)], 1u);
      asm volatile("s_waitcnt vmcnt(0)" ::: "memory");
    } else {
      XB_SPIN(xb_ld(&bar[XB_XGEN(b.x)]) == gen, bar);
      __builtin_amdgcn_fence(__ATOMIC_ACQUIRE, "agent");
      asm volatile("s_waitcnt vmcnt(0)" ::: "memory");
    }
  }
  __syncthreads();
}

namespace gm {
constexpr int BM = 256, BK = 64, HALF = 128, HT = HALF * BK, NXCD = 8, WGM = 8;
DI int lds_byte(int r, int c) {
  int st = (r >> 4) * 2 + (c >> 5), rr = r & 15, cc = c & 31, ob = rr * 64 + cc * 2;
  return st * 1024 + (ob ^ (((ob >> 9) & 1) << 5));
}
DI void stage_rc(int b, int& R, int& C) {
  int st = b / 1024, sb = b % 1024, swz = sb ^ (((sb >> 9) & 1) << 5);
  R = (st >> 1) * 16 + swz / 64;
  C = (st & 1) * 32 + (swz % 64) / 2;
}
}

enum { EPI_IN = 0, EPI_OUT = 1, EPI_MLP1 = 2, EPI_MLP2 = 3, EPI_MLP2F = 4 };

template <int EPI>
DI void gemm_epilogue(const Params& p, int layer, f32x4 (&acc)[2][2][4][2], int brow, int bcol, int pn, int wr, int wc,
                      int fr, int fq, char* smem, int ksplit = -1) {
  using namespace gm;
  if (EPI == EPI_IN) {
    u16* Z = p.z;
    const bool latent = brow < NLAT;
    if (pn == 9 || pn == 10) {
      float* xch = (float*)smem;
#pragma unroll
      for (int ai = 0; ai < 2; ++ai)
#pragma unroll
        for (int m = 0; m < 4; ++m)
#pragma unroll
          for (int bj = 0; bj < 2; ++bj) {
            float s = 0.f;
#pragma unroll
            for (int n = 0; n < 2; ++n)
#pragma unroll
              for (int j = 0; j < 4; ++j) s += acc[ai][bj][m][n][j] * acc[ai][bj][m][n][j];
            s = xsum16(s);
            s = xsum32(s);
            if (fq == 0) xch[(ai * 128 + wr * 64 + m * 16 + fr) * 8 + bj * 4 + wc] = s;
          }
      __syncthreads();
      const float* gq = (pn == 9 ? p.qn_g : p.kn_g) + layer * 64;
#pragma unroll
      for (int ai = 0; ai < 2; ++ai)
#pragma unroll
        for (int m = 0; m < 4; ++m) {
          __builtin_amdgcn_sched_barrier(0);
          const int rl = ai * 128 + wr * 64 + m * 16 + fr;
          const int row = brow + rl;
          const int spos = row & (SEQ - 1);
#pragma unroll
          for (int bj = 0; bj < 2; ++bj) {
            const bool normed = (pn == 9) || (bj == 0);
            float rs = 1.f;
            if (normed) {
              float tot = xch[rl * 8 + bj * 4 + wc] + xch[rl * 8 + bj * 4 + (wc ^ 1)];
              rs = __builtin_amdgcn_rsqf(tot * (1.f / 64.f) + EPSN);
            }
            u32x4 o;
#pragma unroll
            for (int n = 0; n < 2; ++n) {
              const int cih = (wc & 1) * 32 + fq * 8 + n * 4;
              f32x4 v = acc[ai][bj][m][n];
              if (normed) {
                f32x4 g = *(const f32x4*)(gq + cih);
                v = v * rs * g;
                if (latent) {
                  const float2 cs = *(const float2*)(p.ropec + spos * 32 + (cih >> 1));
                  const float2 sn = *(const float2*)(p.ropes + spos * 32 + (cih >> 1));
                  f32x4 r;
                  r[0] = v[0] * cs.x - v[1] * sn.x;
                  r[1] = v[0] * sn.x + v[1] * cs.x;
                  r[2] = v[2] * cs.y - v[3] * sn.y;
                  r[3] = v[2] * sn.y + v[3] * cs.y;
                  v = r;
                }
                if (pn == 9) v = v * 0.125f;
              }
              o[2 * n] = pk_bf16(v[0], v[1]);
              o[2 * n + 1] = pk_bf16(v[2], v[3]);
            }
            *(u32x4*)(Z + (size_t)row * ZW + bcol + bj * 128 + wc * 32 + fq * 8) = o;
          }
        }
    } else {
      const float sc = (pn == 0 || pn == 6 || pn == 11) ? 0.125f : 1.f;
      const bool dosilu = (pn == 0);
#pragma unroll
      for (int ai = 0; ai < 2; ++ai)
#pragma unroll
        for (int m = 0; m < 4; ++m) {
          __builtin_amdgcn_sched_barrier(0);
          const int row = brow + ai * 128 + wr * 64 + m * 16 + fr;
#pragma unroll
          for (int bj = 0; bj < 2; ++bj) {
            u32x4 o;
#pragma unroll
            for (int n = 0; n < 2; ++n) {
              f32x4 v = acc[ai][bj][m][n];
              if (dosilu) {
#pragma unroll
                for (int j = 0; j < 4; ++j) v[j] = siluf(v[j]);
              }
              v = v * sc;
              o[2 * n] = pk_bf16(v[0], v[1]);
              o[2 * n + 1] = pk_bf16(v[2], v[3]);
            }
            *(u32x4*)(Z + (size_t)row * ZW + bcol + bj * 128 + wc * 32 + fq * 8) = o;
          }
        }
    }
  } else if (EPI == EPI_MLP1) {
    const int bidx = (brow < NLAT) ? (brow >> 11) : 16;
    const float* bias = p.bias1 + (size_t)(layer * 17 + bidx) * HID;
    const int colb = bcol + wc * 32 + fq * 8;
    f32x4 bv[2][2];
    float rsv[2][4];
#pragma unroll
    for (int bj = 0; bj < 2; ++bj)
#pragma unroll
      for (int n = 0; n < 2; ++n) bv[bj][n] = *(const f32x4*)(bias + colb + bj * 128 + n * 4);
#pragma unroll
    for (int ai = 0; ai < 2; ++ai)
#pragma unroll
      for (int m = 0; m < 4; ++m) rsv[ai][m] = p.rowss[(size_t)layer * NTOK + brow + ai * 128 + wr * 64 + m * 16 + fr];
#pragma unroll
    for (int ai = 0; ai < 2; ++ai)
#pragma unroll
      for (int m = 0; m < 4; ++m) {
        __builtin_amdgcn_sched_barrier(0);
        const int row = brow + ai * 128 + wr * 64 + m * 16 + fr;
        const float rs = __builtin_amdgcn_rsqf(rsv[ai][m] * (1.f / DM) + EPSN);
#pragma unroll
        for (int bj = 0; bj < 2; ++bj) {
          u32x4 o;
#pragma unroll
          for (int n = 0; n < 2; ++n) {
            f32x4 v = acc[ai][bj][m][n] * rs + bv[bj][n];
#pragma unroll
            for (int j = 0; j < 4; ++j) {
              float r = fmaxf(v[j], 0.f);
              v[j] = r * r;
            }
            o[2 * n] = pk_bf16(v[0], v[1]);
            o[2 * n + 1] = pk_bf16(v[2], v[3]);
          }
          *(u32x4*)(p.hid + (size_t)row * HID + colb + bj * 128) = o;
        }
      }
  } else if (EPI == EPI_MLP2F) {
    const int bidx = brow >> 11;
    const float* gate = p.modv + ((size_t)(layer * 17 + bidx) * 6 + 5) * DM;
    const float* src = p.out + (size_t)brow * DM;
    const int colb = bcol + wc * 32 + fq * 8;
    f32x4 gv[2][2];
#pragma unroll
    for (int bj = 0; bj < 2; ++bj)
#pragma unroll
      for (int n = 0; n < 2; ++n) gv[bj][n] = *(const f32x4*)(gate + colb + bj * 128 + n * 4);
#pragma unroll
    for (int am = 0; am < 4; ++am) {
      const int ai = am >> 1, m0 = (am & 1) * 2;
      __builtin_amdgcn_sched_barrier(0);
      f32x4 xv[2][2][2];
#pragma unroll
      for (int mm = 0; mm < 2; ++mm)
#pragma unroll
        for (int bj = 0; bj < 2; ++bj)
#pragma unroll
          for (int n = 0; n < 2; ++n)
            xv[mm][bj][n] = *(const f32x4*)(src + (size_t)(ai * 128 + wr * 64 + (m0 + mm) * 16 + fr) * DM + colb + bj * 128 + n * 4);
      __builtin_amdgcn_sched_barrier(0);
#pragma unroll
      for (int mm = 0; mm < 2; ++mm) {
        const int m = m0 + mm;
        float ssq = 0.f;
#pragma unroll
        for (int bj = 0; bj < 2; ++bj)
#pragma unroll
          for (int n = 0; n < 2; ++n) {
            const f32x4 o = xv[mm][bj][n] + gv[bj][n] * acc[ai][bj][m][n];
            acc[ai][bj][m][n] = o;
            ssq += o[0] * o[0] + o[1] * o[1] + o[2] * o[2] + o[3] * o[3];
          }
        ssq = xsum16(ssq);
        ssq = xsum32(ssq);
        if (fq == 0) atomicAdd(p.rowssF + brow + ai * 128 + wr * 64 + m * 16 + fr, ssq);
      }
    }
    asm volatile("s_waitcnt vmcnt(0)" ::: "memory");
    __syncthreads();
    if (threadIdx.x == 0) {
      unsigned* cnt = p.cntF + (brow >> 8);
      __builtin_amdgcn_fence(__ATOMIC_RELEASE, "agent");
      __hip_atomic_fetch_add(cnt, 1u, __ATOMIC_RELAXED, __HIP_MEMORY_SCOPE_AGENT);
      unsigned spins = 0;
      while (__hip_atomic_load(cnt, __ATOMIC_RELAXED, __HIP_MEMORY_SCOPE_AGENT) < 4u) {
        __builtin_amdgcn_s_sleep(1);
        if (++spins > (1u << 24)) break;
      }
      __builtin_amdgcn_fence(__ATOMIC_ACQUIRE, "agent");
    }
    __syncthreads();
    float rsv[2][4];
#pragma unroll
    for (int ai = 0; ai < 2; ++ai)
#pragma unroll
      for (int m = 0; m < 4; ++m)
        rsv[ai][m] = __hip_atomic_load(p.rowssF + brow + ai * 128 + wr * 64 + m * 16 + fr, __ATOMIC_RELAXED, __HIP_MEMORY_SCOPE_AGENT);
    f32x4 fg[2][2];
#pragma unroll
    for (int bj = 0; bj < 2; ++bj)
#pragma unroll
      for (int n = 0; n < 2; ++n) fg[bj][n] = *(const f32x4*)(p.final_g + colb + bj * 128 + n * 4);
#pragma unroll
    for (int ai = 0; ai < 2; ++ai)
#pragma unroll
      for (int m = 0; m < 4; ++m) {
        __builtin_amdgcn_sched_barrier(0);
        const float rs = __builtin_amdgcn_rsqf(rsv[ai][m] * (1.f / DM) + EPSN);
        float* drow = p.out + (size_t)(brow + ai * 128 + wr * 64 + m * 16 + fr) * DM;
#pragma unroll
        for (int bj = 0; bj < 2; ++bj)
#pragma unroll
          for (int n = 0; n < 2; ++n) *(f32x4*)(drow + colb + bj * 128 + n * 4) = acc[ai][bj][m][n] * rs * fg[bj][n];
      }
  } else {
    const bool latent = brow < NLAT;
    const int bidx = latent ? (brow >> 11) : 16;
    const float* gate = p.modv + ((size_t)(layer * 17 + bidx) * 6 + (EPI == EPI_OUT ? 2 : 5)) * DM;
    const float* src;
    float* dst;
    if (latent) {
      dst = p.out + (size_t)brow * DM;
      src = (EPI == EPI_OUT && layer == 0) ? p.x + (size_t)brow * DM : dst;
    } else {
      dst = p.xcw + (size_t)(brow - NLAT) * DM;
      src = (EPI == EPI_OUT && layer == 0) ? p.ctx + (size_t)(brow - NLAT) * DM : dst;
    }
    const float* sc2 = p.modv + ((size_t)(layer * 17 + bidx) * 6 + 4) * DM;
    const float* g2 = p.g2 + layer * DM;
    const int colb = bcol + wc * 32 + fq * 8;
    if (EPI == EPI_MLP2 && ksplit >= 0) {
      float* pb = (float*)p.obuf + ((size_t)ksplit * (NBATCH * CTXL) + (brow - NLAT)) * DM;
#pragma unroll
      for (int ai = 0; ai < 2; ++ai)
#pragma unroll
        for (int m = 0; m < 4; ++m) {
          __builtin_amdgcn_sched_barrier(0);
          float* drow = pb + (size_t)(ai * 128 + wr * 64 + m * 16 + fr) * DM;
#pragma unroll
          for (int bj = 0; bj < 2; ++bj)
#pragma unroll
            for (int n = 0; n < 2; ++n) {
              const int col = colb + bj * 128 + n * 4;
              *(f32x4*)(drow + col) = *(const f32x4*)(gate + col) * acc[ai][bj][m][n];
            }
        }
      return;
    }
    f32x4 gv[2][2], gs[2][2];
#pragma unroll
    for (int bj = 0; bj < 2; ++bj)
#pragma unroll
      for (int n = 0; n < 2; ++n) {
        const int col = colb + bj * 128 + n * 4;
        gv[bj][n] = *(const f32x4*)(gate + col);
        if (EPI == EPI_OUT) gs[bj][n] = *(const f32x4*)(g2 + col) * (*(const f32x4*)(sc2 + col) + 1.f);
      }
#pragma unroll
    for (int am = 0; am < 4; ++am) {
      const int ai = am >> 1, m0 = (am & 1) * 2;
      __builtin_amdgcn_sched_barrier(0);
      f32x4 xv[2][2][2];
#pragma unroll
      for (int mm = 0; mm < 2; ++mm)
#pragma unroll
        for (int bj = 0; bj < 2; ++bj)
#pragma unroll
          for (int n = 0; n < 2; ++n)
            xv[mm][bj][n] = *(const f32x4*)(src + (size_t)(ai * 128 + wr * 64 + (m0 + mm) * 16 + fr) * DM + colb + bj * 128 + n * 4);
      __builtin_amdgcn_sched_barrier(0);
#pragma unroll
      for (int mm = 0; mm < 2; ++mm) {
        const int m = m0 + mm;
        const int rl = ai * 128 + wr * 64 + m * 16 + fr;
        float ssq = 0.f;
#pragma unroll
        for (int bj = 0; bj < 2; ++bj) {
          u32x4 ob;
#pragma unroll
          for (int n = 0; n < 2; ++n) {
            const int col = colb + bj * 128 + n * 4;
            f32x4 o = xv[mm][bj][n] + gv[bj][n] * acc[ai][bj][m][n];
            *(f32x4*)(dst + (size_t)rl * DM + col) = o;
            if (EPI == EPI_OUT) {
              ssq += o[0] * o[0] + o[1] * o[1] + o[2] * o[2] + o[3] * o[3];
              o = o * gs[bj][n];
              ob[2 * n] = pk_bf16(o[0], o[1]);
              ob[2 * n + 1] = pk_bf16(o[2], o[3]);
            }
          }
          if (EPI == EPI_OUT) *(u32x4*)(p.xn2 + (size_t)(brow + rl) * DM + colb + bj * 128) = ob;
        }
        if (EPI == EPI_OUT) {
          ssq = xsum16(ssq);
          ssq = xsum32(ssq);
          if (fq == 0) atomicAdd(p.rowss + (size_t)layer * NTOK + brow + rl, ssq);
        }
      }
    }
  }
}

template <int EPI, int K, bool SPLIT = false>
__device__ void gemm_phase(const Params& p, int layer, const u16* __restrict__ A, const u16* __restrict__ Bt, int nM, int nN, int nMsplit = 0) {
  using namespace gm;
  extern __shared__ __attribute__((aligned(16))) unsigned char shm[];
  LAS unsigned char* lds = (LAS unsigned char*)shm;
  constexpr int HTB = HT * 2;
#define SAo(b, h) (((b) * 2 + (h)) * HTB)
#define SBo(b, h) ((4 + (b) * 2 + (h)) * HTB)
#define STAGE(bufoff, gbase, voff)                                                                   \
  do {                                                                                               \
    _Pragma("unroll") for (int _i = 0; _i < 2; ++_i)                                                 \
      __builtin_amdgcn_global_load_lds((const unsigned*)((const char*)(gbase) + (voff)[_i]),         \
                                       (LAS unsigned*)(lds + (bufoff) + ldsw + _i * 8192), 16, 0, 0); \
  } while (0)
#define LDA(dst, b, h)                                                                               \
  do {                                                                                               \
    _Pragma("unroll") for (int m = 0; m < 4; ++m) _Pragma("unroll") for (int k = 0; k < 2; ++k)      \
      dst[m][k] = *(const LAS bf16x8*)(lds + SAo(b, h) + aoff + m * 2048 + k * 1024);                \
  } while (0)
#define LDB(dst, b, h)                                                                               \
  do {                                                                                               \
    _Pragma("unroll") for (int n = 0; n < 2; ++n) _Pragma("unroll") for (int k = 0; k < 2; ++k)      \
      dst[n][k] = *(const LAS bf16x8*)(lds + SBo(b, h) + boff + n * 2048 + k * 1024);                \
  } while (0)
#define MMA(ai, bj, At_, Bt_)                                                                        \
  do {                                                                                               \
    __builtin_amdgcn_s_setprio(1);                                                                   \
    _Pragma("unroll") for (int m = 0; m < 4; ++m) _Pragma("unroll") for (int n = 0; n < 2; ++n)      \
      _Pragma("unroll") for (int k = 0; k < 2; ++k)                                                  \
        acc[ai][bj][m][n] = __builtin_amdgcn_mfma_f32_16x16x32_bf16(Bt_[n][k], At_[m][k], acc[ai][bj][m][n], 0, 0, 0); \
    __builtin_amdgcn_s_setprio(0);                                                                   \
  } while (0)
#define WAIT_V(n) asm volatile("s_waitcnt vmcnt(" #n ")" ::: "memory")
#define WAIT_L(n) asm volatile("s_waitcnt lgkmcnt(" #n ")" ::: "memory")
#define BAR __builtin_amdgcn_s_barrier()
#define SCHED __builtin_amdgcn_sched_barrier(0)

  const int nwg = nM * nN;
  const int tid = opaque_tid(), wid = __builtin_amdgcn_readfirstlane(tid >> 6), lane = tid & 63, wr = wid >> 2, wc = wid & 3;
  constexpr int nt = K / BK;
  unsigned voff[2], voffB[2];
#pragma unroll
  for (int i = 0; i < 2; ++i) {
    int r_, c_;
    stage_rc(tid * 16 + i * 8192, r_, c_);
    voff[i] = (unsigned)(r_ * K + c_) * 2u;
    const int rho = r_ & 31, nn = rho >> 4, ii = rho & 15;
    const int rb = (r_ & ~31) + 8 * (ii >> 2) + 4 * nn + (ii & 3);
    voffB[i] = (unsigned)(rb * K + c_) * 2u;
  }
  const size_t kstep = (size_t)(BK * 2);
  const size_t hstep = (size_t)HALF * K * 2;
  const size_t tstep = 2 * hstep;
  const unsigned ldsw = (unsigned)wid * 1024u;
  const int aoff = lds_byte(wr * 64 + (lane & 15), (lane >> 4) * 8), boff = lds_byte(wc * 32 + (lane & 15), (lane >> 4) * 8);
  auto unit = [&](int i, int& pm, int& pn, int& kq) -> bool {
    const long L = (long)i * gridDim.x + blockIdx.x;
    kq = -1;
    if (SPLIT && L >= nwg) {
      const int u = (int)(L - nwg);
      if (u >= 16 * nMsplit) return false;
      pm = nM + (u >> 4); pn = (u >> 2) & 3; kq = u & 3;
      return true;
    }
    if (L >= nwg) return false;
    int wgid = (int)L;
    {
      const int q = nwg / NXCD, r = nwg % NXCD, xcd = wgid % NXCD, off = wgid / NXCD;
      wgid = (xcd < r ? xcd * (q + 1) : r * (q + 1) + (xcd - r) * q) + off;
    }
    const int nig = WGM * nN, gid = wgid / nig, fm = gid * WGM, gsz = min(nM - fm, WGM);
    pm = fm + ((wgid % nig) % gsz);
    pn = (wgid % nig) / gsz;
    return true;
  };
  int pm, pn, kq, npm = 0, npn = 0, nkq = -1, ui = 0;
  if (!unit(0, pm, pn, kq)) return;
  const char* cA = (const char*)A + (size_t)pm * tstep + (kq > 0 ? (size_t)kq * (K / 4) * 2 : 0);
  const char* cB = (const char*)Bt + (size_t)pn * tstep + (kq > 0 ? (size_t)kq * (K / 4) * 2 : 0);
  f32x4 acc[2][2][4][2];
#pragma unroll
  for (int a = 0; a < 2; ++a)
#pragma unroll
    for (int b = 0; b < 2; ++b)
#pragma unroll
      for (int m = 0; m < 4; ++m)
#pragma unroll
        for (int n = 0; n < 2; ++n) acc[a][b][m][n] = (f32x4){0.f, 0.f, 0.f, 0.f};
  bf16x8 At[4][2], B0[2][2], B1[2][2];
  STAGE(SBo(0, 0), cB, voffB); STAGE(SBo(0, 1), cB + hstep, voffB); STAGE(SAo(0, 0), cA, voff); STAGE(SAo(0, 1), cA + hstep, voff);
  if (wr == 1) BAR;
  WAIT_V(2); BAR;
  STAGE(SBo(1, 0), cB + kstep, voffB); STAGE(SAo(1, 0), cA + kstep, voff); STAGE(SBo(1, 1), cB + hstep + kstep, voffB);
  WAIT_V(6); BAR;
  for (;;) {
    const bool has_next = unit(ui + 1, npm, npn, nkq);
    const char* nA = has_next ? (const char*)A + (size_t)npm * tstep + (nkq > 0 ? (size_t)nkq * (K / 4) * 2 : 0) : cA;
    const char* nB = has_next ? (const char*)Bt + (size_t)npn * tstep + (nkq > 0 ? (size_t)nkq * (K / 4) * 2 : 0) : cB;
    const int ntu = (SPLIT && kq >= 0) ? nt / 4 : nt;
    for (int t = 0; t < ntu; t += 2) {
      const bool last = (t == ntu - 2);
      const char* a1 = cA + (size_t)(t + 1) * kstep;
      const char* a2 = last ? nA : cA + (size_t)(t + 2) * kstep;
      const char* b2 = last ? nB : cB + (size_t)(t + 2) * kstep;
      const char* a3 = a2 + kstep;
      const char* b3 = b2 + kstep;
      LDB(B0, 0, 0); LDB(B1, 0, 1); SCHED; LDA(At, 0, 0); STAGE(SAo(1, 1), a1 + hstep, voff);
      WAIT_V(8); WAIT_L(0); BAR; MMA(0, 0, At, B0); MMA(0, 1, At, B1); BAR; SCHED;
      LDA(At, 0, 1); STAGE(SBo(0, 0), b2, voffB); STAGE(SBo(0, 1), b2 + hstep, voffB); STAGE(SAo(0, 0), a2, voff);
      WAIT_V(8); WAIT_L(0); BAR; MMA(1, 0, At, B0); MMA(1, 1, At, B1); BAR; SCHED;
      LDB(B0, 1, 0); LDB(B1, 1, 1); SCHED; LDA(At, 1, 0); STAGE(SAo(0, 1), a2 + hstep, voff);
      WAIT_V(8); WAIT_L(0); BAR; MMA(0, 0, At, B0); MMA(0, 1, At, B1); BAR; SCHED;
      LDA(At, 1, 1); STAGE(SBo(1, 0), b3, voffB); STAGE(SBo(1, 1), b3 + hstep, voffB); STAGE(SAo(1, 0), a3, voff);
      WAIT_V(8); WAIT_L(0); BAR; MMA(1, 0, At, B0); MMA(1, 1, At, B1); BAR; SCHED;
    }
    if (wr == 0) BAR;
    {
      const int tid2 = opaque_tid(), lane2 = tid2 & 63;
      gemm_epilogue<EPI>(p, layer, acc, pm * BM, pn * BM, pn, wr, wc, lane2 & 15, lane2 >> 4, (char*)shm + XCH_OFF, SPLIT ? kq : -1);
    }
    if (!has_next) break;
#pragma unroll
    for (int a = 0; a < 2; ++a)
#pragma unroll
      for (int b = 0; b < 2; ++b)
#pragma unroll
        for (int m = 0; m < 4; ++m)
#pragma unroll
          for (int n = 0; n < 2; ++n) acc[a][b][m][n] = (f32x4){0.f, 0.f, 0.f, 0.f};
    pm = npm; pn = npn; kq = nkq; cA = nA; cB = nB; ++ui;
    if (wr == 1) BAR;
  }
  WAIT_V(0);
  __syncthreads();
#undef SAo
#undef SBo
#undef STAGE
#undef LDA
#undef LDB
#undef MMA
}

__device__ void transpose_tile(const float* __restrict__ src, int ldsrc, int scol0, int k0, u16* __restrict__ dst, int Kd, int drow0, char* smem) {
  float* ts = (float*)smem;
  const int tid = opaque_tid();
  {
    const int kk = tid >> 4, n4 = (tid & 15) * 4;
#pragma unroll
    for (int i = 0; i < 2; ++i) {
      const int k = kk + 32 * i;
      const f32x4 v = *(const f32x4*)(src + (size_t)(k0 + k) * ldsrc + scol0 + n4);
      ts[k * 65 + n4 + 0] = v[0];
      ts[k * 65 + n4 + 1] = v[1];
      ts[k * 65 + n4 + 2] = v[2];
      ts[k * 65 + n4 + 3] = v[3];
    }
  }
  __syncthreads();
  {
    const int n = tid >> 3, k8 = (tid & 7) * 8;
    u32x4 o;
#pragma unroll
    for (int j = 0; j < 4; ++j) o[j] = pk_bf16(ts[(k8 + 2 * j) * 65 + n], ts[(k8 + 2 * j + 1) * 65 + n]);
    *(u32x4*)(dst + (size_t)(drow0 + n) * Kd + k0 + k8) = o;
  }
  __syncthreads();
}

__device__ void mod_job(const Params& p, int job, char* smem) {
  const int l = job / 96, n0 = (job % 96) * 64;
  float* sc = (float*)smem;
  float* red = (float*)(smem + 17 * 1024 * 4);
  const int tid = opaque_tid();
  for (int i = tid; i < 17 * 1024; i += NTHR) {
    const int r = i >> 10, k = i & 1023;
    const float v = (r < 16) ? p.c[r * 1024 + k] : p.c_ctx[k];
    sc[i] = siluf(v);
  }
  __syncthreads();
  const int col = tid & 63, kq = tid >> 6;
  float acc[17];
#pragma unroll
  for (int r = 0; r < 17; ++r) acc[r] = 0.f;
  const float* w = p.w_mod + (size_t)l * 1024 * 6144 + n0 + col;
  for (int k = kq * 128; k < kq * 128 + 128; k += 16) {
    float wv[16];
#pragma unroll
    for (int u = 0; u < 16; ++u) wv[u] = w[(size_t)(k + u) * 6144];
#pragma unroll
    for (int u = 0; u < 16; ++u)
#pragma unroll
      for (int r = 0; r < 17; ++r) acc[r] += sc[r * 1024 + k + u] * wv[u];
  }
#pragma unroll
  for (int r = 0; r < 17; ++r) red[(kq * 17 + r) * 64 + col] = acc[r];
  __syncthreads();
  for (int i = tid; i < 17 * 64; i += NTHR) {
    const int r = i >> 6, cc = i & 63;
    float s = p.b_mod[l * 6144 + n0 + cc];
#pragma unroll
    for (int q = 0; q < 8; ++q) s += red[(q * 17 + r) * 64 + cc];
    const int n = n0 + cc;
    p.modv[((size_t)(l * 17 + r) * 6 + (n >> 10)) * DM + (n & 1023)] = s;
  }
  __syncthreads();
}

__device__ void bias_job(const Params& p, int l, int job, char* smem) {
  const int n0 = job * 64;
  float* sc = (float*)smem;
  float* red = (float*)(smem + 17 * 1024 * 4);
  const int tid = opaque_tid();
  for (int i = tid; i < 17 * 1024; i += NTHR) {
    const int r = i >> 10, k = i & 1023;
    sc[i] = p.modv[((size_t)(l * 17 + r) * 6 + 3) * DM + k];
  }
  __syncthreads();
  const int col = tid & 63, kq = tid >> 6;
  float acc[17];
#pragma unroll
  for (int r = 0; r < 17; ++r) acc[r] = 0.f;
  const float* w = p.w1 + (size_t)l * DM * HID + n0 + col;
  for (int k = kq * 128; k < kq * 128 + 128; k += 16) {
    float wv[16];
#pragma unroll
    for (int u = 0; u < 16; ++u) wv[u] = w[(size_t)(k + u) * HID];
#pragma unroll
    for (int u = 0; u < 16; ++u)
#pragma unroll
      for (int r = 0; r < 17; ++r) acc[r] += sc[r * 1024 + k + u] * wv[u];
  }
#pragma unroll
  for (int r = 0; r < 17; ++r) red[(kq * 17 + r) * 64 + col] = acc[r];
  __syncthreads();
  for (int i = tid; i < 17 * 64; i += NTHR) {
    const int r = i >> 6, cc = i & 63;
    float sum = 0.f;
#pragma unroll
    for (int q = 0; q < 8; ++q) sum += red[(q * 17 + r) * 64 + cc];
    p.bias1[(size_t)(l * 17 + r) * HID + n0 + cc] = sum;
  }
  __syncthreads();
}

__device__ void prologue_phase(const Params& p, char* smem) {
  constexpr int NJ_MOD = 192, NJ_TR = 6400, NJ_G = 2, NJ_R = 16;
  for (int job = blockIdx.x; job < NJ_MOD + NJ_TR + NJ_G + NJ_R; job += gridDim.x) {
    if (job < NJ_MOD) {
      mod_job(p, job, smem);
    } else if (job < NJ_MOD + NJ_TR) {
      int j = job - NJ_MOD;
      const int l = j / 3200;
      j %= 3200;
      if (j < 896) {
        const int kt = j / 56, nt = j % 56;
        const int scol = nt * 64 + (nt >= 36 ? 16 : 0);
        transpose_tile(p.w_in + (size_t)l * DM * INW, INW, scol, kt * 64, p.WinT + (size_t)l * ZW * DM, DM, nt * 64, smem);
      } else if (j < 896 + 256) {
        j -= 896;
        const int kt = j / 16, nt = j % 16;
        transpose_tile(p.w_out + (size_t)l * DM * DM, DM, nt * 64, kt * 64, p.WoutT + (size_t)l * DM * DM, DM, nt * 64, smem);
      } else if (j < 896 + 256 + 1024) {
        j -= 896 + 256;
        const int kt = j / 64, nt = j % 64;
        transpose_tile(p.w1 + (size_t)l * DM * HID, HID, nt * 64, kt * 64, p.W1T + (size_t)l * HID * DM, DM, nt * 64, smem);
      } else {
        j -= 896 + 256 + 1024;
        const int kt = j / 16, nt = j % 16;
        transpose_tile(p.w2 + (size_t)l * HID * DM, DM, nt * 64, kt * 64, p.W2T + (size_t)l * DM * HID, HID, nt * 64, smem);
      }
    } else if (job < NJ_MOD + NJ_TR + NJ_G) {
      const int l = job - NJ_MOD - NJ_TR;
      for (int i = threadIdx.x; i < 16 * 1024; i += NTHR) {
        const int n = i & 15, k = i >> 4;
        p.wg[(size_t)(l * 16 + n) * DM + k] = p.w_in[(size_t)l * DM * INW + (size_t)k * INW + 2304 + n];
      }
    } else {
      const int j = job - NJ_MOD - NJ_TR - NJ_G;
      for (int i = threadIdx.x; i < 4096; i += NTHR) {
        const int e = j * 4096 + i;
        const int s = e >> 5, idx = e & 31;
        const int row = s >> 6, col = s & 63;
        const int fi = idx & 15;
        const float inv = powf(10000.f, -2.0f * (float)fi / 32.f);
        const float ang = (idx < 16 ? (float)row : (float)col) * inv;
        p.ropec[e] = cosf(ang);
        p.ropes[e] = sinf(ang);
      }
    }
  }
}

__device__ void norm_phase(const Params& p, int layer, int which, int nrows, char* smem) {
  const int tid_ = opaque_tid();
  const int lane = tid_ & 63, wid = tid_ >> 6;
  const float* g = (which == 0 ? p.g1 : p.g2) + layer * DM;
  float* wgs = (float*)smem;
  if (which == 0) {
    const float* wgl = p.wg + (size_t)layer * 16 * DM;
    for (int i = tid_; i < 16 * DM / 4; i += NTHR) *(f32x4*)(wgs + i * 4) = *(const f32x4*)(wgl + i * 4);
    __syncthreads();
  }
  for (int pr = blockIdx.x * 8 + wid; pr < nrows / 2; pr += gridDim.x * 8) {
    const int row0 = pr * 2;
    const bool latent = row0 < NLAT;
    const float* src;
    if (which == 0 && layer == 0) src = latent ? p.x + (size_t)row0 * DM : p.ctx + (size_t)(row0 - NLAT) * DM;
    else src = latent ? p.out + (size_t)row0 * DM : p.xcw + (size_t)(row0 - NLAT) * DM;
    const int bidx = latent ? (row0 >> 11) : 16;
    const float* shift = p.modv + ((size_t)(layer * 17 + bidx) * 6 + (which == 0 ? 0 : 3)) * DM;
    const float* scale = shift + DM;
    f32x4 v[2][4];
    float ss0 = 0.f, ss1 = 0.f;
#pragma unroll
    for (int i = 0; i < 4; ++i) {
      v[0][i] = *(const f32x4*)(src + i * 256 + lane * 4);
      v[1][i] = *(const f32x4*)(src + DM + i * 256 + lane * 4);
    }
    if (which == 0 && layer == 1 && !latent) {
      const float* pb = (const float*)p.obuf + (size_t)(row0 - NLAT) * DM;
#pragma unroll
      for (int q = 0; q < 4; ++q)
#pragma unroll
        for (int i = 0; i < 4; ++i) {
          v[0][i] += *(const f32x4*)(pb + (size_t)q * (NBATCH * CTXL) * DM + i * 256 + lane * 4);
          v[1][i] += *(const f32x4*)(pb + (size_t)q * (NBATCH * CTXL) * DM + DM + i * 256 + lane * 4);
        }
    }
#pragma unroll
    for (int i = 0; i < 4; ++i) {
      ss0 += v[0][i][0] * v[0][i][0] + v[0][i][1] * v[0][i][1] + v[0][i][2] * v[0][i][2] + v[0][i][3] * v[0][i][3];
      ss1 += v[1][i][0] * v[1][i][0] + v[1][i][1] * v[1][i][1] + v[1][i][2] * v[1][i][2] + v[1][i][3] * v[1][i][3];
    }
    ss0 = xsum16(xsum32(ss0)); ss1 = xsum16(xsum32(ss1));
#pragma unroll
    for (int o = 8; o > 0; o >>= 1) { ss0 += __shfl_xor(ss0, o); ss1 += __shfl_xor(ss1, o); }
    const float rs0 = __builtin_amdgcn_rsqf(ss0 * (1.f / DM) + EPSN), rs1 = __builtin_amdgcn_rsqf(ss1 * (1.f / DM) + EPSN);
#pragma unroll
    for (int i = 0; i < 4; ++i) {
      const int c0 = i * 256 + lane * 4;
      const f32x4 gv = *(const f32x4*)(g + c0), sh = *(const f32x4*)(shift + c0), sc = *(const f32x4*)(scale + c0) + 1.f;
      v[0][i] = (v[0][i] * rs0 * gv) * sc + sh;
      v[1][i] = (v[1][i] * rs1 * gv) * sc + sh;
      u32x2 o;
      o[0] = pk_bf16(v[0][i][0], v[0][i][1]);
      o[1] = pk_bf16(v[0][i][2], v[0][i][3]);
      *(u32x2*)(p.xn + (size_t)row0 * DM + c0) = o;
      o[0] = pk_bf16(v[1][i][0], v[1][i][1]);
      o[1] = pk_bf16(v[1][i][2], v[1][i][3]);
      *(u32x2*)(p.xn + (size_t)(row0 + 1) * DM + c0) = o;
    }
    if (which == 0) {
      float a32[32];
      typedef float f32x2 __attribute__((ext_vector_type(2)));
#pragma unroll
      for (int n = 0; n < 16; ++n) {
        f32x2 a0 = {0.f, 0.f}, a1 = {0.f, 0.f};
#pragma unroll
        for (int i = 0; i < 4; ++i) {
          const f32x4 wv = *(const f32x4*)(wgs + n * DM + i * 256 + lane * 4);
          const f32x2 wlo = {wv[0], wv[1]}, whi = {wv[2], wv[3]};
          a0 += (f32x2){v[0][i][0], v[0][i][1]} * wlo;
          a0 += (f32x2){v[0][i][2], v[0][i][3]} * whi;
          a1 += (f32x2){v[1][i][0], v[1][i][1]} * wlo;
          a1 += (f32x2){v[1][i][2], v[1][i][3]} * whi;
        }
        a32[n] = a0[0] + a0[1];
        a32[16 + n] = a1[0] + a1[1];
        if ((n & 1) == 1) __builtin_amdgcn_sched_barrier(0);
      }
#pragma unroll
      for (int i = 0; i < 16; ++i) a32[i] = bfly32(a32[i], a32[i + 16]);
#pragma unroll
      for (int i = 0; i < 8; ++i) a32[i] = bfly16(a32[i], a32[i + 8]);
#pragma unroll
      for (int half = 4; half >= 1; half >>= 1) {
        const int mask = half * 2;
        const bool up = (lane & mask) != 0;
#pragma unroll
        for (int i = 0; i < half; ++i) {
          const float send = up ? a32[i] : a32[i + half];
          const float keep = up ? a32[i + half] : a32[i];
          a32[i] = keep + __shfl_xor(send, mask);
        }
      }
      const float tot = a32[0] + __shfl_xor(a32[0], 1);
      if ((lane & 1) == 0) {
        const int gi = (lane >> 1) & 15;
        p.gates[(size_t)(row0 + (lane >> 5)) * 16 + gi] = tot + p.mlstm_b[layer * 16 + gi];
      }
    }
  }
}

__device__ void final_norm_phase(const Params& p) {
  const int tid_ = opaque_tid();
  const int lane = tid_ & 63, wid = tid_ >> 6;
  for (int row = blockIdx.x * 8 + wid; row < NLAT; row += gridDim.x * 8) {
    float* src = p.out + (size_t)row * DM;
    f32x4 v[4];
    float ss = 0.f;
#pragma unroll
    for (int i = 0; i < 4; ++i) {
      v[i] = *(const f32x4*)(src + i * 256 + lane * 4);
      ss += v[i][0] * v[i][0] + v[i][1] * v[i][1] + v[i][2] * v[i][2] + v[i][3] * v[i][3];
    }
    ss = wave_sum(ss);
    const float rs = __builtin_amdgcn_rsqf(ss * (1.f / DM) + EPSN);
#pragma unroll
    for (int i = 0; i < 4; ++i) {
      const int c0 = i * 256 + lane * 4;
      const f32x4 gv = *(const f32x4*)(p.final_g + c0);
      *(f32x4*)(src + c0) = v[i] * rs * gv;
    }
  }
}

constexpr int KS_STRIDE = 72, VT_STRIDE = 66;
DI bf16x8 ld_frag16(const u16* base) { return *(const bf16x8*)base; }
DI bf16x8 ld_frag4x4(const u16* a, const u16* b) {
  u32x4 r;
  const unsigned* pa = (const unsigned*)a;
  const unsigned* pb = (const unsigned*)b;
  r[0] = pa[0]; r[1] = pa[1]; r[2] = pb[0]; r[3] = pb[1];
  return as_bf16x8(r);
}


#define TRR(i, off) "ds_read_b64_tr_b16 %" #i ", %16 offset:" #off "\n\t"
DI void tr_read_vtile(u32x2 (&r)[16], unsigned addr) {
  asm volatile(
      TRR(0, 0)     TRR(1, 1152)  TRR(2, 64)    TRR(3, 1216)
      TRR(4, 2304)  TRR(5, 3456)  TRR(6, 2368)  TRR(7, 3520)
      TRR(8, 4608)  TRR(9, 5760)  TRR(10, 4672) TRR(11, 5824)
      TRR(12, 6912) TRR(13, 8064) TRR(14, 6976) TRR(15, 8128)
      "s_waitcnt lgkmcnt(0)"
      : "=&v"(r[0]), "=&v"(r[1]), "=&v"(r[2]), "=&v"(r[3]), "=&v"(r[4]), "=&v"(r[5]), "=&v"(r[6]), "=&v"(r[7]),
        "=&v"(r[8]), "=&v"(r[9]), "=&v"(r[10]), "=&v"(r[11]), "=&v"(r[12]), "=&v"(r[13]), "=&v"(r[14]), "=&v"(r[15])
      : "v"(addr)
      : "memory");
}

DI void tr_read_vtile8(u32x2 (&r)[8], unsigned addr) {
  asm volatile(
      "ds_read_b64_tr_b16 %0, %8 offset:0\n\tds_read_b64_tr_b16 %1, %8 offset:1152\n\t"
      "ds_read_b64_tr_b16 %2, %8 offset:64\n\tds_read_b64_tr_b16 %3, %8 offset:1216\n\t"
      "ds_read_b64_tr_b16 %4, %8 offset:2304\n\tds_read_b64_tr_b16 %5, %8 offset:3456\n\t"
      "ds_read_b64_tr_b16 %6, %8 offset:2368\n\tds_read_b64_tr_b16 %7, %8 offset:3520\n\t"
      "s_waitcnt lgkmcnt(0)"
      : "=&v"(r[0]), "=&v"(r[1]), "=&v"(r[2]), "=&v"(r[3]), "=&v"(r[4]), "=&v"(r[5]), "=&v"(r[6]), "=&v"(r[7])
      : "v"(addr)
      : "memory");
}

template <int NB>
DI void softmax_pv(f32x16 (&s)[2], float& mrun, float& lsum, f32x16 (&O)[2], unsigned vaddr) {
  u32x2 vf[16];
  u32x2 vf8[8];
  if (NB == 2) tr_read_vtile(vf, vaddr);
  else tr_read_vtile8(vf8, vaddr);
  float mx = -1e30f;
#pragma unroll
  for (int kb = 0; kb < NB; ++kb)
#pragma unroll
    for (int e = 0; e < 16; ++e) mx = fmaxf(mx, s[kb][e]);
  mx = xmax32(mx);
  constexpr float THR = 6.f;
  float alpha = 1.f;
  if (__builtin_amdgcn_ballot_w64(mx - mrun > THR) != 0ull) {
    const float mnew = fmaxf(mrun, mx);
    alpha = __builtin_amdgcn_exp2f((mrun - mnew) * L2E);
    mrun = mnew;
#pragma unroll
    for (int e = 0; e < 16; ++e) { O[0][e] *= alpha; O[1][e] *= alpha; }
  }
  typedef float f32x2 __attribute__((ext_vector_type(2)));
  const float mb = mrun * L2E;
  f32x2 ps2 = {0.f, 0.f};
  const f32x2 l2e2 = {L2E, L2E}, mb2 = {mb, mb};
  if (NB == 2) {
#pragma unroll
    for (int kb = 0; kb < 2; ++kb) {
#pragma unroll
      for (int e = 0; e < 16; e += 2) {
        f32x2 t = {s[kb][e], s[kb][e + 1]};
        t = t * l2e2 - mb2;
        f32x2 pv;
        pv[0] = __builtin_amdgcn_exp2f(t[0]);
        pv[1] = __builtin_amdgcn_exp2f(t[1]);
        s[kb][e] = pv[0];
        s[kb][e + 1] = pv[1];
        ps2 += pv;
      }
      u32x4 pp[2];
#pragma unroll
      for (int st = 0; st < 2; ++st)
#pragma unroll
        for (int j = 0; j < 4; ++j) pp[st][j] = pk_bf16(s[kb][8 * st + 2 * j], s[kb][8 * st + 2 * j + 1]);
      __builtin_amdgcn_sched_barrier(0);
      __builtin_amdgcn_s_setprio(1);
#pragma unroll
      for (int st = 0; st < 2; ++st) {
        const bf16x8 pf = as_bf16x8(pp[st]);
#pragma unroll
        for (int db = 0; db < 2; ++db) {
          const int ix = ((kb * 2 + st) * 2 + db) * 2;
          u32x4 av;
          av[0] = vf[ix][0]; av[1] = vf[ix][1]; av[2] = vf[ix + 1][0]; av[3] = vf[ix + 1][1];
          O[db] = mfma32(as_bf16x8(av), pf, O[db]);
        }
      }
      __builtin_amdgcn_s_setprio(0);
      __builtin_amdgcn_sched_barrier(0);
    }
  } else {
#pragma unroll
    for (int e = 0; e < 16; e += 2) {
      f32x2 t = {s[0][e], s[0][e + 1]};
      t = t * l2e2 - mb2;
      f32x2 pv;
      pv[0] = __builtin_amdgcn_exp2f(t[0]);
      pv[1] = __builtin_amdgcn_exp2f(t[1]);
      s[0][e] = pv[0];
      s[0][e + 1] = pv[1];
      ps2 += pv;
    }
    __builtin_amdgcn_s_setprio(1);
#pragma unroll
    for (int st = 0; st < 2; ++st) {
      u32x4 pp;
#pragma unroll
      for (int j = 0; j < 4; ++j) pp[j] = pk_bf16(s[0][8 * st + 2 * j], s[0][8 * st + 2 * j + 1]);
      const bf16x8 pf = as_bf16x8(pp);
#pragma unroll
      for (int db = 0; db < 2; ++db) {
        const int ix = (st * 2 + db) * 2;
        u32x4 av;
        av[0] = vf8[ix][0]; av[1] = vf8[ix][1]; av[2] = vf8[ix + 1][0]; av[3] = vf8[ix + 1][1];
        O[db] = mfma32(as_bf16x8(av), pf, O[db]);
      }
    }
    __builtin_amdgcn_s_setprio(0);
  }
  lsum = lsum * alpha + (ps2[0] + ps2[1]);
}

template <int kind>
__device__ void attn_job(const Params& p, int layer, int idx, char* smem) {
  u16* Ks = (u16*)smem;
  u16* Vt = (u16*)(smem + 2 * 64 * KS_STRIDE * 2);
  float* rpbs = (float*)(smem + 4 * 64 * KS_STRIDE * 2);
  const int tid = opaque_tid(), lane = tid & 63, w = __builtin_amdgcn_readfirstlane(tid >> 6), tq = lane & 31, hh = lane >> 5;
  int b, qtok, qcol, ocol, kcol, vcol, nlat = 0, lat0 = 0, R0 = 0, hN = 0;
  int qrow_l = 0, qc = 0, k0 = 0, r0A = 0, r0l = 0;
  if (kind == 0) {
    b = idx >> 5; const int kvh = (idx >> 4) & 1, qt = idx & 15;
    const int head = kvh * 2 + (w >> 2);
    qtok = b * SEQ + qt * 128 + (w & 3) * 32 + tq; qcol = GQ + head * 64; ocol = 512 + head * 64;
    kcol = GK + kvh * 64; vcol = GV + kvh * 64; nlat = 32; lat0 = b * SEQ;
  } else if (kind == 1) {
    b = idx >> 5; hN = (idx >> 3) & 3; const int rg = idx & 7;
    const int rA = rg * 4 + 2 * (w >> 2), cb = w & 3;
    qrow_l = rA + (tq >> 4); qc = 16 * cb + (tq & 15);
    qtok = b * SEQ + qrow_l * 64 + qc; qcol = NQ + hN * 64; ocol = 768 + hN * 64;
    kcol = NK + hN * 64; vcol = NV + hN * 64;
    R0 = min(max(rg * 4 - 4, 0), 24);
    const int R1 = min(max(rg * 4 + 3 - 4, 0), 24) + 8;
    nlat = R1 - R0; lat0 = b * SEQ + R0 * 64;
    k0 = min(max(16 * cb - 8, 0), 32);
    r0A = min(max(rA - 4, 0), 24);
    r0l = min(max(qrow_l - 4, 0), 24);
  } else if (kind == 2) {
    b = idx >> 2; const int kvh = (idx >> 1) & 1, half = idx & 1;
    const int head = kvh * 2 + (w >> 2);
    qtok = NLAT + b * CTXL + half * 128 + (w & 3) * 32 + tq; qcol = GQ + head * 64; ocol = 512 + head * 64;
    kcol = GK + kvh * 64; vcol = GV + kvh * 64;
  } else {
    b = idx >> 2; hN = idx & 3;
    qtok = NLAT + b * CTXL + w * 32 + tq; qcol = NQ + hN * 64; ocol = 768 + hN * 64;
    kcol = NK + hN * 64; vcol = NV + hN * 64;
  }
  const int ntiles = 4 + nlat;
  const u16* Z = p.z;
  if (kind == 1) {
    for (int i = tid; i < 16 + 15 * 32 + 32; i += NTHR) {
      const int j = i - 16, rr = j >> 5, cc = j & 31;
      rpbs[i] = (j >= 0 && rr < 15 && cc < 31) ? p.rpb[((size_t)(layer * 4 + hN) * 15 + rr) * 31 + cc] : 0.f;
    }
  }
  bf16x8 qf[4];
#pragma unroll
  for (int st = 0; st < 4; ++st) qf[st] = *(const bf16x8*)(Z + (size_t)qtok * ZW + qcol + 16 * st + 8 * hh);
  unsigned colmask = 0;
  int dcbase = 0;
  if (kind == 1) {
    const int cs = min(max(qc - 8, 0), 48);
#pragma unroll
    for (int e = 0; e < 16; ++e) {
      const int kc = k0 + (e & 3) + 8 * (e >> 2) + 4 * hh;
      colmask |= ((kc >= cs) && (kc < cs + 16)) ? (1u << e) : 0u;
    }
    dcbase = 16 + k0 + 4 * hh - qc + 15;
  }
  float mrun = -1e30f, lsum = 0.f;
  f32x16 O[2], zero16;
#pragma unroll
  for (int i = 0; i < 16; ++i) { O[0][i] = 0.f; O[1][i] = 0.f; zero16[i] = 0.f; }
  asm volatile("" : "+v"(zero16));
  const int lkey = tid >> 3, lc = tid & 7;
  const unsigned vlane_off = (unsigned)((4 * (lane >> 5) + ((lane & 15) >> 2)) * (KS_STRIDE * 2) + (((lane >> 4) & 1) * 16 + 4 * (lane & 3)) * 2);
  auto tile_row0 = [&](int i) { return (i < 4) ? (NLAT + b * CTXL + i * 64) : (lat0 + (i - 4) * 64); };
  u32x4 kreg, vreg;
  {
    const size_t ro = (size_t)(tile_row0(0) + lkey) * ZW;
    kreg = *(const u32x4*)(Z + ro + kcol + lc * 8);
    vreg = *(const u32x4*)(Z + ro + vcol + lc * 8);
  }
  for (int i = 0; i < ntiles; ++i) {
    u16* Kb = Ks + (i & 1) * 64 * KS_STRIDE;
    u16* Vb = Vt + (i & 1) * 64 * KS_STRIDE;
    *(u32x4*)(Kb + lkey * KS_STRIDE + lc * 8) = kreg;
    *(u32x4*)(Vb + lkey * KS_STRIDE + lc * 8) = vreg;
    lds_barrier();
    if (i + 1 < ntiles) {
      const size_t ro = (size_t)(tile_row0(i + 1) + lkey) * ZW;
      kreg = *(const u32x4*)(Z + ro + kcol + lc * 8);
      vreg = *(const u32x4*)(Z + ro + vcol + lc * 8);
    }
    if (kind == 1 && i >= 4) {
      const int kr = R0 + i - 4;
      if (kr >= r0A && kr < r0A + 9) {
        f32x16 s[2];
#pragma unroll
        for (int st = 0; st < 4; ++st) s[0] = mfma32(ld_frag16(Kb + (k0 + tq) * KS_STRIDE + 16 * st + 8 * hh), qf[st], st == 0 ? zero16 : s[0]);
        const bool rowvalid = (kr >= r0l) && (kr < r0l + 8);
        const unsigned m = rowvalid ? colmask : 0u;
        const float* brow = rpbs + (kr - qrow_l + 7) * 32 + dcbase;
#pragma unroll
        for (int e = 0; e < 16; ++e) {
          const float bias = brow[(e & 3) + 8 * (e >> 2)];
          s[0][e] = ((m >> e) & 1u) ? s[0][e] + bias : -1e30f;
        }
        softmax_pv<1>(s, mrun, lsum, O, (unsigned)(size_t)Vb + vlane_off + (unsigned)(k0 * KS_STRIDE * 2));
      }
    } else {
      f32x16 s[2];
      __builtin_amdgcn_s_setprio(1);
#pragma unroll
      for (int kb = 0; kb < 2; ++kb) {
#pragma unroll
        for (int st = 0; st < 4; ++st) s[kb] = mfma32(ld_frag16(Kb + (kb * 32 + tq) * KS_STRIDE + 16 * st + 8 * hh), qf[st], st == 0 ? zero16 : s[kb]);
      }
      __builtin_amdgcn_s_setprio(0);
      softmax_pv<2>(s, mrun, lsum, O, (unsigned)(size_t)Vb + vlane_off);
    }
  }
  lsum = xsum32(lsum);
  const float inv = 1.f / lsum;
  u16* dst = p.xn + (size_t)qtok * DM + ocol;
#pragma unroll
  for (int db = 0; db < 2; ++db)
#pragma unroll
    for (int k = 0; k < 2; ++k) {
      const int gA = 2 * k, gB = 2 * k + 1;
      const unsigned x0 = pk_bf16(O[db][4 * gA + 0] * inv, O[db][4 * gA + 1] * inv), x1 = pk_bf16(O[db][4 * gA + 2] * inv, O[db][4 * gA + 3] * inv);
      const unsigned y0 = pk_bf16(O[db][4 * gB + 0] * inv, O[db][4 * gB + 1] * inv), y1 = pk_bf16(O[db][4 * gB + 2] * inv, O[db][4 * gB + 3] * inv);
      auto r0 = __builtin_amdgcn_permlane32_swap(x0, y0, false, false);
      auto r1 = __builtin_amdgcn_permlane32_swap(x1, y1, false, false);
      u32x4 wv;
      wv[0] = r0[0]; wv[1] = r1[0]; wv[2] = r0[1]; wv[3] = r1[1];
      *(u32x4*)(dst + db * 32 + 16 * k + 8 * hh) = wv;
    }
  __syncthreads();
}

__device__ void hgrn_chain(const Params& p, int layer, int idx, char* smem) {
  const int b = idx >> 3, h = (idx >> 1) & 3, dir = idx & 1;
  u16* Qs0 = (u16*)smem;
  u16* Qs1 = (u16*)(smem + 92928);
  u16* VT0 = (u16*)(smem + 9216);
  u16* VT1 = (u16*)(smem + 75264);
  float* bb = (float*)(smem + 17664);
  u16* KD = (u16*)(smem + 34304);
  u16* KE = (u16*)(smem + 43520);
  u16* KdT = (u16*)(smem + 52736);
  u16* ST0 = (u16*)(smem + 61184);
  u16* ST1 = (u16*)(smem + 83712);
  float* tot = (float*)(smem + 70400);
  float* bend = (float*)(smem + 72448);
  float* Ftab = (float*)(smem + 72704);
  float* rtab = (float*)(smem + 74240);
  const int tid = opaque_tid(), lane = tid & 63, w = __builtin_amdgcn_readfirstlane(tid >> 6), c = lane & 15, g = lane >> 4;
  const int d_ = tid & 63, part = w;
  const int lrow = tid >> 3, c8 = tid & 7;
  float lb = 0.f;
  if (layer == 1) {
    const float l0 = p.lb_logits[(0 * 2 + dir) * 256 + h * 64 + d_], l1 = p.lb_logits[(1 * 2 + dir) * 256 + h * 64 + d_];
    lb = 1.f / (1.f + __expf(l0 - l1));
  }
  const int fcol = (dir ? HFB : HFF) + h * 64;
  const u16* Z = p.z;
  u16* ob = p.obuf + (size_t)(0 * 2 + dir) * NTOK * 256;
  f32x4 cst[2];
  cst[0] = (f32x4){0.f, 0.f, 0.f, 0.f};
  cst[1] = cst[0];
  for (int i = tid; i < 64 * 72; i += NTHR) ST0[i] = 0;
  auto chunk_base = [&](int i) {
    if (i < 4) { const int cc = dir ? 3 - i : i; return NLAT + b * CTXL + cc * 64; }
    const int cc = dir ? 31 - (i - 4) : (i - 4);
    return b * SEQ + cc * 64;
  };
  u32x4 nq, nv;
  u16 nf[8];
  {
    const int base = chunk_base(0);
    const size_t ro = (size_t)(base + (dir ? 63 - lrow : lrow)) * ZW;
    nq = *(const u32x4*)(Z + ro + HQ + h * 64 + c8 * 8);
    nv = *(const u32x4*)(Z + ro + HI_ + h * 64 + c8 * 8);
#pragma unroll
    for (int e = 0; e < 8; ++e) {
      const int t = part * 8 + e;
      nf[e] = Z[(size_t)(base + (dir ? 63 - t : t)) * ZW + fcol + d_];
    }
  }
  __syncthreads();
  for (int i = 0; i < 36; ++i) {
    const int base = chunk_base(i);
    u16* VT = (i & 1) ? VT1 : VT0;
    u16* Qs = (i & 1) ? Qs1 : Qs0;
    const u16* ST = (i & 1) ? ST1 : ST0;
    u16* STn = (i & 1) ? ST0 : ST1;
    *(u32x4*)(Qs + lrow * 72 + c8 * 8) = nq;
#pragma unroll
    for (int j = 0; j < 4; ++j) {
      VT[(c8 * 8 + 2 * j) * 66 + lrow] = (u16)(nv[j] & 0xffffu);
      VT[(c8 * 8 + 2 * j + 1) * 66 + lrow] = (u16)(nv[j] >> 16);
    }
    float cl[8], kf[8];
    {
      float cum = 0.f;
#pragma unroll
      for (int e = 0; e < 8; ++e) {
        const float f = bf2f(nf[e]);
        const float ef = __expf(-f);
        const float sig = __builtin_amdgcn_rcpf(1.f + ef);
        const float forget = lb + (1.f - lb) * sig;
        cum += __logf(fmaxf(forget, 1e-20f));
        cl[e] = cum;
        kf[e] = (1.f - lb) * (ef * sig);
      }
      tot[part * 64 + d_] = cum;
    }
    lds_barrier();
    if (i + 1 < 36) {
      const int nb = chunk_base(i + 1);
      const size_t ro = (size_t)(nb + (dir ? 63 - lrow : lrow)) * ZW;
      nq = *(const u32x4*)(Z + ro + HQ + h * 64 + c8 * 8);
      nv = *(const u32x4*)(Z + ro + HI_ + h * 64 + c8 * 8);
#pragma unroll
      for (int e = 0; e < 8; ++e) {
        const int t = part * 8 + e;
        nf[e] = Z[(size_t)(nb + (dir ? 63 - t : t)) * ZW + fcol + d_];
      }
    }
    {
      const int jsub = part >> 1;
      float off = 0.f, bendv = 0.f, rj = 0.f, rj1 = 0.f, r1 = 0.f, r2 = 0.f, r3 = 0.f;
#pragma unroll
      for (int q = 0; q < 8; ++q) {
        const float tv = tot[q * 64 + d_];
        bendv += tv;
        if (q < part) off += tv;
        if (q < 2 * jsub) rj += tv;
        if (q < 2 * jsub + 2) rj1 += tv;
        if (q < 2) r1 += tv;
        if (q < 4) r2 += tv;
        if (q < 6) r3 += tv;
      }
      float kd[8];
      const float e_next = __expf(rj1 - rj), e_end = __expf(bendv - rj);
#pragma unroll
      for (int e = 0; e < 8; ++e) {
        const int t = part * 8 + e;
        const float bv = off + cl[e];
        bb[t * 65 + d_] = bv;
        const float kE = kf[e] * __expf(fminf(rj - bv, 80.f));
        kd[e] = kE * e_end;
        KD[t * 72 + d_] = f2bf(kE);
        KE[t * 72 + d_] = f2bf(kE * e_next);
      }
      unsigned* kdp = (unsigned*)(KdT + d_ * 66 + part * 8);
#pragma unroll
      for (int j = 0; j < 4; ++j) kdp[j] = pk_bf16(kd[2 * j], kd[2 * j + 1]);
      if (part == 0) Ftab[0 * 64 + d_] = __expf(r1);
      else if (part == 1) Ftab[1 * 64 + d_] = __expf(r2);
      else if (part == 2) Ftab[2 * 64 + d_] = __expf(r3);
      else if (part == 3) Ftab[3 * 64 + d_] = __expf(r2 - r1);
      else if (part == 4) Ftab[4 * 64 + d_] = __expf(r3 - r1);
      else if (part == 5) Ftab[5 * 64 + d_] = __expf(r3 - r2);
      else if (part == 6) { rtab[d_] = 0.f; rtab[64 + d_] = r1; rtab[128 + d_] = r2; rtab[192 + d_] = r3; }
      else bend[d_] = bendv;
    }
    lds_barrier();
    {
      const int tb = (w < 4) ? w : 7 - w, vh = w >> 2;
      const int t = tb * 16 + c;
      float qtf[2][8];
      bf16x8 qd[2], qe[2];
#pragma unroll
      for (int kk = 0; kk < 2; ++kk) {
        const u32x4 qraw = *(const u32x4*)(Qs + t * 72 + 32 * kk + 8 * g);
        u32x4 a, e2;
#pragma unroll
        for (int j = 0; j < 4; ++j) {
          const int d0 = 32 * kk + 8 * g + 2 * j;
          const float r0 = rtab[tb * 64 + d0], r1 = rtab[tb * 64 + d0 + 1];
          const float b0 = bb[t * 65 + d0], b1 = bb[t * 65 + d0 + 1];
          const float e0 = tb ? Ftab[(tb - 1) * 64 + d0] : 1.f, e1 = tb ? Ftab[(tb - 1) * 64 + d0 + 1] : 1.f;
          const float q0 = bf_lo(qraw[j]) * __expf(b0 - r0), q1 = bf_hi(qraw[j]) * __expf(b1 - r1);
          qtf[kk][2 * j] = q0;
          qtf[kk][2 * j + 1] = q1;
          a[j] = pk_bf16(q0, q1);
          e2[j] = pk_bf16(q0 * e0, q1 * e1);
        }
        qd[kk] = as_bf16x8(a);
        qe[kk] = as_bf16x8(e2);
      }
      unsigned pp[4][2];
#pragma unroll
      for (int st = 0; st < 4; ++st) {
        f32x4 sacc = (f32x4){0.f, 0.f, 0.f, 0.f};
        if (st <= tb) {
          const int s = st * 16 + c;
          if (st == tb) {
#pragma unroll
            for (int kk = 0; kk < 2; ++kk) sacc = mfma16(ld_frag16(KD + s * 72 + 32 * kk + 8 * g), qd[kk], sacc);
#pragma unroll
            for (int rg = 0; rg < 4; ++rg)
              if (4 * g + rg > c) sacc[rg] = 0.f;
          } else if (st + 1 == tb) {
#pragma unroll
            for (int kk = 0; kk < 2; ++kk) sacc = mfma16(ld_frag16(KE + s * 72 + 32 * kk + 8 * g), qd[kk], sacc);
          } else {
            const float* F = Ftab + ((tb == 2) ? 3 : 4 + st) * 64;
#pragma unroll
            for (int kk = 0; kk < 2; ++kk) {
              u32x4 bq;
#pragma unroll
              for (int j = 0; j < 4; ++j) {
                const int d0 = 32 * kk + 8 * g + 2 * j;
                bq[j] = pk_bf16(qtf[kk][2 * j] * F[d0], qtf[kk][2 * j + 1] * F[d0 + 1]);
              }
              sacc = mfma16(ld_frag16(KE + s * 72 + 32 * kk + 8 * g), as_bf16x8(bq), sacc);
            }
          }
        }
        pp[st][0] = pk_bf16(sacc[0], sacc[1]);
        pp[st][1] = pk_bf16(sacc[2], sacc[3]);
      }
      bf16x8 pf[2];
#pragma unroll
      for (int kk = 0; kk < 2; ++kk) {
        u32x4 a;
        a[0] = pp[2 * kk][0]; a[1] = pp[2 * kk][1]; a[2] = pp[2 * kk + 1][0]; a[3] = pp[2 * kk + 1][1];
        pf[kk] = as_bf16x8(a);
      }
      const int tok = base + (dir ? 63 - t : t);
#pragma unroll
      for (int vi = 0; vi < 2; ++vi) {
        const int vt = vh * 2 + vi;
        f32x4 o = (f32x4){0.f, 0.f, 0.f, 0.f};
#pragma unroll
        for (int kk = 0; kk < 2; ++kk) {
          const bf16x8 a = ld_frag16(ST + (vt * 16 + c) * 72 + 32 * kk + 8 * g);
          o = mfma16(a, qe[kk], o);
          const u16* vrow = VT + (vt * 16 + c) * 66 + 32 * kk + 4 * g;
          const bf16x8 a2 = ld_frag4x4(vrow, vrow + 16);
          o = mfma16(a2, pf[kk], o);
        }
        u32x2 ov;
        ov[0] = pk_bf16(o[0], o[1]);
        ov[1] = pk_bf16(o[2], o[3]);
        *(u32x2*)(ob + (size_t)tok * 256 + h * 64 + vt * 16 + 4 * g) = ov;
      }
    }
    {
      const int vt = w >> 1, dh = w & 1;
#pragma unroll
      for (int i2 = 0; i2 < 2; ++i2) {
        const int dt = 2 * dh + i2, dcol = dt * 16 + c;
        const float dec = __expf(bend[dcol]);
        f32x4 a4 = cst[i2] * dec;
#pragma unroll
        for (int kk = 0; kk < 2; ++kk) {
          const u16* ar = VT + (vt * 16 + c) * 66 + 32 * kk + 8 * g;
          const u16* br = KdT + (dt * 16 + c) * 66 + 32 * kk + 8 * g;
          a4 = mfma16(ld_frag4x4(ar, ar + 4), ld_frag4x4(br, br + 4), a4);
        }
        cst[i2] = a4;
#pragma unroll
        for (int rg = 0; rg < 4; ++rg) STn[(vt * 16 + 4 * g + rg) * 72 + dcol] = f2bf(a4[rg]);
      }
    }
  }
}

__device__ void mlstm_chain(const Params& p, int layer, int idx, char* smem) {
  const int b = idx >> 3, h = (idx >> 1) & 3, dir = idx & 1;
  u16* Qs0 = (u16*)smem;
  u16* Ksm0 = (u16*)(smem + 9216);
  u16* VTb = (u16*)(smem + 18432);
  u16* KTwb = (u16*)(smem + 26880);
  u16* CT0 = (u16*)(smem + 35328);
  float* nvv0 = (float*)(smem + 44544);
  float* bsA = (float*)(smem + 45056);
  float* usA = (float*)(smem + 45056 + 9216);
  float* cmA = (float*)(smem + 45056 + 18432);
  const int tid = opaque_tid(), lane = tid & 63, w = __builtin_amdgcn_readfirstlane(tid >> 6), c = lane & 15, g = lane >> 4;
  const int lrow = tid >> 3, c8 = tid & 7;
  const u16* Z = p.z;
  u16* ob = p.obuf + (size_t)(2 + dir) * NTOK * 256;
  f32x4 cst[2];
  cst[0] = (f32x4){0.f, 0.f, 0.f, 0.f};
  cst[1] = cst[0];
  for (int i = tid; i < 64 * 72; i += NTHR) CT0[i] = 0;
  if (tid < 64) nvv0[tid] = 0.f;
  float mprev = 0.f;
  auto chunk_base = [&](int i) {
    if (i < 4) { const int cc = dir ? 3 - i : i; return NLAT + b * CTXL + cc * 64; }
    const int cc = dir ? 31 - (i - 4) : (i - 4);
    return b * SEQ + cc * 64;
  };
  for (int ci = w; ci < 36; ci += 8) {
    const size_t tg = (size_t)(chunk_base(ci) + (dir ? 63 - lane : lane)) * 16;
    const float ig = p.gates[tg + dir * 4 + h], fg = p.gates[tg + 8 + dir * 4 + h];
    const float lf = fminf(fg, 0.f) - __logf(1.f + __expf(-fabsf(fg)));
    float bc = lf;
#pragma unroll
    for (int o = 1; o < 64; o <<= 1) {
      const float t = __shfl_up(bc, o);
      if (lane >= o) bc += t;
    }
    const float u = ig - bc;
    float cm = u;
#pragma unroll
    for (int o = 1; o < 64; o <<= 1) {
      const float t = __shfl_up(cm, o);
      if (lane >= o) cm = fmaxf(cm, t);
    }
    bsA[ci * 64 + lane] = bc;
    usA[ci * 64 + lane] = u;
    cmA[ci * 64 + lane] = cm;
  }
  u32x4 nq, nk, nv;
  {
    const int base = chunk_base(0);
    const size_t ro = (size_t)(base + (dir ? 63 - lrow : lrow)) * ZW;
    nq = *(const u32x4*)(Z + ro + MQ + h * 64 + c8 * 8);
    nk = *(const u32x4*)(Z + ro + MK + h * 64 + c8 * 8);
    nv = *(const u32x4*)(Z + ro + MV + h * 64 + c8 * 8);
  }
  __syncthreads();
  for (int i = 0; i < 36; ++i) {
    const int base = chunk_base(i);
    u16* VT = (i & 1) ? (u16*)(smem + 72704) : VTb;
    u16* KTw = (i & 1) ? (u16*)(smem + 72704 + 8448) : KTwb;
    u16* Qs = (i & 1) ? (u16*)(smem + 89600) : Qs0;
    u16* Ksm = (i & 1) ? (u16*)(smem + 98816) : Ksm0;
    const u16* CT = (i & 1) ? (const u16*)(smem + 108032) : CT0;
    u16* CTn = (i & 1) ? CT0 : (u16*)(smem + 108032);
    const float* nvv = (i & 1) ? (const float*)(smem + 117248) : nvv0;
    float* nvn = (i & 1) ? nvv0 : (float*)(smem + 117248);
    const float* bs = bsA + i * 64;
    const float* us = usA + i * 64;
    const float* cms = cmA + i * 64;
    const float Mend = fmaxf(mprev, cms[63]);
    const float wold = __expf(mprev - Mend);
    const float mnew = bs[63] + Mend;
    *(u32x4*)(Qs + lrow * 72 + c8 * 8) = nq;
    *(u32x4*)(Ksm + lrow * 72 + c8 * 8) = nk;
    {
      const float ws = __expf(us[lrow] - Mend);
#pragma unroll
      for (int j = 0; j < 4; ++j) {
        VT[(c8 * 8 + 2 * j) * 66 + lrow] = (u16)(nv[j] & 0xffffu);
        VT[(c8 * 8 + 2 * j + 1) * 66 + lrow] = (u16)(nv[j] >> 16);
        KTw[(c8 * 8 + 2 * j) * 66 + lrow] = f2bf(bf_lo(nk[j]) * ws);
        KTw[(c8 * 8 + 2 * j + 1) * 66 + lrow] = f2bf(bf_hi(nk[j]) * ws);
      }
    }
    lds_barrier();
    if (i + 1 < 36) {
      const int nb = chunk_base(i + 1);
      const size_t ro = (size_t)(nb + (dir ? 63 - lrow : lrow)) * ZW;
      nq = *(const u32x4*)(Z + ro + MQ + h * 64 + c8 * 8);
      nk = *(const u32x4*)(Z + ro + MK + h * 64 + c8 * 8);
      nv = *(const u32x4*)(Z + ro + MV + h * 64 + c8 * 8);
    }
    {
      const int tb = (w < 4) ? w : 7 - w, vh = w >> 2;
      const int t = tb * 16 + c;
      const float Mt = fmaxf(mprev, cms[t]);
      const float win = __expf(mprev - Mt);
      bf16x8 qf[2];
#pragma unroll
      for (int kk = 0; kk < 2; ++kk) qf[kk] = ld_frag16(Qs + t * 72 + 32 * kk + 8 * g);
      float psum = 0.f;
      unsigned pp[4][2];
#pragma unroll
      for (int st = 0; st < 4; ++st) {
        f32x4 sacc = (f32x4){0.f, 0.f, 0.f, 0.f};
        if (st <= tb) {
#pragma unroll
          for (int kk = 0; kk < 2; ++kk) sacc = mfma16(ld_frag16(Ksm + (st * 16 + c) * 72 + 32 * kk + 8 * g), qf[kk], sacc);
#pragma unroll
          for (int rg = 0; rg < 4; ++rg) {
            const int s = st * 16 + 4 * g + rg;
            const float dv = (s <= t) ? __expf(us[s] - Mt) : 0.f;
            sacc[rg] *= dv;
            psum += sacc[rg];
          }
        }
        pp[st][0] = pk_bf16(sacc[0], sacc[1]);
        pp[st][1] = pk_bf16(sacc[2], sacc[3]);
      }
      psum = xsum16(psum);
      psum = xsum32(psum);
      float qn = 0.f;
      {
        const u32x4 q0 = *(const u32x4*)(Qs + t * 72 + 16 * g), q1 = *(const u32x4*)(Qs + t * 72 + 16 * g + 8);
#pragma unroll
        for (int j = 0; j < 4; ++j) {
          qn += bf_lo(q0[j]) * nvv[16 * g + 2 * j] + bf_hi(q0[j]) * nvv[16 * g + 2 * j + 1];
          qn += bf_lo(q1[j]) * nvv[16 * g + 8 + 2 * j] + bf_hi(q1[j]) * nvv[16 * g + 8 + 2 * j + 1];
        }
      }
      qn = xsum16(qn);
      qn = xsum32(qn);
      const float den = win * qn + psum;
      const float mt = bs[t] + Mt;
      const float hs = __builtin_amdgcn_rcpf(fmaxf(fabsf(den), __expf(-mt)));
      bf16x8 pf[2];
#pragma unroll
      for (int kk = 0; kk < 2; ++kk) {
        u32x4 a;
        a[0] = pp[2 * kk][0]; a[1] = pp[2 * kk][1]; a[2] = pp[2 * kk + 1][0]; a[3] = pp[2 * kk + 1][1];
        pf[kk] = as_bf16x8(a);
      }
      const int tok = base + (dir ? 63 - t : t);
#pragma unroll
      for (int vi = 0; vi < 2; ++vi) {
        const int vt = vh * 2 + vi;
        f32x4 o = (f32x4){0.f, 0.f, 0.f, 0.f};
#pragma unroll
        for (int kk = 0; kk < 2; ++kk) o = mfma16(ld_frag16(CT + (vt * 16 + c) * 72 + 32 * kk + 8 * g), qf[kk], o);
        o = o * win;
#pragma unroll
        for (int kk = 0; kk < 2; ++kk) {
          const u16* vrow = VT + (vt * 16 + c) * 66 + 32 * kk + 4 * g;
          o = mfma16(ld_frag4x4(vrow, vrow + 16), pf[kk], o);
        }
        o = o * hs;
        u32x2 ov;
        ov[0] = pk_bf16(o[0], o[1]);
        ov[1] = pk_bf16(o[2], o[3]);
        *(u32x2*)(ob + (size_t)tok * 256 + h * 64 + vt * 16 + 4 * g) = ov;
      }
    }
    {
      const int vt = w >> 1, dh = w & 1;
#pragma unroll
      for (int i2 = 0; i2 < 2; ++i2) {
        const int dt = 2 * dh + i2, dcol = dt * 16 + c;
        f32x4 a4 = cst[i2] * wold;
#pragma unroll
        for (int kk = 0; kk < 2; ++kk) {
          const u16* ar = VT + (vt * 16 + c) * 66 + 32 * kk + 8 * g;
          const u16* br = KTw + (dt * 16 + c) * 66 + 32 * kk + 8 * g;
          a4 = mfma16(ld_frag4x4(ar, ar + 4), ld_frag4x4(br, br + 4), a4);
        }
        cst[i2] = a4;
#pragma unroll
        for (int rg = 0; rg < 4; ++rg) CTn[(vt * 16 + 4 * g + rg) * 72 + dcol] = f2bf(a4[rg]);
      }
      {
        const int dn = tid >> 3, p8 = tid & 7;
        const unsigned* kr = (const unsigned*)(KTw + dn * 66 + p8 * 8);
        float s = 0.f;
#pragma unroll
        for (int j = 0; j < 4; ++j) s += bf_lo(kr[j]) + bf_hi(kr[j]);
        s += __shfl_xor(s, 1);
        s += __shfl_xor(s, 2);
        s += __shfl_xor(s, 4);
        if (p8 == 0) nvn[dn] = wold * nvv[dn] + s;
      }
      mprev = mnew;
    }
  }
}

__device__ void mixer_phase(const Params& p, int layer, char* smem) {
  const int natt = 256 + 512 + 512 + (layer == 0 ? 128 : 0);
  const int njobs = natt + 64;
  volatile LAS unsigned* slot = (volatile LAS unsigned*)(smem + ST_OFF + 8);
  unsigned* ctr = p.bar + XCD_BAR_WORDS + 64 * layer;
  for (;;) {
    if (threadIdx.x == 0) *slot = atomicAdd(ctr, 1u);
    __syncthreads();
    int job = (int)*slot;
    __syncthreads();
    if (job >= njobs) break;
    if (job >= 256 && job < 320) {
      bias_job(p, layer, job - 256, smem);
      continue;
    }
    if (job >= 320) job -= 64;
    if (job < 256) {
      for (int rep = 0; rep < REP_CHAIN; ++rep) {
        if (job < 128) hgrn_chain(p, layer, job, smem);
        else mlstm_chain(p, layer, job - 128, smem);
        __syncthreads();
      }
    } else {
      for (int rep = 0; rep < REP_ATT; ++rep) {
        if (job < 768) attn_job<0>(p, layer, job - 256, smem);
        else if (job < 1280) attn_job<1>(p, layer, job - 768, smem);
        else if (job < 1344) attn_job<2>(p, layer, job - 1280, smem);
        else attn_job<3>(p, layer, job - 1344, smem);
        __syncthreads();
      }
    }
  }
}

__device__ void combine_phase(const Params& p, int layer, int nrows) {
  const int tid_ = opaque_tid();
  const int lane = tid_ & 63, wid = tid_ >> 6;
  const int mixer = lane >> 5;
  const int col = (lane & 31) * 8;
  const float* gsrc = (mixer == 0 ? p.hgrn_g : p.mlstm_g) + layer * 64 + (col & 63);
  float gv[8];
#pragma unroll
  for (int j = 0; j < 8; ++j) gv[j] = gsrc[j];
  for (int row = blockIdx.x * 8 + wid; row < nrows; row += gridDim.x * 8) {
    const u32x4 a = *(const u32x4*)(p.obuf + ((size_t)(mixer * 2 + 0) * NTOK + row) * 256 + col);
    const u32x4 bq = *(const u32x4*)(p.obuf + ((size_t)(mixer * 2 + 1) * NTOK + row) * 256 + col);
    const u32x4 gz = *(const u32x4*)(p.z + (size_t)row * ZW + (mixer == 0 ? HG : MO) + col);
    float o[8];
    float ss = 0.f;
#pragma unroll
    for (int j = 0; j < 4; ++j) {
      o[2 * j] = bf_lo(a[j]) + bf_lo(bq[j]);
      o[2 * j + 1] = bf_hi(a[j]) + bf_hi(bq[j]);
      ss += o[2 * j] * o[2 * j] + o[2 * j + 1] * o[2 * j + 1];
    }
    ss += __shfl_xor(ss, 1);
    ss += __shfl_xor(ss, 2);
    ss += __shfl_xor(ss, 4);
    const float rs = __builtin_amdgcn_rsqf(ss * (1.f / 64.f) + EPSN);
    u32x4 outv;
#pragma unroll
    for (int j = 0; j < 4; ++j) {
      const float z0 = bf_lo(gz[j]), z1 = bf_hi(gz[j]);
      const float g0 = mixer == 0 ? siluf(z0) : sigmf(z0), g1 = mixer == 0 ? siluf(z1) : sigmf(z1);
      outv[j] = pk_bf16(o[2 * j] * rs * gv[2 * j] * g0, o[2 * j + 1] * rs * gv[2 * j + 1] * g1);
    }
    *(u32x4*)(p.xn + (size_t)row * DM + mixer * 256 + col) = outv;
  }
}

__global__ void __launch_bounds__(NTHR) fwd_megakernel(Params p) {
  extern __shared__ __attribute__((aligned(16))) char smem_raw[];
  cg::grid_group grid = cg::this_grid();
  volatile LAS unsigned* xst = (volatile LAS unsigned*)(smem_raw + ST_OFF);
  if (threadIdx.x == 0) { xst[0] = 0u; xst[1] = 0u; }
  __syncthreads();
  const XcdBarrier xb = xcd_barrier_post(p.bar, xst);
#define SEAM() xcd_barrier(xb)
  prologue_phase(p, smem_raw);
  grid.sync();
  for (int l = 0; l < 2; ++l) {
    const int nMr = (l == 0) ? 144 : 128;
    const int nrows2 = (l == 0) ? NTOK : NLAT;
    for (int rep = 0; rep < REP_NORM; ++rep) { norm_phase(p, l, 0, NTOK, smem_raw); SEAM(); }
    for (int rep = 0; rep < REP_GIN; ++rep) { gemm_phase<EPI_IN, 1024>(p, l, p.xn, p.WinT + (size_t)l * ZW * DM, 144, 14); SEAM(); }
    for (int rep = 0; rep < REP_MIXER; ++rep) { mixer_phase(p, l, smem_raw); SEAM(); }
    for (int rep = 0; rep < REP_COMB; ++rep) { combine_phase(p, l, nrows2); SEAM(); }
    gemm_phase<EPI_OUT, 1024>(p, l, p.xn, p.WoutT + (size_t)l * DM * DM, nMr, 4);
    SEAM();
    for (int rep = 0; rep < REP_MLP1; ++rep) { gemm_phase<EPI_MLP1, 1024>(p, l, p.xn2, p.W1T + (size_t)l * HID * DM, nMr, 16); SEAM(); }
    if (l == 0) gemm_phase<EPI_MLP2, 4096, true>(p, l, p.hid, p.W2T + (size_t)l * DM * HID, 128, 4, 16);
    else if (gridDim.x == 256) gemm_phase<EPI_MLP2F, 4096>(p, l, p.hid, p.W2T + (size_t)l * DM * HID, nMr, 4);
    else { gemm_phase<EPI_MLP2, 4096>(p, l, p.hid, p.W2T + (size_t)l * DM * HID, nMr, 4); SEAM(); final_norm_phase(p); }
    if (l == 0) SEAM();
  }
  for (int e = 0; e < EXTRA_SYNC; ++e) SEAM();
}

extern "C" void kernel_launch(void* const* d_in, const int* in_sizes, int n_in, void* d_out, int out_size, void* d_ws,
                              size_t ws_size, hipStream_t stream) {
  static int grid_blocks = 0;
  if (!grid_blocks) {
    hipFuncSetAttribute((const void*)fwd_megakernel, hipFuncAttributeMaxDynamicSharedMemorySize, LDS_BYTES);
    int dev = 0, cus = 0, per_cu = 0;
    hipGetDevice(&dev);
    hipDeviceGetAttribute(&cus, hipDeviceAttributeMultiprocessorCount, dev);
    hipOccupancyMaxActiveBlocksPerMultiprocessor(&per_cu, fwd_megakernel, NTHR, LDS_BYTES);
    if (per_cu < 1) per_cu = 1;
    if (per_cu > 1) per_cu = 1;
    grid_blocks = cus * per_cu;
  }
  Params p{};
  const float* const* in = (const float* const*)d_in;
  p.x = in[0]; p.c = in[1]; p.ctx = in[2]; p.c_ctx = in[3]; p.w_mod = in[4]; p.b_mod = in[5]; p.g1 = in[6]; p.g2 = in[7];
  p.w_in = in[8]; p.lb_logits = in[9]; p.hgrn_g = in[10]; p.mlstm_b = in[11]; p.mlstm_g = in[12]; p.qn_g = in[13];
  p.kn_g = in[14]; p.rpb = in[15]; p.w_out = in[16]; p.w1 = in[17]; p.w2 = in[18]; p.final_g = in[19];
  p.out = (float*)d_out;
  char* ws = (char*)d_ws;
  size_t off = 0;
  auto take = [&](size_t bytes) { char* r = ws + off; off += (bytes + 255) & ~(size_t)255; return r; };
  p.WinT = (u16*)take((size_t)2 * ZW * DM * 2);
  p.WoutT = (u16*)take((size_t)2 * DM * DM * 2);
  p.W1T = (u16*)take((size_t)2 * HID * DM * 2);
  p.W2T = (u16*)take((size_t)2 * DM * HID * 2);
  p.wg = (float*)take((size_t)2 * 16 * DM * 4);
  p.modv = (float*)take((size_t)2 * 17 * 6 * DM * 4);
  p.ropec = (float*)take((size_t)SEQ * 32 * 4);
  p.ropes = (float*)take((size_t)SEQ * 32 * 4);
  p.gates = (float*)take((size_t)NTOK * 16 * 4);
  p.xcw = (float*)take((size_t)NBATCH * CTXL * DM * 4);
  p.z = (u16*)take((size_t)NTOK * ZW * 2);
  p.xn = (u16*)take((size_t)NTOK * DM * 2);
  p.obuf = (u16*)take((size_t)4 * NTOK * 256 * 2);
  p.hid = p.z;
  p.xn2 = p.obuf;
  p.bias1 = (float*)take((size_t)2 * 17 * HID * 4);
  p.bar = (unsigned*)take((size_t)(XCD_BAR_WORDS + 128 + 2 * NTOK + NLAT + 128) * 4);
  p.rowss = (float*)(p.bar + XCD_BAR_WORDS + 128);
  p.rowssF = p.rowss + 2 * NTOK;
  p.cntF = (unsigned*)(p.rowssF + NLAT);
  if (off > ws_size) fprintf(stderr, "workspace too small: need %zu have %zu\n", off, ws_size);
  (void)hipMemsetAsync(p.bar, 0, (size_t)(XCD_BAR_WORDS + 128 + 2 * NTOK + NLAT + 128) * 4, stream);
  void* args[] = {&p};
  hipError_t e = hipLaunchCooperativeKernel((const void*)fwd_megakernel, dim3(grid_blocks), dim3(NTHR), args, LDS_BYTES, stream);
  if (e != hipSuccess) fprintf(stderr, "cooperative launch failed: %s (grid %d)\n", hipGetErrorString(e), grid_blocks);
}
```

```cpp
#include <hip/hip_runtime.h>
#include <hip/hip_cooperative_groups.h>
#include <cstdio>
#include <cstdint>
namespace cg = cooperative_groups;

typedef unsigned short u16;
typedef short bf16x8 __attribute__((ext_vector_type(8)));
typedef float f32x4 __attribute__((ext_vector_type(4)));
typedef float f32x16 __attribute__((ext_vector_type(16)));
typedef unsigned u32x4 __attribute__((ext_vector_type(4)));
typedef unsigned u32x2 __attribute__((ext_vector_type(2)));
#define DI __device__ __forceinline__

#ifndef PHASE_LIMIT
#define PHASE_LIMIT 1000
#endif
#define REP_MIXER 1
#define REP_GIN 1
#define REP_MLP1 1
#define REP_PROL 1
#define REP_NORM 1
#define REP_COMB 1
#define REP_CHAIN 1
#define REP_ATT 1
#define EXTRA_SYNC 0

constexpr int DM = 1024, NBATCH = 16, SEQ = 2048, CTXL = 256;
constexpr int NLAT = NBATCH * SEQ;
constexpr int NTOK = NLAT + NBATCH * CTXL;
constexpr int ZW = 3584;
constexpr int INW = 3600;
constexpr int HID = 4096;
constexpr int HQ = 0, HI_ = 256, HG = 512, HFF = 768, HFB = 1024, MQ = 1280, MK = 1536, MV = 1792, MO = 2048,
              GQ = 2304, GK = 2560, GV = 2688, NQ = 2816, NK = 3072, NV = 3328;
constexpr float EPSN = 1e-6f;
constexpr float L2E = 1.4426950408889634f;
constexpr int NTHR = 512;
constexpr int LDS_BYTES = 131072 + 8192 + 16;
constexpr int XCH_OFF = 131072, ST_OFF = 131072 + 8192;

struct Params {
  const float *x, *c, *ctx, *c_ctx, *w_mod, *b_mod, *g1, *g2, *w_in, *lb_logits, *hgrn_g, *mlstm_b, *mlstm_g,
      *qn_g, *kn_g, *rpb, *w_out, *w1, *w2, *final_g;
  float* out;
  u16 *WinT, *WoutT, *W1T, *W2T;
  float *wg, *modv, *ropec, *ropes, *gates, *xcw;
  u16 *xn, *z, *obuf, *hid;
  unsigned* bar;
  float *rowss, *bias1, *rowssF;
  unsigned* cntF;
  u16* xn2;
};

DI unsigned pk_bf16(float a, float b) {
  typedef __bf16 bf2 __attribute__((ext_vector_type(2)));
  typedef float f2 __attribute__((ext_vector_type(2)));
  f2 v = {a, b};
  bf2 r = __builtin_convertvector(v, bf2);
  return __builtin_bit_cast(unsigned, r);
}
DI u16 f2bf(float a) { return (u16)(pk_bf16(a, 0.f) & 0xffffu); }
DI float bf_lo(unsigned u) { return __uint_as_float(u << 16); }
DI float bf_hi(unsigned u) { return __uint_as_float(u & 0xffff0000u); }
DI float bf2f(u16 h) { return __uint_as_float(((unsigned)h) << 16); }
DI f32x16 mfma32(bf16x8 a, bf16x8 b, f32x16 c) { return __builtin_amdgcn_mfma_f32_32x32x16_bf16(a, b, c, 0, 0, 0); }
DI f32x4 mfma16(bf16x8 a, bf16x8 b, f32x4 c) { return __builtin_amdgcn_mfma_f32_16x16x32_bf16(a, b, c, 0, 0, 0); }
DI bf16x8 as_bf16x8(u32x4 v) { return __builtin_bit_cast(bf16x8, v); }
DI float xsum32(float x) { auto r = __builtin_amdgcn_permlane32_swap(__float_as_uint(x), __float_as_uint(x), false, false); return __uint_as_float(r[0]) + __uint_as_float(r[1]); }
DI float xsum16(float x) { auto r = __builtin_amdgcn_permlane16_swap(__float_as_uint(x), __float_as_uint(x), false, false); return __uint_as_float(r[0]) + __uint_as_float(r[1]); }
DI float xmax32(float x) { auto r = __builtin_amdgcn_permlane32_swap(__float_as_uint(x), __float_as_uint(x), false, false); return fmaxf(__uint_as_float(r[0]), __uint_as_float(r[1])); }
DI float bfly32(float lo, float hi) { auto r = __builtin_amdgcn_permlane32_swap(__float_as_uint(lo), __float_as_uint(hi), false, false); return __uint_as_float(r[0]) + __uint_as_float(r[1]); }
DI float bfly16(float lo, float hi) { auto r = __builtin_amdgcn_permlane16_swap(__float_as_uint(lo), __float_as_uint(hi), false, false); return __uint_as_float(r[0]) + __uint_as_float(r[1]); }
DI float wave_sum(float v) {
  v = xsum32(v);
  v = xsum16(v);
#pragma unroll
  for (int o = 8; o > 0; o >>= 1) v += __shfl_xor(v, o);
  return v;
}
DI int opaque_tid() { int t = threadIdx.x; asm volatile("" : "+v"(t)); return t; }
DI void lds_barrier() { asm volatile("s_waitcnt lgkmcnt(0)" ::: "memory"); __builtin_amdgcn_s_barrier(); asm volatile("" ::: "memory"); }
DI float fexp(float x) { return __builtin_amdgcn_exp2f(x * L2E); }
DI float siluf(float x) { return x * __builtin_amdgcn_rcpf(1.f + __expf(-x)); }
DI float sigmf(float x) { return __builtin_amdgcn_rcpf(1.f + __expf(-x)); }

#define XB_TMO      128
#define XB_XCNT(j)  (256  + 64 * (j))
#define XB_XSUB(j)  (1280 + 64 * (j))
#define XB_XGEN(j)  (2304 + 64 * (j))
#define XB_TOP      3328
#define XB_TOPGEN   3392
#define XCD_BAR_WORDS 3456
#define XB_SPIN_CAP (1u << 20)
#define LAS __attribute__((address_space(3)))
DI unsigned xb_ld(unsigned* p) { return __hip_atomic_load(p, __ATOMIC_RELAXED, __HIP_MEMORY_SCOPE_AGENT); }
DI unsigned xb_add(unsigned* p, unsigned v) { return __hip_atomic_fetch_add(p, v, __ATOMIC_RELAXED, __HIP_MEMORY_SCOPE_AGENT); }
DI unsigned xb_xcc_id() { return (unsigned)__builtin_amdgcn_s_getreg((3 << 11) | 20) & 0xFu; }
#define XB_SPIN(cond, bar) do { unsigned _sp = 0; while (cond) { __builtin_amdgcn_s_sleep(1); \
    if ((++_sp & 255u) == 0u) { if (xb_ld(&(bar)[XB_TMO])) break; if (_sp > XB_SPIN_CAP) { atomicAdd(&(bar)[XB_TMO], 1u); break; } } } } while (0)
struct XcdBarrier { unsigned* bar; unsigned x; volatile LAS unsigned* st; };
DI XcdBarrier xcd_barrier_post(unsigned* bar, volatile LAS unsigned* st) {
  XcdBarrier b; b.bar = bar; b.x = xb_xcc_id(); b.st = st;
  if (threadIdx.x == 0) (void)xb_add(&bar[XB_XCNT(b.x)], 1u);
  return b;
}
DI void xcd_barrier_complete(unsigned* bar, unsigned x, unsigned& nloc, unsigned& nx) {
  const unsigned G = gridDim.x * gridDim.y * gridDim.z;
  unsigned sum, cnt, mine, sp = 0u;
  for (;;) {
    sum = 0u; cnt = 0u; mine = 0u;
#pragma unroll
    for (unsigned j = 0; j < 16; ++j) { const unsigned c = xb_ld(&bar[XB_XCNT(j)]); sum += c; cnt += (c > 0u) ? 1u : 0u; mine = (j == x) ? c : mine; }
    if (sum == G) break;
    __builtin_amdgcn_s_sleep(1);
    if ((++sp & 255u) == 0u) { if (xb_ld(&bar[XB_TMO])) break; if (sp > XB_SPIN_CAP) { atomicAdd(&bar[XB_TMO], 1u); break; } }
  }
  nloc = mine > 0u ? mine : 1u; nx = cnt > 0u ? cnt : 1u;
}
DI void xcd_barrier(const XcdBarrier& b) {
  asm volatile("s_waitcnt vmcnt(0)" ::: "memory");
  __syncthreads();
  if (threadIdx.x == 0) {
    unsigned* bar = b.bar;
    __builtin_amdgcn_s_waitcnt(0);
    unsigned nloc = b.st[0], nx = b.st[1];
    if (nloc == 0u) { xcd_barrier_complete(bar, b.x, nloc, nx); b.st[0] = nloc; b.st[1] = nx; }
    const unsigned old = xb_add(&bar[XB_XSUB(b.x)], 1u);
    const unsigned gen = old / nloc;
    if (old + 1u == (gen + 1u) * nloc) {
      __builtin_amdgcn_fence(__ATOMIC_RELEASE, "agent");
      asm volatile("s_waitcnt vmcnt(0)" ::: "memory");
      const unsigned og = xb_add(&bar[XB_TOP], 1u);
      const unsigned tg = og / nx;
      if (og + 1u == (tg + 1u) * nx) xb_add(&bar[XB_TOPGEN], 1u);
      else XB_SPIN(xb_ld(&bar[XB_TOPGEN]) == tg, bar);
      __builtin_amdgcn_fence(__ATOMIC_ACQUIRE, "agent");
      xb_add(&bar[XB_XGEN(b.x)], 1u);
      asm volatile("s_waitcnt vmcnt(0)" ::: "memory");
    } else {
      XB_SPIN(xb_ld(&bar[XB_XGEN(b.x)]) == gen, bar);
      __builtin_amdgcn_fence(__ATOMIC_ACQUIRE, "agent");
      asm volatile("s_waitcnt vmcnt(0)" ::: "memory");
    }
  }
  __syncthreads();
}

namespace gm {
constexpr int BM = 256, BK = 64, HALF = 128, HT = HALF * BK, NXCD = 8, WGM = 8;
DI int lds_byte(int r, int c) {
  int st = (r >> 4) * 2 + (c >> 5), rr = r & 15, cc = c & 31, ob = rr * 64 + cc * 2;
  return st * 1024 + (ob ^ (((ob >> 9) & 1) << 5));
}
DI void stage_rc(int b, int& R, int& C) {
  int st = b / 1024, sb = b % 1024, swz = sb ^ (((sb >> 9) & 1) << 5);
  R = (st >> 1) * 16 + swz / 64;
  C = (st & 1) * 32 + (swz % 64) / 2;
}
}

enum { EPI_IN = 0, EPI_OUT = 1, EPI_MLP1 = 2, EPI_MLP2 = 3, EPI_MLP2F = 4 };

template <int EPI>
DI void gemm_epilogue(const Params& p, int layer, f32x4 (&acc)[2][2][4][2], int brow, int bcol, int pn, int wr, int wc,
                      int fr, int fq, char* smem, int ksplit = -1) {
  using namespace gm;
  if (EPI == EPI_IN) {
    u16* Z = p.z;
    const bool latent = brow < NLAT;
    if (pn == 9 || pn == 10) {
      float* xch = (float*)smem;
#pragma unroll
      for (int ai = 0; ai < 2; ++ai)
#pragma unroll
        for (int m = 0; m < 4; ++m)
#pragma unroll
          for (int bj = 0; bj < 2; ++bj) {
            float s = 0.f;
#pragma unroll
            for (int n = 0; n < 2; ++n)
#pragma unroll
              for (int j = 0; j < 4; ++j) s += acc[ai][bj][m][n][j] * acc[ai][bj][m][n][j];
            s = xsum16(s);
            s = xsum32(s);
            if (fq == 0) xch[(ai * 128 + wr * 64 + m * 16 + fr) * 8 + bj * 4 + wc] = s;
          }
      __syncthreads();
      const float* gq = (pn == 9 ? p.qn_g : p.kn_g) + layer * 64;
#pragma unroll
      for (int ai = 0; ai < 2; ++ai)
#pragma unroll
        for (int m = 0; m < 4; ++m) {
          __builtin_amdgcn_sched_barrier(0);
          const int rl = ai * 128 + wr * 64 + m * 16 + fr;
          const int row = brow + rl;
          const int spos = row & (SEQ - 1);
#pragma unroll
          for (int bj = 0; bj < 2; ++bj) {
            const bool normed = (pn == 9) || (bj == 0);
            float rs = 1.f;
            if (normed) {
              float tot = xch[rl * 8 + bj * 4 + wc] + xch[rl * 8 + bj * 4 + (wc ^ 1)];
              rs = __builtin_amdgcn_rsqf(tot * (1.f / 64.f) + EPSN);
            }
            u32x4 o;
#pragma unroll
            for (int n = 0; n < 2; ++n) {
              const int cih = (wc & 1) * 32 + fq * 8 + n * 4;
              f32x4 v = acc[ai][bj][m][n];
              if (normed) {
                f32x4 g = *(const f32x4*)(gq + cih);
                v = v * rs * g;
                if (latent) {
                  const float2 cs = *(const float2*)(p.ropec + spos * 32 + (cih >> 1));
                  const float2 sn = *(const float2*)(p.ropes + spos * 32 + (cih >> 1));
                  f32x4 r;
                  r[0] = v[0] * cs.x - v[1] * sn.x;
                  r[1] = v[0] * sn.x + v[1] * cs.x;
                  r[2] = v[2] * cs.y - v[3] * sn.y;
                  r[3] = v[2] * sn.y + v[3] * cs.y;
                  v = r;
                }
                if (pn == 9) v = v * 0.125f;
              }
              o[2 * n] = pk_bf16(v[0], v[1]);
              o[2 * n + 1] = pk_bf16(v[2], v[3]);
            }
            *(u32x4*)(Z + (size_t)row * ZW + bcol + bj * 128 + wc * 32 + fq * 8) = o;
          }
        }
    } else {
      const float sc = (pn == 0 || pn == 6 || pn == 11) ? 0.125f : 1.f;
      const bool dosilu = (pn == 0);
#pragma unroll
      for (int ai = 0; ai < 2; ++ai)
#pragma unroll
        for (int m = 0; m < 4; ++m) {
          __builtin_amdgcn_sched_barrier(0);
          const int row = brow + ai * 128 + wr * 64 + m * 16 + fr;
#pragma unroll
          for (int bj = 0; bj < 2; ++bj) {
            u32x4 o;
#pragma unroll
            for (int n = 0; n < 2; ++n) {
              f32x4 v = acc[ai][bj][m][n];
              if (dosilu) {
#pragma unroll
                for (int j = 0; j < 4; ++j) v[j] = siluf(v[j]);
              }
              v = v * sc;
              o[2 * n] = pk_bf16(v[0], v[1]);
              o[2 * n + 1] = pk_bf16(v[2], v[3]);
            }
            *(u32x4*)(Z + (size_t)row * ZW + bcol + bj * 128 + wc * 32 + fq * 8) = o;
          }
        }
    }
  } else if (EPI == EPI_MLP1) {
    const int bidx = (brow < NLAT) ? (brow >> 11) : 16;
    const float* bias = p.bias1 + (size_t)(layer * 17 + bidx) * HID;
    const int colb = bcol + wc * 32 + fq * 8;
    f32x4 bv[2][2];
    float rsv[2][4];
#pragma unroll
    for (int bj = 0; bj < 2; ++bj)
#pragma unroll
      for (int n = 0; n < 2; ++n) bv[bj][n] = *(const f32x4*)(bias + colb + bj * 128 + n * 4);
#pragma unroll
    for (int ai = 0; ai < 2; ++ai)
#pragma unroll
      for (int m = 0; m < 4; ++m) rsv[ai][m] = p.rowss[(size_t)layer * NTOK + brow + ai * 128 + wr * 64 + m * 16 + fr];
#pragma unroll
    for (int ai = 0; ai < 2; ++ai)
#pragma unroll
      for (int m = 0; m < 4; ++m) {
        __builtin_amdgcn_sched_barrier(0);
        const int row = brow + ai * 128 + wr * 64 + m * 16 + fr;
        const float rs = __builtin_amdgcn_rsqf(rsv[ai][m] * (1.f / DM) + EPSN);
#pragma unroll
        for (int bj = 0; bj < 2; ++bj) {
          u32x4 o;
#pragma unroll
          for (int n = 0; n < 2; ++n) {
            f32x4 v = acc[ai][bj][m][n] * rs + bv[bj][n];
#pragma unroll
            for (int j = 0; j < 4; ++j) {
              float r = fmaxf(v[j], 0.f);
              v[j] = r * r;
            }
            o[2 * n] = pk_bf16(v[0], v[1]);
            o[2 * n + 1] = pk_bf16(v[2], v[3]);
          }
          *(u32x4*)(p.hid + (size_t)row * HID + colb + bj * 128) = o;
        }
      }
  } else if (EPI == EPI_MLP2F) {
    const int bidx = brow >> 11;
    const float* gate = p.modv + ((size_t)(layer * 17 + bidx) * 6 + 5) * DM;
    const float* src = p.out + (size_t)brow * DM;
    const int colb = bcol + wc * 32 + fq * 8;
    f32x4 gv[2][2];
#pragma unroll
    for (int bj = 0; bj < 2; ++bj)
#pragma unroll
      for (int n = 0; n < 2; ++n) gv[bj][n] = *(const f32x4*)(gate + colb + bj * 128 + n * 4);
#pragma unroll
    for (int am = 0; am < 4; ++am) {
      const int ai = am >> 1, m0 = (am & 1) * 2;
      __builtin_amdgcn_sched_barrier(0);
      f32x4 xv[2][2][2];
#pragma unroll
      for (int mm = 0; mm < 2; ++mm)
#pragma unroll
        for (int bj = 0; bj < 2; ++bj)
#pragma unroll
          for (int n = 0; n < 2; ++n)
            xv[mm][bj][n] = *(const f32x4*)(src + (size_t)(ai * 128 + wr * 64 + (m0 + mm) * 16 + fr) * DM + colb + bj * 128 + n * 4);
      __builtin_amdgcn_sched_barrier(0);
#pragma unroll
      for (int mm = 0; mm < 2; ++mm) {
        const int m = m0 + mm;
        float ssq = 0.f;
#pragma unroll
        for (int bj = 0; bj < 2; ++bj)
#pragma unroll
          for (int n = 0; n < 2; ++n) {
            const f32x4 o = xv[mm][bj][n] + gv[bj][n] * acc[ai][bj][m][n];
            acc[ai][bj][m][n] = o;
            ssq += o[0] * o[0] + o[1] * o[1] + o[2] * o[2] + o[3] * o[3];
          }
        ssq = xsum16(ssq);
        ssq = xsum32(ssq);
        if (fq == 0) atomicAdd(p.rowssF + brow + ai * 128 + wr * 64 + m * 16 + fr, ssq);
      }
    }
    asm volatile("s_waitcnt vmcnt(0)" ::: "memory");
    __syncthreads();
    if (threadIdx.x == 0) {
      unsigned* cnt = p.cntF + (brow >> 8);
      __builtin_amdgcn_fence(__ATOMIC_RELEASE, "agent");
      __hip_atomic_fetch_add(cnt, 1u, __ATOMIC_RELAXED, __HIP_MEMORY_SCOPE_AGENT);
      unsigned spins = 0;
      while (__hip_atomic_load(cnt, __ATOMIC_RELAXED, __HIP_MEMORY_SCOPE_AGENT) < 4u) {
        __builtin_amdgcn_s_sleep(1);
        if (++spins > (1u << 24)) break;
      }
      __builtin_amdgcn_fence(__ATOMIC_ACQUIRE, "agent");
    }
    __syncthreads();
    float rsv[2][4];
#pragma unroll
    for (int ai = 0; ai < 2; ++ai)
#pragma unroll
      for (int m = 0; m < 4; ++m)
        rsv[ai][m] = __hip_atomic_load(p.rowssF + brow + ai * 128 + wr * 64 + m * 16 + fr, __ATOMIC_RELAXED, __HIP_MEMORY_SCOPE_AGENT);
    f32x4 fg[2][2];
#pragma unroll
    for (int bj = 0; bj < 2; ++bj)
#pragma unroll
      for (int n = 0; n < 2; ++n) fg[bj][n] = *(const f32x4*)(p.final_g + colb + bj * 128 + n * 4);
#pragma unroll
    for (int ai = 0; ai < 2; ++ai)
#pragma unroll
      for (int m = 0; m < 4; ++m) {
        __builtin_amdgcn_sched_barrier(0);
        const float rs = __builtin_amdgcn_rsqf(rsv[ai][m] * (1.f / DM) + EPSN);
        float* drow = p.out + (size_t)(brow + ai * 128 + wr * 64 + m * 16 + fr) * DM;
#pragma unroll
        for (int bj = 0; bj < 2; ++bj)
#pragma unroll
          for (int n = 0; n < 2; ++n) *(f32x4*)(drow + colb + bj * 128 + n * 4) = acc[ai][bj][m][n] * rs * fg[bj][n];
      }
  } else {
    const bool latent = brow < NLAT;
    const int bidx = latent ? (brow >> 11) : 16;
    const float* gate = p.modv + ((size_t)(layer * 17 + bidx) * 6 + (EPI == EPI_OUT ? 2 : 5)) * DM;
    const float* src;
    float* dst;
    if (latent) {
      dst = p.out + (size_t)brow * DM;
      src = (EPI == EPI_OUT && layer == 0) ? p.x + (size_t)brow * DM : dst;
    } else {
      dst = p.xcw + (size_t)(brow - NLAT) * DM;
      src = (EPI == EPI_OUT && layer == 0) ? p.ctx + (size_t)(brow - NLAT) * DM : dst;
    }
    const float* sc2 = p.modv + ((size_t)(layer * 17 + bidx) * 6 + 4) * DM;
    const float* g2 = p.g2 + layer * DM;
    const int colb = bcol + wc * 32 + fq * 8;
    if (EPI == EPI_MLP2 && ksplit >= 0) {
      float* pb = (float*)p.obuf + ((size_t)ksplit * (NBATCH * CTXL) + (brow - NLAT)) * DM;
#pragma unroll
      for (int ai = 0; ai < 2; ++ai)
#pragma unroll
        for (int m = 0; m < 4; ++m) {
          __builtin_amdgcn_sched_barrier(0);
          float* drow = pb + (size_t)(ai * 128 + wr * 64 + m * 16 + fr) * DM;
#pragma unroll
          for (int bj = 0; bj < 2; ++bj)
#pragma unroll
            for (int n = 0; n < 2; ++n) {
              const int col = colb + bj * 128 + n * 4;
              *(f32x4*)(drow + col) = *(const f32x4*)(gate + col) * acc[ai][bj][m][n];
            }
        }
      return;
    }
    f32x4 gv[2][2], gs[2][2];
#pragma unroll
    for (int bj = 0; bj < 2; ++bj)
#pragma unroll
      for (int n = 0; n < 2; ++n) {
        const int col = colb + bj * 128 + n * 4;
        gv[bj][n] = *(const f32x4*)(gate + col);
        if (EPI == EPI_OUT) gs[bj][n] = *(const f32x4*)(g2 + col) * (*(const f32x4*)(sc2 + col) + 1.f);
      }
#pragma unroll
    for (int am = 0; am < 4; ++am) {
      const int ai = am >> 1, m0 = (am & 1) * 2;
      __builtin_amdgcn_sched_barrier(0);
      f32x4 xv[2][2][2];
#pragma unroll
      for (int mm = 0; mm < 2; ++mm)
#pragma unroll
        for (int bj = 0; bj < 2; ++bj)
#pragma unroll
          for (int n = 0; n < 2; ++n)
            xv[mm][bj][n] = *(const f32x4*)(src + (size_t)(ai * 128 + wr * 64 + (m0 + mm) * 16 + fr) * DM + colb + bj * 128 + n * 4);
      __builtin_amdgcn_sched_barrier(0);
#pragma unroll
      for (int mm = 0; mm < 2; ++mm) {
        const int m = m0 + mm;
        const int rl = ai * 128 + wr * 64 + m * 16 + fr;
        float ssq = 0.f;
#pragma unroll
        for (int bj = 0; bj < 2; ++bj) {
          u32x4 ob;
#pragma unroll
          for (int n = 0; n < 2; ++n) {
            const int col = colb + bj * 128 + n * 4;
            f32x4 o = xv[mm][bj][n] + gv[bj][n] * acc[ai][bj][m][n];
            *(f32x4*)(dst + (size_t)rl * DM + col) = o;
            if (EPI == EPI_OUT) {
              ssq += o[0] * o[0] + o[1] * o[1] + o[2] * o[2] + o[3] * o[3];
              o = o * gs[bj][n];
              ob[2 * n] = pk_bf16(o[0], o[1]);
              ob[2 * n + 1] = pk_bf16(o[2], o[3]);
            }
          }
          if (EPI == EPI_OUT) *(u32x4*)(p.xn2 + (size_t)(brow + rl) * DM + colb + bj * 128) = ob;
        }
        if (EPI == EPI_OUT) {
          ssq = xsum16(ssq);
          ssq = xsum32(ssq);
          if (fq == 0) atomicAdd(p.rowss + (size_t)layer * NTOK + brow + rl, ssq);
        }
      }
    }
  }
}

template <int EPI, int K, bool SPLIT = false>
__device__ void gemm_phase(const Params& p, int layer, const u16* __restrict__ A, const u16* __restrict__ Bt, int nM, int nN, int nMsplit = 0) {
  using namespace gm;
  extern __shared__ __attribute__((aligned(16))) unsigned char shm[];
  LAS unsigned char* lds = (LAS unsigned char*)shm;
  constexpr int HTB = HT * 2;
#define SAo(b, h) (((b) * 2 + (h)) * HTB)
#define SBo(b, h) ((4 + (b) * 2 + (h)) * HTB)
#define STAGE(bufoff, gbase, voff)                                                                   \
  do {                                                                                               \
    _Pragma("unroll") for (int _i = 0; _i < 2; ++_i)                                                 \
      __builtin_amdgcn_global_load_lds((const unsigned*)((const char*)(gbase) + (voff)[_i]),         \
                                       (LAS unsigned*)(lds + (bufoff) + ldsw + _i * 8192), 16, 0, 0); \
  } while (0)
#define LDA(dst, b, h)                                                                               \
  do {                                                                                               \
    _Pragma("unroll") for (int m = 0; m < 4; ++m) _Pragma("unroll") for (int k = 0; k < 2; ++k)      \
      dst[m][k] = *(const LAS bf16x8*)(lds + SAo(b, h) + aoff + m * 2048 + k * 1024);                \
  } while (0)
#define LDB(dst, b, h)                                                                               \
  do {                                                                                               \
    _Pragma("unroll") for (int n = 0; n < 2; ++n) _Pragma("unroll") for (int k = 0; k < 2; ++k)      \
      dst[n][k] = *(const LAS bf16x8*)(lds + SBo(b, h) + boff + n * 2048 + k * 1024);                \
  } while (0)
#define MMA(ai, bj, At_, Bt_)                                                                        \
  do {                                                                                               \
    __builtin_amdgcn_s_setprio(1);                                                                   \
    _Pragma("unroll") for (int m = 0; m < 4; ++m) _Pragma("unroll") for (int n = 0; n < 2; ++n)      \
      _Pragma("unroll") for (int k = 0; k < 2; ++k)                                                  \
        acc[ai][bj][m][n] = __builtin_amdgcn_mfma_f32_16x16x32_bf16(Bt_[n][k], At_[m][k], acc[ai][bj][m][n], 0, 0, 0); \
    __builtin_amdgcn_s_setprio(0);                                                                   \
  } while (0)
#define WAIT_V(n) asm volatile("s_waitcnt vmcnt(" #n ")" ::: "memory")
#define WAIT_L(n) asm volatile("s_waitcnt lgkmcnt(" #n ")" ::: "memory")
#define BAR __builtin_amdgcn_s_barrier()
#define SCHED __builtin_amdgcn_sched_barrier(0)

  const int nwg = nM * nN;
  const int tid = opaque_tid(), wid = __builtin_amdgcn_readfirstlane(tid >> 6), lane = tid & 63, wr = wid >> 2, wc = wid & 3;
  constexpr int nt = K / BK;
  unsigned voff[2], voffB[2];
#pragma unroll
  for (int i = 0; i < 2; ++i) {
    int r_, c_;
    stage_rc(tid * 16 + i * 8192, r_, c_);
    voff[i] = (unsigned)(r_ * K + c_) * 2u;
    const int rho = r_ & 31, nn = rho >> 4, ii = rho & 15;
    const int rb = (r_ & ~31) + 8 * (ii >> 2) + 4 * nn + (ii & 3);
    voffB[i] = (unsigned)(rb * K + c_) * 2u;
  }
  const size_t kstep = (size_t)(BK * 2);
  const size_t hstep = (size_t)HALF * K * 2;
  const size_t tstep = 2 * hstep;
  const unsigned ldsw = (unsigned)wid * 1024u;
  const int aoff = lds_byte(wr * 64 + (lane & 15), (lane >> 4) * 8), boff = lds_byte(wc * 32 + (lane & 15), (lane >> 4) * 8);
  auto unit = [&](int i, int& pm, int& pn, int& kq) -> bool {
    const long L = (long)i * gridDim.x + blockIdx.x;
    kq = -1;
    if (SPLIT && L >= nwg) {
      const int u = (int)(L - nwg);
      if (u >= 16 * nMsplit) return false;
      pm = nM + (u >> 4); pn = (u >> 2) & 3; kq = u & 3;
      return true;
    }
    if (L >= nwg) return false;
    int wgid = (int)L;
    {
      const int q = nwg / NXCD, r = nwg % NXCD, xcd = wgid % NXCD, off = wgid / NXCD;
      wgid = (xcd < r ? xcd * (q + 1) : r * (q + 1) + (xcd - r) * q) + off;
    }
    const int nig = WGM * nN, gid = wgid / nig, fm = gid * WGM, gsz = min(nM - fm, WGM);
    pm = fm + ((wgid % nig) % gsz);
    pn = (wgid % nig) / gsz;
    return true;
  };
  int pm, pn, kq, npm = 0, npn = 0, nkq = -1, ui = 0;
  if (!unit(0, pm, pn, kq)) return;
  const char* cA = (const char*)A + (size_t)pm * tstep + (kq > 0 ? (size_t)kq * (K / 4) * 2 : 0);
  const char* cB = (const char*)Bt + (size_t)pn * tstep + (kq > 0 ? (size_t)kq * (K / 4) * 2 : 0);
  f32x4 acc[2][2][4][2];
#pragma unroll
  for (int a = 0; a < 2; ++a)
#pragma unroll
    for (int b = 0; b < 2; ++b)
#pragma unroll
      for (int m = 0; m < 4; ++m)
#pragma unroll
        for (int n = 0; n < 2; ++n) acc[a][b][m][n] = (f32x4){0.f, 0.f, 0.f, 0.f};
  bf16x8 At[4][2], B0[2][2], B1[2][2];
  STAGE(SBo(0, 0), cB, voffB); STAGE(SBo(0, 1), cB + hstep, voffB); STAGE(SAo(0, 0), cA, voff); STAGE(SAo(0, 1), cA + hstep, voff);
  if (wr == 1) BAR;
  WAIT_V(2); BAR;
  STAGE(SBo(1, 0), cB + kstep, voffB); STAGE(SAo(1, 0), cA + kstep, voff); STAGE(SBo(1, 1), cB + hstep + kstep, voffB);
  WAIT_V(6); BAR;
  for (;;) {
    const bool has_next = unit(ui + 1, npm, npn, nkq);
    const char* nA = has_next ? (const char*)A + (size_t)npm * tstep + (nkq > 0 ? (size_t)nkq * (K / 4) * 2 : 0) : cA;
    const char* nB = has_next ? (const char*)Bt + (size_t)npn * tstep + (nkq > 0 ? (size_t)nkq * (K / 4) * 2 : 0) : cB;
    const int ntu = (SPLIT && kq >= 0) ? nt / 4 : nt;
    for (int t = 0; t < ntu; t += 2) {
      const bool last = (t == ntu - 2);
      const char* a1 = cA + (size_t)(t + 1) * kstep;
      const char* a2 = last ? nA : cA + (size_t)(t + 2) * kstep;
      const char* b2 = last ? nB : cB + (size_t)(t + 2) * kstep;
      const char* a3 = a2 + kstep;
      const char* b3 = b2 + kstep;
      LDB(B0, 0, 0); LDB(B1, 0, 1); SCHED; LDA(At, 0, 0); STAGE(SAo(1, 1), a1 + hstep, voff);
      WAIT_V(8); WAIT_L(0); BAR; MMA(0, 0, At, B0); MMA(0, 1, At, B1); BAR; SCHED;
      LDA(At, 0, 1); STAGE(SBo(0, 0), b2, voffB); STAGE(SBo(0, 1), b2 + hstep, voffB); STAGE(SAo(0, 0), a2, voff);
      WAIT_V(8); WAIT_L(0); BAR; MMA(1, 0, At, B0); MMA(1, 1, At, B1); BAR; SCHED;
      LDB(B0, 1, 0); LDB(B1, 1, 1); SCHED; LDA(At, 1, 0); STAGE(SAo(0, 1), a2 + hstep, voff);
      WAIT_V(8); WAIT_L(0); BAR; MMA(0, 0, At, B0); MMA(0, 1, At, B1); BAR; SCHED;
      LDA(At, 1, 1); STAGE(SBo(1, 0), b3, voffB); STAGE(SBo(1, 1), b3 + hstep, voffB); STAGE(SAo(1, 0), a3, voff);
      WAIT_V(8); WAIT_L(0); BAR; MMA(1, 0, At, B0); MMA(1, 1, At, B1); BAR; SCHED;
    }
    if (wr == 0) BAR;
    {
      const int tid2 = opaque_tid(), lane2 = tid2 & 63;
      gemm_epilogue<EPI>(p, layer, acc, pm * BM, pn * BM, pn, wr, wc, lane2 & 15, lane2 >> 4, (char*)shm + XCH_OFF, SPLIT ? kq : -1);
    }
    if (!has_next) break;
#pragma unroll
    for (int a = 0; a < 2; ++a)
#pragma unroll
      for (int b = 0; b < 2; ++b)
#pragma unroll
        for (int m = 0; m < 4; ++m)
#pragma unroll
          for (int n = 0; n < 2; ++n) acc[a][b][m][n] = (f32x4){0.f, 0.f, 0.f, 0.f};
    pm = npm; pn = npn; kq = nkq; cA = nA; cB = nB; ++ui;
    if (wr == 1) BAR;
  }
  WAIT_V(0);
  __syncthreads();
#undef SAo
#undef SBo
#undef STAGE
#undef LDA
#undef LDB
#undef MMA
}

__device__ void transpose_tile(const float* __restrict__ src, int ldsrc, int scol0, int k0, u16* __restrict__ dst, int Kd, int drow0, char* smem) {
  float* ts = (float*)smem;
  const int tid = opaque_tid();
  {
    const int kk = tid >> 4, n4 = (tid & 15) * 4;
#pragma unroll
    for (int i = 0; i < 2; ++i) {
      const int k = kk + 32 * i;
      const f32x4 v = *(const f32x4*)(src + (size_t)(k0 + k) * ldsrc + scol0 + n4);
      ts[k * 65 + n4 + 0] = v[0];
      ts[k * 65 + n4 + 1] = v[1];
      ts[k * 65 + n4 + 2] = v[2];
      ts[k * 65 + n4 + 3] = v[3];
    }
  }
  __syncthreads();
  {
    const int n = tid >> 3, k8 = (tid & 7) * 8;
    u32x4 o;
#pragma unroll
    for (int j = 0; j < 4; ++j) o[j] = pk_bf16(ts[(k8 + 2 * j) * 65 + n], ts[(k8 + 2 * j + 1) * 65 + n]);
    *(u32x4*)(dst + (size_t)(drow0 + n) * Kd + k0 + k8) = o;
  }
  __syncthreads();
}

__device__ void mod_job(const Params& p, int job, char* smem) {
  const int l = job / 96, n0 = (job % 96) * 64;
  float* sc = (float*)smem;
  float* red = (float*)(smem + 17 * 1024 * 4);
  const int tid = opaque_tid();
  for (int i = tid; i < 17 * 1024; i += NTHR) {
    const int r = i >> 10, k = i & 1023;
    const float v = (r < 16) ? p.c[r * 1024 + k] : p.c_ctx[k];
    sc[i] = siluf(v);
  }
  __syncthreads();
  const int col = tid & 63, kq = tid >> 6;
  float acc[17];
#pragma unroll
  for (int r = 0; r < 17; ++r) acc[r] = 0.f;
  const float* w = p.w_mod + (size_t)l * 1024 * 6144 + n0 + col;
  for (int k = kq * 128; k < kq * 128 + 128; k += 16) {
    float wv[16];
#pragma unroll
    for (int u = 0; u < 16; ++u) wv[u] = w[(size_t)(k + u) * 6144];
#pragma unroll
    for (int u = 0; u < 16; ++u)
#pragma unroll
      for (int r = 0; r < 17; ++r) acc[r] += sc[r * 1024 + k + u] * wv[u];
  }
#pragma unroll
  for (int r = 0; r < 17; ++r) red[(kq * 17 + r) * 64 + col] = acc[r];
  __syncthreads();
  for (int i = tid; i < 17 * 64; i += NTHR) {
    const int r = i >> 6, cc = i & 63;
    float s = p.b_mod[l * 6144 + n0 + cc];
#pragma unroll
    for (int q = 0; q < 8; ++q) s += red[(q * 17 + r) * 64 + cc];
    const int n = n0 + cc;
    p.modv[((size_t)(l * 17 + r) * 6 + (n >> 10)) * DM + (n & 1023)] = s;
  }
  __syncthreads();
}

__device__ void bias_job(const Params& p, int l, int job, char* smem) {
  const int n0 = job * 64;
  float* sc = (float*)smem;
  float* red = (float*)(smem + 17 * 1024 * 4);
  const int tid = opaque_tid();
  for (int i = tid; i < 17 * 1024; i += NTHR) {
    const int r = i >> 10, k = i & 1023;
    sc[i] = p.modv[((size_t)(l * 17 + r) * 6 + 3) * DM + k];
  }
  __syncthreads();
  const int col = tid & 63, kq = tid >> 6;
  float acc[17];
#pragma unroll
  for (int r = 0; r < 17; ++r) acc[r] = 0.f;
  const float* w = p.w1 + (size_t)l * DM * HID + n0 + col;
  for (int k = kq * 128; k < kq * 128 + 128; k += 16) {
    float wv[16];
#pragma unroll
    for (int u = 0; u < 16; ++u) wv[u] = w[(size_t)(k + u) * HID];
#pragma unroll
    for (int u = 0; u < 16; ++u)
#pragma unroll
      for (int r = 0; r < 17; ++r) acc[r] += sc[r * 1024 + k + u] * wv[u];
  }
#pragma unroll
  for (int r = 0; r < 17; ++r) red[(kq * 17 + r) * 64 + col] = acc[r];
  __syncthreads();
  for (int i = tid; i < 17 * 64; i += NTHR) {
    const int r = i >> 6, cc = i & 63;
    float sum = 0.f;
#pragma unroll
    for (int q = 0; q < 8; ++q) sum += red[(q * 17 + r) * 64 + cc];
    p.bias1[(size_t)(l * 17 + r) * HID + n0 + cc] = sum;
  }
  __syncthreads();
}

__device__ void prologue_phase(const Params& p, char* smem) {
  constexpr int NJ_MOD = 192, NJ_TR = 6400, NJ_G = 2, NJ_R = 16;
  for (int job = blockIdx.x; job < NJ_MOD + NJ_TR + NJ_G + NJ_R; job += gridDim.x) {
    if (job < NJ_MOD) {
      mod_job(p, job, smem);
    } else if (job < NJ_MOD + NJ_TR) {
      int j = job - NJ_MOD;
      const int l = j / 3200;
      j %= 3200;
      if (j < 896) {
        const int kt = j / 56, nt = j % 56;
        const int scol = nt * 64 + (nt >= 36 ? 16 : 0);
        transpose_tile(p.w_in + (size_t)l * DM * INW, INW, scol, kt * 64, p.WinT + (size_t)l * ZW * DM, DM, nt * 64, smem);
      } else if (j < 896 + 256) {
        j -= 896;
        const int kt = j / 16, nt = j % 16;
        transpose_tile(p.w_out + (size_t)l * DM * DM, DM, nt * 64, kt * 64, p.WoutT + (size_t)l * DM * DM, DM, nt * 64, smem);
      } else if (j < 896 + 256 + 1024) {
        j -= 896 + 256;
        const int kt = j / 64, nt = j % 64;
        transpose_tile(p.w1 + (size_t)l * DM * HID, HID, nt * 64, kt * 64, p.W1T + (size_t)l * HID * DM, DM, nt * 64, smem);
      } else {
        j -= 896 + 256 + 1024;
        const int kt = j / 16, nt = j % 16;
        transpose_tile(p.w2 + (size_t)l * HID * DM, DM, nt * 64, kt * 64, p.W2T + (size_t)l * DM * HID, HID, nt * 64, smem);
      }
    } else if (job < NJ_MOD + NJ_TR + NJ_G) {
      const int l = job - NJ_MOD - NJ_TR;
      for (int i = threadIdx.x; i < 16 * 1024; i += NTHR) {
        const int n = i & 15, k = i >> 4;
        p.wg[(size_t)(l * 16 + n) * DM + k] = p.w_in[(size_t)l * DM * INW + (size_t)k * INW + 2304 + n];
      }
    } else {
      const int j = job - NJ_MOD - NJ_TR - NJ_G;
      for (int i = threadIdx.x; i < 4096; i += NTHR) {
        const int e = j * 4096 + i;
        const int s = e >> 5, idx = e & 31;
        const int row = s >> 6, col = s & 63;
        const int fi = idx & 15;
        const float inv = powf(10000.f, -2.0f * (float)fi / 32.f);
        const float ang = (idx < 16 ? (float)row : (float)col) * inv;
        p.ropec[e] = cosf(ang);
        p.ropes[e] = sinf(ang);
      }
    }
  }
}

__device__ void norm_phase(const Params& p, int layer, int which, int nrows, char* smem) {
  const int tid_ = opaque_tid();
  const int lane = tid_ & 63, wid = tid_ >> 6;
  const float* g = (which == 0 ? p.g1 : p.g2) + layer * DM;
  float* wgs = (float*)smem;
  if (which == 0) {
    const float* wgl = p.wg + (size_t)layer * 16 * DM;
    for (int i = tid_; i < 16 * DM / 4; i += NTHR) *(f32x4*)(wgs + i * 4) = *(const f32x4*)(wgl + i * 4);
    __syncthreads();
  }
  for (int pr = blockIdx.x * 8 + wid; pr < nrows / 2; pr += gridDim.x * 8) {
    const int row0 = pr * 2;
    const bool latent = row0 < NLAT;
    const float* src;
    if (which == 0 && layer == 0) src = latent ? p.x + (size_t)row0 * DM : p.ctx + (size_t)(row0 - NLAT) * DM;
    else src = latent ? p.out + (size_t)row0 * DM : p.xcw + (size_t)(row0 - NLAT) * DM;
    const int bidx = latent ? (row0 >> 11) : 16;
    const float* shift = p.modv + ((size_t)(layer * 17 + bidx) * 6 + (which == 0 ? 0 : 3)) * DM;
    const float* scale = shift + DM;
    f32x4 v[2][4];
    float ss0 = 0.f, ss1 = 0.f;
#pragma unroll
    for (int i = 0; i < 4; ++i) {
      v[0][i] = *(const f32x4*)(src + (i >> 1) * 512 + lane * 8 + (i & 1) * 4);
      v[1][i] = *(const f32x4*)(src + DM + (i >> 1) * 512 + lane * 8 + (i & 1) * 4);
    }
    if (which == 0 && layer == 1 && !latent) {
      const float* pb = (const float*)p.obuf + (size_t)(row0 - NLAT) * DM;
#pragma unroll
      for (int q = 0; q < 4; ++q)
#pragma unroll
        for (int i = 0; i < 4; ++i) {
          v[0][i] += *(const f32x4*)(pb + (size_t)q * (NBATCH * CTXL) * DM + (i >> 1) * 512 + lane * 8 + (i & 1) * 4);
          v[1][i] += *(const f32x4*)(pb + (size_t)q * (NBATCH * CTXL) * DM + DM + (i >> 1) * 512 + lane * 8 + (i & 1) * 4);
        }
    }
#pragma unroll
    for (int i = 0; i < 4; ++i) {
      ss0 += v[0][i][0] * v[0][i][0] + v[0][i][1] * v[0][i][1] + v[0][i][2] * v[0][i][2] + v[0][i][3] * v[0][i][3];
      ss1 += v[1][i][0] * v[1][i][0] + v[1][i][1] * v[1][i][1] + v[1][i][2] * v[1][i][2] + v[1][i][3] * v[1][i][3];
    }
    ss0 = xsum16(xsum32(ss0)); ss1 = xsum16(xsum32(ss1));
#pragma unroll
    for (int o = 8; o > 0; o >>= 1) { ss0 += __shfl_xor(ss0, o); ss1 += __shfl_xor(ss1, o); }
    const float rs0 = __builtin_amdgcn_rsqf(ss0 * (1.f / DM) + EPSN), rs1 = __builtin_amdgcn_rsqf(ss1 * (1.f / DM) + EPSN);
#pragma unroll
    for (int i = 0; i < 4; ++i) {
      const int c0 = (i >> 1) * 512 + lane * 8 + (i & 1) * 4;
      const f32x4 gv = *(const f32x4*)(g + c0), sh = *(const f32x4*)(shift + c0), sc = *(const f32x4*)(scale + c0) + 1.f;
      v[0][i] = (v[0][i] * rs0 * gv) * sc + sh;
      v[1][i] = (v[1][i] * rs1 * gv) * sc + sh;
      if (i & 1) {
        u32x4 o;
        o[0] = pk_bf16(v[0][i - 1][0], v[0][i - 1][1]);
        o[1] = pk_bf16(v[0][i - 1][2], v[0][i - 1][3]);
        o[2] = pk_bf16(v[0][i][0], v[0][i][1]);
        o[3] = pk_bf16(v[0][i][2], v[0][i][3]);
        *(u32x4*)(p.xn + (size_t)row0 * DM + c0 - 4) = o;
        o[0] = pk_bf16(v[1][i - 1][0], v[1][i - 1][1]);
        o[1] = pk_bf16(v[1][i - 1][2], v[1][i - 1][3]);
        o[2] = pk_bf16(v[1][i][0], v[1][i][1]);
        o[3] = pk_bf16(v[1][i][2], v[1][i][3]);
        *(u32x4*)(p.xn + (size_t)(row0 + 1) * DM + c0 - 4) = o;
      }
    }
    if (which == 0) {
      float a32[32];
      typedef float f32x2 __attribute__((ext_vector_type(2)));
#pragma unroll
      for (int n = 0; n < 16; ++n) {
        f32x2 a0 = {0.f, 0.f}, a1 = {0.f, 0.f};
#pragma unroll
        for (int i = 0; i < 4; ++i) {
          const f32x4 wv = *(const f32x4*)(wgs + n * DM + (i >> 1) * 512 + lane * 8 + (i & 1) * 4);
          const f32x2 wlo = {wv[0], wv[1]}, whi = {wv[2], wv[3]};
          a0 += (f32x2){v[0][i][0], v[0][i][1]} * wlo;
          a0 += (f32x2){v[0][i][2], v[0][i][3]} * whi;
          a1 += (f32x2){v[1][i][0], v[1][i][1]} * wlo;
          a1 += (f32x2){v[1][i][2], v[1][i][3]} * whi;
        }
        a32[n] = a0[0] + a0[1];
        a32[16 + n] = a1[0] + a1[1];
        if ((n & 1) == 1) __builtin_amdgcn_sched_barrier(0);
      }
#pragma unroll
      for (int i = 0; i < 16; ++i) a32[i] = bfly32(a32[i], a32[i + 16]);
#pragma unroll
      for (int i = 0; i < 8; ++i) a32[i] = bfly16(a32[i], a32[i + 8]);
#pragma unroll
      for (int half = 4; half >= 1; half >>= 1) {
        const int mask = half * 2;
        const bool up = (lane & mask) != 0;
#pragma unroll
        for (int i = 0; i < half; ++i) {
          const float send = up ? a32[i] : a32[i + half];
          const float keep = up ? a32[i + half] : a32[i];
          a32[i] = keep + __shfl_xor(send, mask);
        }
      }
      const float tot = a32[0] + __shfl_xor(a32[0], 1);
      if ((lane & 1) == 0) {
        const int gi = (lane >> 1) & 15;
        p.gates[(size_t)(row0 + (lane >> 5)) * 16 + gi] = tot + p.mlstm_b[layer * 16 + gi];
      }
    }
  }
}

__device__ void final_norm_phase(const Params& p) {
  const int tid_ = opaque_tid();
  const int lane = tid_ & 63, wid = tid_ >> 6;
  for (int row = blockIdx.x * 8 + wid; row < NLAT; row += gridDim.x * 8) {
    float* src = p.out + (size_t)row * DM;
    f32x4 v[4];
    float ss = 0.f;
#pragma unroll
    for (int i = 0; i < 4; ++i) {
      v[i] = *(const f32x4*)(src + i * 256 + lane * 4);
      ss += v[i][0] * v[i][0] + v[i][1] * v[i][1] + v[i][2] * v[i][2] + v[i][3] * v[i][3];
    }
    ss = wave_sum(ss);
    const float rs = __builtin_amdgcn_rsqf(ss * (1.f / DM) + EPSN);
#pragma unroll
    for (int i = 0; i < 4; ++i) {
      const int c0 = i * 256 + lane * 4;
      const f32x4 gv = *(const f32x4*)(p.final_g + c0);
      *(f32x4*)(src + c0) = v[i] * rs * gv;
    }
  }
}

constexpr int KS_STRIDE = 72, VT_STRIDE = 66;
DI bf16x8 ld_frag16(const u16* base) { return *(const bf16x8*)base; }
DI bf16x8 ld_frag4x4(const u16* a, const u16* b) {
  u32x4 r;
  const unsigned* pa = (const unsigned*)a;
  const unsigned* pb = (const unsigned*)b;
  r[0] = pa[0]; r[1] = pa[1]; r[2] = pb[0]; r[3] = pb[1];
  return as_bf16x8(r);
}


#define TRR(i, off) "ds_read_b64_tr_b16 %" #i ", %16 offset:" #off "\n\t"
DI void tr_read_vtile(u32x2 (&r)[16], unsigned addr) {
  asm volatile(
      TRR(0, 0)     TRR(1, 1152)  TRR(2, 64)    TRR(3, 1216)
      TRR(4, 2304)  TRR(5, 3456)  TRR(6, 2368)  TRR(7, 3520)
      TRR(8, 4608)  TRR(9, 5760)  TRR(10, 4672) TRR(11, 5824)
      TRR(12, 6912) TRR(13, 8064) TRR(14, 6976) TRR(15, 8128)
      "s_waitcnt lgkmcnt(0)"
      : "=&v"(r[0]), "=&v"(r[1]), "=&v"(r[2]), "=&v"(r[3]), "=&v"(r[4]), "=&v"(r[5]), "=&v"(r[6]), "=&v"(r[7]),
        "=&v"(r[8]), "=&v"(r[9]), "=&v"(r[10]), "=&v"(r[11]), "=&v"(r[12]), "=&v"(r[13]), "=&v"(r[14]), "=&v"(r[15])
      : "v"(addr)
      : "memory");
}

DI void tr_read_vtile8(u32x2 (&r)[8], unsigned addr) {
  asm volatile(
      "ds_read_b64_tr_b16 %0, %8 offset:0\n\tds_read_b64_tr_b16 %1, %8 offset:1152\n\t"
      "ds_read_b64_tr_b16 %2, %8 offset:64\n\tds_read_b64_tr_b16 %3, %8 offset:1216\n\t"
      "ds_read_b64_tr_b16 %4, %8 offset:2304\n\tds_read_b64_tr_b16 %5, %8 offset:3456\n\t"
      "ds_read_b64_tr_b16 %6, %8 offset:2368\n\tds_read_b64_tr_b16 %7, %8 offset:3520\n\t"
      "s_waitcnt lgkmcnt(0)"
      : "=&v"(r[0]), "=&v"(r[1]), "=&v"(r[2]), "=&v"(r[3]), "=&v"(r[4]), "=&v"(r[5]), "=&v"(r[6]), "=&v"(r[7])
      : "v"(addr)
      : "memory");
}

template <int NB>
DI void softmax_pv(f32x16 (&s)[2], float& mrun, float& lsum, f32x16 (&O)[2], unsigned vaddr) {
  u32x2 vf[16];
  u32x2 vf8[8];
  if (NB == 2) tr_read_vtile(vf, vaddr);
  else tr_read_vtile8(vf8, vaddr);
  float mx = -1e30f;
#pragma unroll
  for (int kb = 0; kb < NB; ++kb)
#pragma unroll
    for (int e = 0; e < 16; ++e) mx = fmaxf(mx, s[kb][e]);
  mx = xmax32(mx);
  constexpr float THR = 6.f;
  float alpha = 1.f;
  if (__builtin_amdgcn_ballot_w64(mx - mrun > THR) != 0ull) {
    const float mnew = fmaxf(mrun, mx);
    alpha = __builtin_amdgcn_exp2f((mrun - mnew) * L2E);
    mrun = mnew;
#pragma unroll
    for (int e = 0; e < 16; ++e) { O[0][e] *= alpha; O[1][e] *= alpha; }
  }
  typedef float f32x2 __attribute__((ext_vector_type(2)));
  const float mb = mrun * L2E;
  f32x2 ps2 = {0.f, 0.f};
  const f32x2 l2e2 = {L2E, L2E}, mb2 = {mb, mb};
  if (NB == 2) {
#pragma unroll
    for (int kb = 0; kb < 2; ++kb) {
#pragma unroll
      for (int e = 0; e < 16; e += 2) {
        f32x2 t = {s[kb][e], s[kb][e + 1]};
        t = t * l2e2 - mb2;
        f32x2 pv;
        pv[0] = __builtin_amdgcn_exp2f(t[0]);
        pv[1] = __builtin_amdgcn_exp2f(t[1]);
        s[kb][e] = pv[0];
        s[kb][e + 1] = pv[1];
        ps2 += pv;
      }
      u32x4 pp[2];
#pragma unroll
      for (int st = 0; st < 2; ++st)
#pragma unroll
        for (int j = 0; j < 4; ++j) pp[st][j] = pk_bf16(s[kb][8 * st + 2 * j], s[kb][8 * st + 2 * j + 1]);
      __builtin_amdgcn_sched_barrier(0);
      __builtin_amdgcn_s_setprio(1);
#pragma unroll
      for (int st = 0; st < 2; ++st) {
        const bf16x8 pf = as_bf16x8(pp[st]);
#pragma unroll
        for (int db = 0; db < 2; ++db) {
          const int ix = ((kb * 2 + st) * 2 + db) * 2;
          u32x4 av;
          av[0] = vf[ix][0]; av[1] = vf[ix][1]; av[2] = vf[ix + 1][0]; av[3] = vf[ix + 1][1];
          O[db] = mfma32(as_bf16x8(av), pf, O[db]);
        }
      }
      __builtin_amdgcn_s_setprio(0);
      __builtin_amdgcn_sched_barrier(0);
    }
  } else {
#pragma unroll
    for (int e = 0; e < 16; e += 2) {
      f32x2 t = {s[0][e], s[0][e + 1]};
      t = t * l2e2 - mb2;
      f32x2 pv;
      pv[0] = __builtin_amdgcn_exp2f(t[0]);
      pv[1] = __builtin_amdgcn_exp2f(t[1]);
      s[0][e] = pv[0];
      s[0][e + 1] = pv[1];
      ps2 += pv;
    }
    __builtin_amdgcn_s_setprio(1);
#pragma unroll
    for (int st = 0; st < 2; ++st) {
      u32x4 pp;
#pragma unroll
      for (int j = 0; j < 4; ++j) pp[j] = pk_bf16(s[0][8 * st + 2 * j], s[0][8 * st + 2 * j + 1]);
      const bf16x8 pf = as_bf16x8(pp);
#pragma unroll
      for (int db = 0; db < 2; ++db) {
        const int ix = (st * 2 + db) * 2;
        u32x4 av;
        av[0] = vf8[ix][0]; av[1] = vf8[ix][1]; av[2] = vf8[ix + 1][0]; av[3] = vf8[ix + 1][1];
        O[db] = mfma32(as_bf16x8(av), pf, O[db]);
      }
    }
    __builtin_amdgcn_s_setprio(0);
  }
  lsum = lsum * alpha + (ps2[0] + ps2[1]);
}

template <int kind>
__device__ void attn_job(const Params& p, int layer, int idx, char* smem) {
  u16* Ks = (u16*)smem;
  u16* Vt = (u16*)(smem + 2 * 64 * KS_STRIDE * 2);
  float* rpbs = (float*)(smem + 4 * 64 * KS_STRIDE * 2);
  const int tid = opaque_tid(), lane = tid & 63, w = __builtin_amdgcn_readfirstlane(tid >> 6), tq = lane & 31, hh = lane >> 5;
  int b, qtok, qcol, ocol, kcol, vcol, nlat = 0, lat0 = 0, R0 = 0, hN = 0;
  int qrow_l = 0, qc = 0, k0 = 0, r0A = 0, r0l = 0;
  if (kind == 0) {
    b = idx >> 5; const int kvh = (idx >> 4) & 1, qt = idx & 15;
    const int head = kvh * 2 + (w >> 2);
    qtok = b * SEQ + qt * 128 + (w & 3) * 32 + tq; qcol = GQ + head * 64; ocol = 512 + head * 64;
    kcol = GK + kvh * 64; vcol = GV + kvh * 64; nlat = 32; lat0 = b * SEQ;
  } else if (kind == 1) {
    b = idx >> 5; hN = (idx >> 3) & 3; const int rg = idx & 7;
    const int rA = rg * 4 + 2 * (w >> 2), cb = w & 3;
    qrow_l = rA + (tq >> 4); qc = 16 * cb + (tq & 15);
    qtok = b * SEQ + qrow_l * 64 + qc; qcol = NQ + hN * 64; ocol = 768 + hN * 64;
    kcol = NK + hN * 64; vcol = NV + hN * 64;
    R0 = min(max(rg * 4 - 4, 0), 24);
    const int R1 = min(max(rg * 4 + 3 - 4, 0), 24) + 8;
    nlat = R1 - R0; lat0 = b * SEQ + R0 * 64;
    k0 = min(max(16 * cb - 8, 0), 32);
    r0A = min(max(rA - 4, 0), 24);
    r0l = min(max(qrow_l - 4, 0), 24);
  } else if (kind == 2) {
    b = idx >> 2; const int kvh = (idx >> 1) & 1, half = idx & 1;
    const int head = kvh * 2 + (w >> 2);
    qtok = NLAT + b * CTXL + half * 128 + (w & 3) * 32 + tq; qcol = GQ + head * 64; ocol = 512 + head * 64;
    kcol = GK + kvh * 64; vcol = GV + kvh * 64;
  } else {
    b = idx >> 2; hN = idx & 3;
    qtok = NLAT + b * CTXL + w * 32 + tq; qcol = NQ + hN * 64; ocol = 768 + hN * 64;
    kcol = NK + hN * 64; vcol = NV + hN * 64;
  }
  const int ntiles = 4 + nlat;
  const u16* Z = p.z;
  if (kind == 1) {
    for (int i = tid; i < 16 + 15 * 32 + 32; i += NTHR) {
      const int j = i - 16, rr = j >> 5, cc = j & 31;
      rpbs[i] = (j >= 0 && rr < 15 && cc < 31) ? p.rpb[((size_t)(layer * 4 + hN) * 15 + rr) * 31 + cc] : 0.f;
    }
  }
  bf16x8 qf[4];
#pragma unroll
  for (int st = 0; st < 4; ++st) qf[st] = *(const bf16x8*)(Z + (size_t)qtok * ZW + qcol + 16 * st + 8 * hh);
  unsigned colmask = 0;
  int dcbase = 0;
  if (kind == 1) {
    const int cs = min(max(qc - 8, 0), 48);
#pragma unroll
    for (int e = 0; e < 16; ++e) {
      const int kc = k0 + (e & 3) + 8 * (e >> 2) + 4 * hh;
      colmask |= ((kc >= cs) && (kc < cs + 16)) ? (1u << e) : 0u;
    }
    dcbase = 16 + k0 + 4 * hh - qc + 15;
  }
  float mrun = -1e30f, lsum = 0.f;
  f32x16 O[2], zero16;
#pragma unroll
  for (int i = 0; i < 16; ++i) { O[0][i] = 0.f; O[1][i] = 0.f; zero16[i] = 0.f; }
  asm volatile("" : "+v"(zero16));
  const int lkey = tid >> 3, lc = tid & 7;
  const unsigned vlane_off = (unsigned)((4 * (lane >> 5) + ((lane & 15) >> 2)) * (KS_STRIDE * 2) + (((lane >> 4) & 1) * 16 + 4 * (lane & 3)) * 2);
  auto tile_row0 = [&](int i) { return (i < 4) ? (NLAT + b * CTXL + i * 64) : (lat0 + (i - 4) * 64); };
  u32x4 kreg, vreg;
  {
    const size_t ro = (size_t)(tile_row0(0) + lkey) * ZW;
    kreg = *(const u32x4*)(Z + ro + kcol + lc * 8);
    vreg = *(const u32x4*)(Z + ro + vcol + lc * 8);
  }
  for (int i = 0; i < ntiles; ++i) {
    u16* Kb = Ks + (i & 1) * 64 * KS_STRIDE;
    u16* Vb = Vt + (i & 1) * 64 * KS_STRIDE;
    *(u32x4*)(Kb + lkey * KS_STRIDE + lc * 8) = kreg;
    *(u32x4*)(Vb + lkey * KS_STRIDE + lc * 8) = vreg;
    lds_barrier();
    if (i + 1 < ntiles) {
      const size_t ro = (size_t)(tile_row0(i + 1) + lkey) * ZW;
      kreg = *(const u32x4*)(Z + ro + kcol + lc * 8);
      vreg = *(const u32x4*)(Z + ro + vcol + lc * 8);
    }
    if (kind == 1 && i >= 4) {
      const int kr = R0 + i - 4;
      if (kr >= r0A && kr < r0A + 9) {
        f32x16 s[2];
#pragma unroll
        for (int st = 0; st < 4; ++st) s[0] = mfma32(ld_frag16(Kb + (k0 + tq) * KS_STRIDE + 16 * st + 8 * hh), qf[st], st == 0 ? zero16 : s[0]);
        const bool rowvalid = (kr >= r0l) && (kr < r0l + 8);
        const unsigned m = rowvalid ? colmask : 0u;
        const float* brow = rpbs + (kr - qrow_l + 7) * 32 + dcbase;
#pragma unroll
        for (int e = 0; e < 16; ++e) {
          const float bias = brow[(e & 3) + 8 * (e >> 2)];
          s[0][e] = ((m >> e) & 1u) ? s[0][e] + bias : -1e30f;
        }
        softmax_pv<1>(s, mrun, lsum, O, (unsigned)(size_t)Vb + vlane_off + (unsigned)(k0 * KS_STRIDE * 2));
      }
    } else {
      f32x16 s[2];
      __builtin_amdgcn_s_setprio(1);
#pragma unroll
      for (int kb = 0; kb < 2; ++kb) {
#pragma unroll
        for (int st = 0; st < 4; ++st) s[kb] = mfma32(ld_frag16(Kb + (kb * 32 + tq) * KS_STRIDE + 16 * st + 8 * hh), qf[st], st == 0 ? zero16 : s[kb]);
      }
      __builtin_amdgcn_s_setprio(0);
      softmax_pv<2>(s, mrun, lsum, O, (unsigned)(size_t)Vb + vlane_off);
    }
  }
  lsum = xsum32(lsum);
  const float inv = 1.f / lsum;
  u16* dst = p.xn + (size_t)qtok * DM + ocol;
#pragma unroll
  for (int db = 0; db < 2; ++db)
#pragma unroll
    for (int k = 0; k < 2; ++k) {
      const int gA = 2 * k, gB = 2 * k + 1;
      const unsigned x0 = pk_bf16(O[db][4 * gA + 0] * inv, O[db][4 * gA + 1] * inv), x1 = pk_bf16(O[db][4 * gA + 2] * inv, O[db][4 * gA + 3] * inv);
      const unsigned y0 = pk_bf16(O[db][4 * gB + 0] * inv, O[db][4 * gB + 1] * inv), y1 = pk_bf16(O[db][4 * gB + 2] * inv, O[db][4 * gB + 3] * inv);
      auto r0 = __builtin_amdgcn_permlane32_swap(x0, y0, false, false);
      auto r1 = __builtin_amdgcn_permlane32_swap(x1, y1, false, false);
      u32x4 wv;
      wv[0] = r0[0]; wv[1] = r1[0]; wv[2] = r0[1]; wv[3] = r1[1];
      *(u32x4*)(dst + db * 32 + 16 * k + 8 * hh) = wv;
    }
  __syncthreads();
}

__device__ void hgrn_chain(const Params& p, int layer, int idx, char* smem) {
  const int b = idx >> 3, h = (idx >> 1) & 3, dir = idx & 1;
  u16* Qs0 = (u16*)smem;
  u16* Qs1 = (u16*)(smem + 92928);
  u16* VT0 = (u16*)(smem + 9216);
  u16* VT1 = (u16*)(smem + 75264);
  float* bb = (float*)(smem + 17664);
  u16* KD = (u16*)(smem + 34304);
  u16* KE = (u16*)(smem + 43520);
  u16* KdT = (u16*)(smem + 52736);
  u16* ST0 = (u16*)(smem + 61184);
  u16* ST1 = (u16*)(smem + 83712);
  float* tot = (float*)(smem + 70400);
  float* bend = (float*)(smem + 72448);
  float* Ftab = (float*)(smem + 72704);
  float* rtab = (float*)(smem + 74240);
  const int tid = opaque_tid(), lane = tid & 63, w = __builtin_amdgcn_readfirstlane(tid >> 6), c = lane & 15, g = lane >> 4;
  const int d_ = tid & 63, part = w;
  const int lrow = tid >> 3, c8 = tid & 7;
  float lb = 0.f;
  if (layer == 1) {
    const float l0 = p.lb_logits[(0 * 2 + dir) * 256 + h * 64 + d_], l1 = p.lb_logits[(1 * 2 + dir) * 256 + h * 64 + d_];
    lb = 1.f / (1.f + __expf(l0 - l1));
  }
  const int fcol = (dir ? HFB : HFF) + h * 64;
  const u16* Z = p.z;
  u16* ob = p.obuf + (size_t)(0 * 2 + dir) * NTOK * 256;
  f32x4 cst[2];
  cst[0] = (f32x4){0.f, 0.f, 0.f, 0.f};
  cst[1] = cst[0];
  for (int i = tid; i < 64 * 72; i += NTHR) ST0[i] = 0;
  auto chunk_base = [&](int i) {
    if (i < 4) { const int cc = dir ? 3 - i : i; return NLAT + b * CTXL + cc * 64; }
    const int cc = dir ? 31 - (i - 4) : (i - 4);
    return b * SEQ + cc * 64;
  };
  u32x4 nq, nv;
  u16 nf[8];
  {
    const int base = chunk_base(0);
    const size_t ro = (size_t)(base + (dir ? 63 - lrow : lrow)) * ZW;
    nq = *(const u32x4*)(Z + ro + HQ + h * 64 + c8 * 8);
    nv = *(const u32x4*)(Z + ro + HI_ + h * 64 + c8 * 8);
#pragma unroll
    for (int e = 0; e < 8; ++e) {
      const int t = part * 8 + e;
      nf[e] = Z[(size_t)(base + (dir ? 63 - t : t)) * ZW + fcol + d_];
    }
  }
  __syncthreads();
  for (int i = 0; i < 36; ++i) {
    const int base = chunk_base(i);
    u16* VT = (i & 1) ? VT1 : VT0;
    u16* Qs = (i & 1) ? Qs1 : Qs0;
    const u16* ST = (i & 1) ? ST1 : ST0;
    u16* STn = (i & 1) ? ST0 : ST1;
    *(u32x4*)(Qs + lrow * 72 + c8 * 8) = nq;
#pragma unroll
    for (int j = 0; j < 4; ++j) {
      VT[(c8 * 8 + 2 * j) * 66 + lrow] = (u16)(nv[j] & 0xffffu);
      VT[(c8 * 8 + 2 * j + 1) * 66 + lrow] = (u16)(nv[j] >> 16);
    }
    float cl[8], kf[8];
    {
      float cum = 0.f;
#pragma unroll
      for (int e = 0; e < 8; ++e) {
        const float f = bf2f(nf[e]);
        const float ef = __expf(-f);
        const float sig = __builtin_amdgcn_rcpf(1.f + ef);
        const float forget = lb + (1.f - lb) * sig;
        cum += __logf(fmaxf(forget, 1e-20f));
        cl[e] = cum;
        kf[e] = (1.f - lb) * (ef * sig);
      }
      tot[part * 64 + d_] = cum;
    }
    lds_barrier();
    if (i + 1 < 36) {
      const int nb = chunk_base(i + 1);
      const size_t ro = (size_t)(nb + (dir ? 63 - lrow : lrow)) * ZW;
      nq = *(const u32x4*)(Z + ro + HQ + h * 64 + c8 * 8);
      nv = *(const u32x4*)(Z + ro + HI_ + h * 64 + c8 * 8);
#pragma unroll
      for (int e = 0; e < 8; ++e) {
        const int t = part * 8 + e;
        nf[e] = Z[(size_t)(nb + (dir ? 63 - t : t)) * ZW + fcol + d_];
      }
    }
    {
      const int jsub = part >> 1;
      float off = 0.f, bendv = 0.f, rj = 0.f, rj1 = 0.f, r1 = 0.f, r2 = 0.f, r3 = 0.f;
#pragma unroll
      for (int q = 0; q < 8; ++q) {
        const float tv = tot[q * 64 + d_];
        bendv += tv;
        if (q < part) off += tv;
        if (q < 2 * jsub) rj += tv;
        if (q < 2 * jsub + 2) rj1 += tv;
        if (q < 2) r1 += tv;
        if (q < 4) r2 += tv;
        if (q < 6) r3 += tv;
      }
      float kd[8];
      const float e_next = __expf(rj1 - rj), e_end = __expf(bendv - rj);
#pragma unroll
      for (int e = 0; e < 8; ++e) {
        const int t = part * 8 + e;
        const float bv = off + cl[e];
        bb[t * 65 + d_] = bv;
        const float kE = kf[e] * __expf(fminf(rj - bv, 80.f));
        kd[e] = kE * e_end;
        KD[t * 72 + d_] = f2bf(kE);
        KE[t * 72 + d_] = f2bf(kE * e_next);
      }
      unsigned* kdp = (unsigned*)(KdT + d_ * 66 + part * 8);
#pragma unroll
      for (int j = 0; j < 4; ++j) kdp[j] = pk_bf16(kd[2 * j], kd[2 * j + 1]);
      if (part == 0) Ftab[0 * 64 + d_] = __expf(r1);
      else if (part == 1) Ftab[1 * 64 + d_] = __expf(r2);
      else if (part == 2) Ftab[2 * 64 + d_] = __expf(r3);
      else if (part == 3) Ftab[3 * 64 + d_] = __expf(r2 - r1);
      else if (part == 4) Ftab[4 * 64 + d_] = __expf(r3 - r1);
      else if (part == 5) Ftab[5 * 64 + d_] = __expf(r3 - r2);
      else if (part == 6) { rtab[d_] = 0.f; rtab[64 + d_] = r1; rtab[128 + d_] = r2; rtab[192 + d_] = r3; }
      else bend[d_] = bendv;
    }
    lds_barrier();
    {
      const int tb = (w < 4) ? w : 7 - w, vh = w >> 2;
      const int t = tb * 16 + c;
      float qtf[2][8];
      bf16x8 qd[2], qe[2];
#pragma unroll
      for (int kk = 0; kk < 2; ++kk) {
        const u32x4 qraw = *(const u32x4*)(Qs + t * 72 + 32 * kk + 8 * g);
        u32x4 a, e2;
#pragma unroll
        for (int j = 0; j < 4; ++j) {
          const int d0 = 32 * kk + 8 * g + 2 * j;
          const float r0 = rtab[tb * 64 + d0], r1 = rtab[tb * 64 + d0 + 1];
          const float b0 = bb[t * 65 + d0], b1 = bb[t * 65 + d0 + 1];
          const float e0 = tb ? Ftab[(tb - 1) * 64 + d0] : 1.f, e1 = tb ? Ftab[(tb - 1) * 64 + d0 + 1] : 1.f;
          const float q0 = bf_lo(qraw[j]) * __expf(b0 - r0), q1 = bf_hi(qraw[j]) * __expf(b1 - r1);
          qtf[kk][2 * j] = q0;
          qtf[kk][2 * j + 1] = q1;
          a[j] = pk_bf16(q0, q1);
          e2[j] = pk_bf16(q0 * e0, q1 * e1);
        }
        qd[kk] = as_bf16x8(a);
        qe[kk] = as_bf16x8(e2);
      }
      unsigned pp[4][2];
#pragma unroll
      for (int st = 0; st < 4; ++st) {
        f32x4 sacc = (f32x4){0.f, 0.f, 0.f, 0.f};
        if (st <= tb) {
          const int s = st * 16 + c;
          if (st == tb) {
#pragma unroll
            for (int kk = 0; kk < 2; ++kk) sacc = mfma16(ld_frag16(KD + s * 72 + 32 * kk + 8 * g), qd[kk], sacc);
#pragma unroll
            for (int rg = 0; rg < 4; ++rg)
              if (4 * g + rg > c) sacc[rg] = 0.f;
          } else if (st + 1 == tb) {
#pragma unroll
            for (int kk = 0; kk < 2; ++kk) sacc = mfma16(ld_frag16(KE + s * 72 + 32 * kk + 8 * g), qd[kk], sacc);
          } else {
            const float* F = Ftab + ((tb == 2) ? 3 : 4 + st) * 64;
#pragma unroll
            for (int kk = 0; kk < 2; ++kk) {
              u32x4 bq;
#pragma unroll
              for (int j = 0; j < 4; ++j) {
                const int d0 = 32 * kk + 8 * g + 2 * j;
                bq[j] = pk_bf16(qtf[kk][2 * j] * F[d0], qtf[kk][2 * j + 1] * F[d0 + 1]);
              }
              sacc = mfma16(ld_frag16(KE + s * 72 + 32 * kk + 8 * g), as_bf16x8(bq), sacc);
            }
          }
        }
        pp[st][0] = pk_bf16(sacc[0], sacc[1]);
        pp[st][1] = pk_bf16(sacc[2], sacc[3]);
      }
      bf16x8 pf[2];
#pragma unroll
      for (int kk = 0; kk < 2; ++kk) {
        u32x4 a;
        a[0] = pp[2 * kk][0]; a[1] = pp[2 * kk][1]; a[2] = pp[2 * kk + 1][0]; a[3] = pp[2 * kk + 1][1];
        pf[kk] = as_bf16x8(a);
      }
      const int tok = base + (dir ? 63 - t : t);
#pragma unroll
      for (int vi = 0; vi < 2; ++vi) {
        const int vt = vh * 2 + vi;
        f32x4 o = (f32x4){0.f, 0.f, 0.f, 0.f};
#pragma unroll
        for (int kk = 0; kk < 2; ++kk) {
          const bf16x8 a = ld_frag16(ST + (vt * 16 + c) * 72 + 32 * kk + 8 * g);
          o = mfma16(a, qe[kk], o);
          const u16* vrow = VT + (vt * 16 + c) * 66 + 32 * kk + 4 * g;
          const bf16x8 a2 = ld_frag4x4(vrow, vrow + 16);
          o = mfma16(a2, pf[kk], o);
        }
        u32x2 ov;
        ov[0] = pk_bf16(o[0], o[1]);
        ov[1] = pk_bf16(o[2], o[3]);
        *(u32x2*)(ob + (size_t)tok * 256 + h * 64 + vt * 16 + 4 * g) = ov;
      }
    }
    {
      const int vt = w >> 1, dh = w & 1;
#pragma unroll
      for (int i2 = 0; i2 < 2; ++i2) {
        const int dt = 2 * dh + i2, dcol = dt * 16 + c;
        const float dec = __expf(bend[dcol]);
        f32x4 a4 = cst[i2] * dec;
#pragma unroll
        for (int kk = 0; kk < 2; ++kk) {
          const u16* ar = VT + (vt * 16 + c) * 66 + 32 * kk + 8 * g;
          const u16* br = KdT + (dt * 16 + c) * 66 + 32 * kk + 8 * g;
          a4 = mfma16(ld_frag4x4(ar, ar + 4), ld_frag4x4(br, br + 4), a4);
        }
        cst[i2] = a4;
#pragma unroll
        for (int rg = 0; rg < 4; ++rg) STn[(vt * 16 + 4 * g + rg) * 72 + dcol] = f2bf(a4[rg]);
      }
    }
  }
}

__device__ void mlstm_chain(const Params& p, int layer, int idx, char* smem) {
  const int b = idx >> 3, h = (idx >> 1) & 3, dir = idx & 1;
  u16* Qs0 = (u16*)smem;
  u16* Ksm0 = (u16*)(smem + 9216);
  u16* VTb = (u16*)(smem + 18432);
  u16* KTwb = (u16*)(smem + 26880);
  u16* CT0 = (u16*)(smem + 35328);
  float* nvv0 = (float*)(smem + 44544);
  float* bsA = (float*)(smem + 45056);
  float* usA = (float*)(smem + 45056 + 9216);
  float* cmA = (float*)(smem + 45056 + 18432);
  const int tid = opaque_tid(), lane = tid & 63, w = __builtin_amdgcn_readfirstlane(tid >> 6), c = lane & 15, g = lane >> 4;
  const int lrow = tid >> 3, c8 = tid & 7;
  const u16* Z = p.z;
  u16* ob = p.obuf + (size_t)(2 + dir) * NTOK * 256;
  f32x4 cst[2];
  cst[0] = (f32x4){0.f, 0.f, 0.f, 0.f};
  cst[1] = cst[0];
  for (int i = tid; i < 64 * 72; i += NTHR) CT0[i] = 0;
  if (tid < 64) nvv0[tid] = 0.f;
  float mprev = 0.f;
  auto chunk_base = [&](int i) {
    if (i < 4) { const int cc = dir ? 3 - i : i; return NLAT + b * CTXL + cc * 64; }
    const int cc = dir ? 31 - (i - 4) : (i - 4);
    return b * SEQ + cc * 64;
  };
  for (int ci = w; ci < 36; ci += 8) {
    const size_t tg = (size_t)(chunk_base(ci) + (dir ? 63 - lane : lane)) * 16;
    const float ig = p.gates[tg + dir * 4 + h], fg = p.gates[tg + 8 + dir * 4 + h];
    const float lf = fminf(fg, 0.f) - __logf(1.f + __expf(-fabsf(fg)));
    float bc = lf;
#pragma unroll
    for (int o = 1; o < 64; o <<= 1) {
      const float t = __shfl_up(bc, o);
      if (lane >= o) bc += t;
    }
    const float u = ig - bc;
    float cm = u;
#pragma unroll
    for (int o = 1; o < 64; o <<= 1) {
      const float t = __shfl_up(cm, o);
      if (lane >= o) cm = fmaxf(cm, t);
    }
    bsA[ci * 64 + lane] = bc;
    usA[ci * 64 + lane] = u;
    cmA[ci * 64 + lane] = cm;
  }
  u32x4 nq, nk, nv;
  {
    const int base = chunk_base(0);
    const size_t ro = (size_t)(base + (dir ? 63 - lrow : lrow)) * ZW;
    nq = *(const u32x4*)(Z + ro + MQ + h * 64 + c8 * 8);
    nk = *(const u32x4*)(Z + ro + MK + h * 64 + c8 * 8);
    nv = *(const u32x4*)(Z + ro + MV + h * 64 + c8 * 8);
  }
  __syncthreads();
  for (int i = 0; i < 36; ++i) {
    const int base = chunk_base(i);
    u16* VT = (i & 1) ? (u16*)(smem + 72704) : VTb;
    u16* KTw = (i & 1) ? (u16*)(smem + 72704 + 8448) : KTwb;
    u16* Qs = (i & 1) ? (u16*)(smem + 89600) : Qs0;
    u16* Ksm = (i & 1) ? (u16*)(smem + 98816) : Ksm0;
    const u16* CT = (i & 1) ? (const u16*)(smem + 108032) : CT0;
    u16* CTn = (i & 1) ? CT0 : (u16*)(smem + 108032);
    const float* nvv = (i & 1) ? (const float*)(smem + 117248) : nvv0;
    float* nvn = (i & 1) ? nvv0 : (float*)(smem + 117248);
    const float* bs = bsA + i * 64;
    const float* us = usA + i * 64;
    const float* cms = cmA + i * 64;
    const float Mend = fmaxf(mprev, cms[63]);
    const float wold = __expf(mprev - Mend);
    const float mnew = bs[63] + Mend;
    *(u32x4*)(Qs + lrow * 72 + c8 * 8) = nq;
    *(u32x4*)(Ksm + lrow * 72 + c8 * 8) = nk;
    {
      const float ws = __expf(us[lrow] - Mend);
#pragma unroll
      for (int j = 0; j < 4; ++j) {
        VT[(c8 * 8 + 2 * j) * 66 + lrow] = (u16)(nv[j] & 0xffffu);
        VT[(c8 * 8 + 2 * j + 1) * 66 + lrow] = (u16)(nv[j] >> 16);
        KTw[(c8 * 8 + 2 * j) * 66 + lrow] = f2bf(bf_lo(nk[j]) * ws);
        KTw[(c8 * 8 + 2 * j + 1) * 66 + lrow] = f2bf(bf_hi(nk[j]) * ws);
      }
    }
    lds_barrier();
    if (i + 1 < 36) {
      const int nb = chunk_base(i + 1);
      const size_t ro = (size_t)(nb + (dir ? 63 - lrow : lrow)) * ZW;
      nq = *(const u32x4*)(Z + ro + MQ + h * 64 + c8 * 8);
      nk = *(const u32x4*)(Z + ro + MK + h * 64 + c8 * 8);
      nv = *(const u32x4*)(Z + ro + MV + h * 64 + c8 * 8);
    }
    {
      const int tb = (w < 4) ? w : 7 - w, vh = w >> 2;
      const int t = tb * 16 + c;
      const float Mt = fmaxf(mprev, cms[t]);
      const float win = __expf(mprev - Mt);
      bf16x8 qf[2];
#pragma unroll
      for (int kk = 0; kk < 2; ++kk) qf[kk] = ld_frag16(Qs + t * 72 + 32 * kk + 8 * g);
      float psum = 0.f;
      unsigned pp[4][2];
#pragma unroll
      for (int st = 0; st < 4; ++st) {
        f32x4 sacc = (f32x4){0.f, 0.f, 0.f, 0.f};
        if (st <= tb) {
#pragma unroll
          for (int kk = 0; kk < 2; ++kk) sacc = mfma16(ld_frag16(Ksm + (st * 16 + c) * 72 + 32 * kk + 8 * g), qf[kk], sacc);
#pragma unroll
          for (int rg = 0; rg < 4; ++rg) {
            const int s = st * 16 + 4 * g + rg;
            const float dv = (s <= t) ? __expf(us[s] - Mt) : 0.f;
            sacc[rg] *= dv;
            psum += sacc[rg];
          }
        }
        pp[st][0] = pk_bf16(sacc[0], sacc[1]);
        pp[st][1] = pk_bf16(sacc[2], sacc[3]);
      }
      psum = xsum16(psum);
      psum = xsum32(psum);
      float qn = 0.f;
      {
        const u32x4 q0 = *(const u32x4*)(Qs + t * 72 + 16 * g), q1 = *(const u32x4*)(Qs + t * 72 + 16 * g + 8);
#pragma unroll
        for (int j = 0; j < 4; ++j) {
          qn += bf_lo(q0[j]) * nvv[16 * g + 2 * j] + bf_hi(q0[j]) * nvv[16 * g + 2 * j + 1];
          qn += bf_lo(q1[j]) * nvv[16 * g + 8 + 2 * j] + bf_hi(q1[j]) * nvv[16 * g + 8 + 2 * j + 1];
        }
      }
      qn = xsum16(qn);
      qn = xsum32(qn);
      const float den = win * qn + psum;
      const float mt = bs[t] + Mt;
      const float hs = __builtin_amdgcn_rcpf(fmaxf(fabsf(den), __expf(-mt)));
      bf16x8 pf[2];
#pragma unroll
      for (int kk = 0; kk < 2; ++kk) {
        u32x4 a;
        a[0] = pp[2 * kk][0]; a[1] = pp[2 * kk][1]; a[2] = pp[2 * kk + 1][0]; a[3] = pp[2 * kk + 1][1];
        pf[kk] = as_bf16x8(a);
      }
      const int tok = base + (dir ? 63 - t : t);
#pragma unroll
      for (int vi = 0; vi < 2; ++vi) {
        const int vt = vh * 2 + vi;
        f32x4 o = (f32x4){0.f, 0.f, 0.f, 0.f};
#pragma unroll
        for (int kk = 0; kk < 2; ++kk) o = mfma16(ld_frag16(CT + (vt * 16 + c) * 72 + 32 * kk + 8 * g), qf[kk], o);
        o = o * win;
#pragma unroll
        for (int kk = 0; kk < 2; ++kk) {
          const u16* vrow = VT + (vt * 16 + c) * 66 + 32 * kk + 4 * g;
          o = mfma16(ld_frag4x4(vrow, vrow + 16), pf[kk], o);
        }
        o = o * hs;
        u32x2 ov;
        ov[0] = pk_bf16(o[0], o[1]);
        ov[1] = pk_bf16(o[2], o[3]);
        *(u32x2*)(ob + (size_t)tok * 256 + h * 64 + vt * 16 + 4 * g) = ov;
      }
    }
    {
      const int vt = w >> 1, dh = w & 1;
#pragma unroll
      for (int i2 = 0; i2 < 2; ++i2) {
        const int dt = 2 * dh + i2, dcol = dt * 16 + c;
        f32x4 a4 = cst[i2] * wold;
#pragma unroll
        for (int kk = 0; kk < 2; ++kk) {
          const u16* ar = VT + (vt * 16 + c) * 66 + 32 * kk + 8 * g;
          const u16* br = KTw + (dt * 16 + c) * 66 + 32 * kk + 8 * g;
          a4 = mfma16(ld_frag4x4(ar, ar + 4), ld_frag4x4(br, br + 4), a4);
        }
        cst[i2] = a4;
#pragma unroll
        for (int rg = 0; rg < 4; ++rg) CTn[(vt * 16 + 4 * g + rg) * 72 + dcol] = f2bf(a4[rg]);
      }
      {
        const int dn = tid >> 3, p8 = tid & 7;
        const unsigned* kr = (const unsigned*)(KTw + dn * 66 + p8 * 8);
        float s = 0.f;
#pragma unroll
        for (int j = 0; j < 4; ++j) s += bf_lo(kr[j]) + bf_hi(kr[j]);
        s += __shfl_xor(s, 1);
        s += __shfl_xor(s, 2);
        s += __shfl_xor(s, 4);
        if (p8 == 0) nvn[dn] = wold * nvv[dn] + s;
      }
      mprev = mnew;
    }
  }
}

__device__ void mixer_phase(const Params& p, int layer, char* smem) {
  const int natt = 256 + 512 + 512 + (layer == 0 ? 128 : 0);
  const int njobs = natt + 64;
  volatile LAS unsigned* slot = (volatile LAS unsigned*)(smem + ST_OFF + 8);
  unsigned* ctr = p.bar + XCD_BAR_WORDS + 64 * layer;
  for (;;) {
    if (threadIdx.x == 0) *slot = atomicAdd(ctr, 1u);
    __syncthreads();
    int job = (int)*slot;
    __syncthreads();
    if (job >= njobs) break;
    if (job >= 256 && job < 320) {
      bias_job(p, layer, job - 256, smem);
      continue;
    }
    if (job >= 320) job -= 64;
    if (job < 256) {
      for (int rep = 0; rep < REP_CHAIN; ++rep) {
        if (job < 128) hgrn_chain(p, layer, job, smem);
        else mlstm_chain(p, layer, job - 128, smem);
        __syncthreads();
      }
    } else {
      for (int rep = 0; rep < REP_ATT; ++rep) {
        if (job < 768) attn_job<0>(p, layer, job - 256, smem);
        else if (job < 1280) attn_job<1>(p, layer, job - 768, smem);
        else if (job < 1344) attn_job<2>(p, layer, job - 1280, smem);
        else attn_job<3>(p, layer, job - 1344, smem);
        __syncthreads();
      }
    }
  }
}

__device__ void combine_phase(const Params& p, int layer, int nrows) {
  const int tid_ = opaque_tid();
  const int lane = tid_ & 63, wid = tid_ >> 6;
  const int mixer = lane >> 5;
  const int col = (lane & 31) * 8;
  const float* gsrc = (mixer == 0 ? p.hgrn_g : p.mlstm_g) + layer * 64 + (col & 63);
  float gv[8];
#pragma unroll
  for (int j = 0; j < 8; ++j) gv[j] = gsrc[j];
  for (int row = blockIdx.x * 8 + wid; row < nrows; row += gridDim.x * 8) {
    const u32x4 a = *(const u32x4*)(p.obuf + ((size_t)(mixer * 2 + 0) * NTOK + row) * 256 + col);
    const u32x4 bq = *(const u32x4*)(p.obuf + ((size_t)(mixer * 2 + 1) * NTOK + row) * 256 + col);
    const u32x4 gz = *(const u32x4*)(p.z + (size_t)row * ZW + (mixer == 0 ? HG : MO) + col);
    float o[8];
    float ss = 0.f;
#pragma unroll
    for (int j = 0; j < 4; ++j) {
      o[2 * j] = bf_lo(a[j]) + bf_lo(bq[j]);
      o[2 * j + 1] = bf_hi(a[j]) + bf_hi(bq[j]);
      ss += o[2 * j] * o[2 * j] + o[2 * j + 1] * o[2 * j + 1];
    }
    ss += __shfl_xor(ss, 1);
    ss += __shfl_xor(ss, 2);
    ss += __shfl_xor(ss, 4);
    const float rs = __builtin_amdgcn_rsqf(ss * (1.f / 64.f) + EPSN);
    u32x4 outv;
#pragma unroll
    for (int j = 0; j < 4; ++j) {
      const float z0 = bf_lo(gz[j]), z1 = bf_hi(gz[j]);
      const float g0 = mixer == 0 ? siluf(z0) : sigmf(z0), g1 = mixer == 0 ? siluf(z1) : sigmf(z1);
      outv[j] = pk_bf16(o[2 * j] * rs * gv[2 * j] * g0, o[2 * j + 1] * rs * gv[2 * j + 1] * g1);
    }
    *(u32x4*)(p.xn + (size_t)row * DM + mixer * 256 + col) = outv;
  }
}

__global__ void __launch_bounds__(NTHR) fwd_megakernel(Params p) {
  extern __shared__ __attribute__((aligned(16))) char smem_raw[];
  cg::grid_group grid = cg::this_grid();
  volatile LAS unsigned* xst = (volatile LAS unsigned*)(smem_raw + ST_OFF);
  if (threadIdx.x == 0) { xst[0] = 0u; xst[1] = 0u; }
  __syncthreads();
  const XcdBarrier xb = xcd_barrier_post(p.bar, xst);
#define SEAM() xcd_barrier(xb)
  prologue_phase(p, smem_raw);
  grid.sync();
  for (int l = 0; l < 2; ++l) {
    const int nMr = (l == 0) ? 144 : 128;
    const int nrows2 = (l == 0) ? NTOK : NLAT;
    for (int rep = 0; rep < REP_NORM; ++rep) { norm_phase(p, l, 0, NTOK, smem_raw); SEAM(); }
    for (int rep = 0; rep < REP_GIN; ++rep) { gemm_phase<EPI_IN, 1024>(p, l, p.xn, p.WinT + (size_t)l * ZW * DM, 144, 14); SEAM(); }
    for (int rep = 0; rep < REP_MIXER; ++rep) { mixer_phase(p, l, smem_raw); SEAM(); }
    for (int rep = 0; rep < REP_COMB; ++rep) { combine_phase(p, l, nrows2); SEAM(); }
    gemm_phase<EPI_OUT, 1024>(p, l, p.xn, p.WoutT + (size_t)l * DM * DM, nMr, 4);
    SEAM();
    for (int rep = 0; rep < REP_MLP1; ++rep) { gemm_phase<EPI_MLP1, 1024>(p, l, p.xn2, p.W1T + (size_t)l * HID * DM, nMr, 16); SEAM(); }
    if (l == 0) gemm_phase<EPI_MLP2, 4096, true>(p, l, p.hid, p.W2T + (size_t)l * DM * HID, 128, 4, 16);
    else if (gridDim.x == 256) gemm_phase<EPI_MLP2F, 4096>(p, l, p.hid, p.W2T + (size_t)l * DM * HID, nMr, 4);
    else { gemm_phase<EPI_MLP2, 4096>(p, l, p.hid, p.W2T + (size_t)l * DM * HID, nMr, 4); SEAM(); final_norm_phase(p); }
    if (l == 0) SEAM();
  }
  for (int e = 0; e < EXTRA_SYNC; ++e) SEAM();
}

extern "C" void kernel_launch(void* const* d_in, const int* in_sizes, int n_in, void* d_out, int out_size, void* d_ws,
                              size_t ws_size, hipStream_t stream) {
  static int grid_blocks = 0;
  if (!grid_blocks) {
    hipFuncSetAttribute((const void*)fwd_megakernel, hipFuncAttributeMaxDynamicSharedMemorySize, LDS_BYTES);
    int dev = 0, cus = 0, per_cu = 0;
    hipGetDevice(&dev);
    hipDeviceGetAttribute(&cus, hipDeviceAttributeMultiprocessorCount, dev);
    hipOccupancyMaxActiveBlocksPerMultiprocessor(&per_cu, fwd_megakernel, NTHR, LDS_BYTES);
    if (per_cu < 1) per_cu = 1;
    if (per_cu > 1) per_cu = 1;
    grid_blocks = cus * per_cu;
  }
  Params p{};
  const float* const* in = (const float* const*)d_in;
  p.x = in[0]; p.c = in[1]; p.ctx = in[2]; p.c_ctx = in[3]; p.w_mod = in[4]; p.b_mod = in[5]; p.g1 = in[6]; p.g2 = in[7];
  p.w_in = in[8]; p.lb_logits = in[9]; p.hgrn_g = in[10]; p.mlstm_b = in[11]; p.mlstm_g = in[12]; p.qn_g = in[13];
  p.kn_g = in[14]; p.rpb = in[15]; p.w_out = in[16]; p.w1 = in[17]; p.w2 = in[18]; p.final_g = in[19];
  p.out = (float*)d_out;
  char* ws = (char*)d_ws;
  size_t off = 0;
  auto take = [&](size_t bytes) { char* r = ws + off; off += (bytes + 255) & ~(size_t)255; return r; };
  p.WinT = (u16*)take((size_t)2 * ZW * DM * 2);
  p.WoutT = (u16*)take((size_t)2 * DM * DM * 2);
  p.W1T = (u16*)take((size_t)2 * HID * DM * 2);
  p.W2T = (u16*)take((size_t)2 * DM * HID * 2);
  p.wg = (float*)take((size_t)2 * 16 * DM * 4);
  p.modv = (float*)take((size_t)2 * 17 * 6 * DM * 4);
  p.ropec = (float*)take((size_t)SEQ * 32 * 4);
  p.ropes = (float*)take((size_t)SEQ * 32 * 4);
  p.gates = (float*)take((size_t)NTOK * 16 * 4);
  p.xcw = (float*)take((size_t)NBATCH * CTXL * DM * 4);
  p.z = (u16*)take((size_t)NTOK * ZW * 2);
  p.xn = (u16*)take((size_t)NTOK * DM * 2);
  p.obuf = (u16*)take((size_t)4 * NTOK * 256 * 2);
  p.hid = p.z;
  p.xn2 = p.obuf;
  p.bias1 = (float*)take((size_t)2 * 17 * HID * 4);
  p.bar = (unsigned*)take((size_t)(XCD_BAR_WORDS + 128 + 2 * NTOK + NLAT + 128) * 4);
  p.rowss = (float*)(p.bar + XCD_BAR_WORDS + 128);
  p.rowssF = p.rowss + 2 * NTOK;
  p.cntF = (unsigned*)(p.rowssF + NLAT);
  if (off > ws_size) fprintf(stderr, "workspace too small: need %zu have %zu\n", off, ws_size);
  (void)hipMemsetAsync(p.bar, 0, (size_t)(XCD_BAR_WORDS + 128 + 2 * NTOK + NLAT + 128) * 4, stream);
  void* args[] = {&p};
  hipError_t e = hipLaunchCooperativeKernel((const void*)fwd_megakernel, dim3(grid_blocks), dim3(NTHR), args, LDS_BYTES, stream);
  if (e != hipSuccess) fprintf(stderr, "cooperative launch failed: %s (grid %d)\n", hipGetErrorString(e), grid_blocks);
}
```
